# Optimizing an MI355X kernel written in HIP

```python
import jax, jax.numpy as jnp
from jax import lax
import numpy as np

D_MODEL = 2048
BATCH = 2
SEQ = 4096
DEPTH = 4

GRID_W = 64
CTX_LEN = 256
HEAD_DIM = 128
ROPE_BASE = 10000.0
EPS = 1e-6
NEG_INF = -1e30

RET_HEADS = 8
RET_DK = 128
RET_DV = 128
RET_CHUNK = 128
WIN_HEADS = 8
WIN_KV_HEADS = 2
WIN_RADIUS = 128
WIN_BLOCK = 128
CONV_WIDTH = 1024
CONV_K = 3
MLA_HEADS = 8
MLA_Q_RANK = 512
MLA_KV_RANK = 256
MLA_NOPE = 128
MLA_ROPE = 64
MLA_V = 128
MLA_BLOCK = 128
D_FF = 4 * D_MODEL

EVEN_SPLITS = (RET_HEADS * RET_DK, RET_HEADS * RET_DK, RET_HEADS * RET_DV, RET_HEADS * RET_DV,
               WIN_HEADS * HEAD_DIM, WIN_KV_HEADS * HEAD_DIM, WIN_KV_HEADS * HEAD_DIM)
EVEN_IN = sum(EVEN_SPLITS)
EVEN_MIX = RET_HEADS * RET_DV + WIN_HEADS * HEAD_DIM
ODD_SPLITS = (CONV_WIDTH, CONV_WIDTH, CONV_WIDTH, MLA_Q_RANK, MLA_KV_RANK, MLA_ROPE)
ODD_IN = sum(ODD_SPLITS)
ODD_MIX = CONV_WIDTH + MLA_HEADS * MLA_V
N_EVEN = (DEPTH + 1) // 2
N_ODD = DEPTH // 2

kernel_name = "hybrid_retention_window_conv_mla_dit"


def rms_norm(x, w):
    xf = x.astype(jnp.float32)
    y = xf * lax.rsqrt(jnp.mean(xf * xf, axis=-1, keepdims=True) + EPS)
    return (y * w.astype(jnp.float32)).astype(x.dtype)


def split_cols(h, sizes):
    return jnp.split(h, [int(s) for s in np.cumsum(sizes)[:-1]], axis=-1)


def to_heads(t, n):
    b, tl, _ = t.shape
    return t.reshape(b, tl, n, -1).transpose(0, 2, 1, 3)


def from_heads(t):
    b, h, tl, d = t.shape
    return t.transpose(0, 2, 1, 3).reshape(b, tl, h * d)


def rope_1d(x, pos):
    d = x.shape[-1]
    inv = ROPE_BASE ** (-jnp.arange(0, d, 2, dtype=jnp.float32) / d)
    ang = pos.astype(jnp.float32)[:, None] * inv[None, :]
    cos, sin = jnp.cos(ang), jnp.sin(ang)
    x1, x2 = jnp.split(x.astype(jnp.float32), 2, axis=-1)
    return jnp.concatenate([x1 * cos - x2 * sin, x2 * cos + x1 * sin], axis=-1).astype(x.dtype)


def rope_axial(x, row, col):
    xr, xc = jnp.split(x, 2, axis=-1)
    return jnp.concatenate([rope_1d(xr, row), rope_1d(xc, col)], axis=-1)


def modulation(cvec, w_mod, b_mod):
    return jnp.split(jax.nn.silu(cvec) @ w_mod + b_mod, 6, axis=-1)


def modulate(h, shift, scale):
    return h * (1 + scale[:, None]) + shift[:, None]


def sink_softmax(s, sink):
    sink = jnp.broadcast_to(sink, s.shape[:-1] + (1,))
    return jax.nn.softmax(jnp.concatenate([sink, s], axis=-1), axis=-1)[..., 1:]


def retention_chunkwise(q, k, v, log_gamma, s0, inclusive):
    b, h, tl, dk = q.shape
    dv = v.shape[-1]
    n = tl // RET_CHUNK
    qc = q.astype(jnp.float32).reshape(b, h, n, RET_CHUNK, dk)
    kc = k.astype(jnp.float32).reshape(b, h, n, RET_CHUNK, dk)
    vc = v.astype(jnp.float32).reshape(b, h, n, RET_CHUNK, dv)
    lg = log_gamma.astype(jnp.float32)[:, None]
    i = jnp.arange(RET_CHUNK, dtype=jnp.float32)
    diff = i[:, None] - i[None, :]
    mask = diff >= 0 if inclusive else diff > 0
    dmat = jnp.where(mask[None], jnp.exp(lg[:, :, None] * jnp.maximum(diff, 0.0)[None]), 0.0)
    scores = jnp.einsum('bhnid,bhnjd->bhnij', qc, kc) * dmat[None, :, None]
    o = jnp.einsum('bhnij,bhnje->bhnie', scores, vc)
    k_dec = kc * jnp.exp(lg * (RET_CHUNK - 1 - i))[None, :, None, :, None]
    kv = jnp.einsum('bhnjd,bhnje->bhnde', k_dec, vc)
    g_chunk = jnp.exp(lg[:, 0] * RET_CHUNK)[None, :, None, None]

    def step(s, kv_n):
        return g_chunk * s + kv_n, s

    s_fin, s_prev = lax.scan(step, s0.astype(jnp.float32), jnp.moveaxis(kv, 2, 0))
    s_prev = jnp.moveaxis(s_prev, 0, 2)
    q_dec = qc * jnp.exp(lg * (i + 1))[None, :, None, :, None]
    o = o + jnp.einsum('bhnid,bhnde->bhnie', q_dec, s_prev)
    return o.reshape(b, h, tl, dv), s_fin


def bidir_retention(q, k, v, lg, s0_f, s0_b):
    o_f, s_f = retention_chunkwise(q, k, v, lg[0], s0_f, True)
    flip = lambda t: jnp.flip(t, axis=2)
    o_b, s_b = retention_chunkwise(flip(q), flip(k), flip(v), lg[1], s0_b, False)
    return o_f + flip(o_b), s_f, s_b


def retention_output(o, g, gn_w):
    mu = jnp.mean(o, axis=-1, keepdims=True)
    var = jnp.mean(jnp.square(o - mu), axis=-1, keepdims=True)
    o = from_heads((o - mu) * lax.rsqrt(var + EPS)) * gn_w.astype(jnp.float32)
    return (jax.nn.silu(g.astype(jnp.float32)) * o).astype(g.dtype)


def retention_group(pc, px, log2_decay, gn_w, pos):
    q_c, k_c, v_c, g_c = pc
    q_x, k_x, v_x, g_x = px
    lg = jnp.log1p(-jnp.exp2(log2_decay.astype(jnp.float32)))
    sc = RET_DK ** -0.5
    q_c = to_heads(q_c, RET_HEADS) * sc
    k_c = to_heads(k_c, RET_HEADS)
    v_c = to_heads(v_c, RET_HEADS)
    q_x = rope_1d(to_heads(q_x, RET_HEADS), pos) * sc
    k_x = rope_1d(to_heads(k_x, RET_HEADS), pos)
    v_x = to_heads(v_x, RET_HEADS)
    s0 = jnp.zeros((q_c.shape[0], RET_HEADS, RET_DK, RET_DV), jnp.float32)
    o_c, s_f, s_b = bidir_retention(q_c, k_c, v_c, lg, s0, s0)
    o_x, _, _ = bidir_retention(q_x, k_x, v_x, lg, s_f, s_b)
    return retention_output(o_c, g_c, gn_w), retention_output(o_x, g_x, gn_w)


def window_attention_group(pc, px, sink, row, col):
    q_c, k_c, v_c = pc
    q_x, k_x, v_x = px
    grp = WIN_HEADS // WIN_KV_HEADS
    sc = HEAD_DIM ** -0.5

    def heads_q(t):
        b, tl, _ = t.shape
        return t.reshape(b, tl, WIN_KV_HEADS, grp, HEAD_DIM).transpose(0, 2, 3, 1, 4)

    def merge_q(t):
        b, kh, g, tl, d = t.shape
        return t.transpose(0, 3, 1, 2, 4).reshape(b, tl, kh * g * d)

    sink_kg = sink.astype(jnp.float32).reshape(WIN_KV_HEADS, grp)
    q_c = heads_q(q_c) * sc
    k_c = to_heads(k_c, WIN_KV_HEADS)
    v_c = to_heads(v_c, WIN_KV_HEADS)
    q_x = rope_axial(heads_q(q_x), row, col) * sc
    k_x = rope_axial(to_heads(k_x, WIN_KV_HEADS), row, col)
    v_x = to_heads(v_x, WIN_KV_HEADS)
    s_cc = jnp.einsum('bkgid,bkjd->bkgij', q_c, k_c).astype(jnp.float32)
    p_c = sink_softmax(s_cc, sink_kg[None, :, :, None, None]).astype(v_c.dtype)
    o_c = jnp.einsum('bkgij,bkjd->bkgid', p_c, v_c)
    b, kh, _, tl, d = q_x.shape
    nb = tl // WIN_BLOCK
    qb = q_x.reshape(b, kh, grp, nb, WIN_BLOCK, d)

    def band(t):
        tp = jnp.pad(t, ((0, 0), (0, 0), (WIN_BLOCK, WIN_BLOCK), (0, 0))).reshape(b, kh, nb + 2, WIN_BLOCK, d)
        return jnp.concatenate([tp[:, :, :-2], tp[:, :, 1:-1], tp[:, :, 2:]], axis=3)

    kw, vw = band(k_x), band(v_x)
    qpos = jnp.arange(tl).reshape(nb, WIN_BLOCK)
    kpos = (jnp.arange(nb)[:, None] - 1) * WIN_BLOCK + jnp.arange(3 * WIN_BLOCK)[None, :]
    valid = ((jnp.abs(qpos[:, :, None] - kpos[:, None, :]) <= WIN_RADIUS)
             & (kpos[:, None, :] >= 0) & (kpos[:, None, :] < tl))
    s_win = jnp.where(valid, jnp.einsum('bkgnid,bknjd->bkgnij', qb, kw).astype(jnp.float32), NEG_INF)
    s_ctx = jnp.einsum('bkgnid,bkjd->bkgnij', qb, k_c).astype(jnp.float32)
    n_ctx = k_c.shape[2]
    p = sink_softmax(jnp.concatenate([s_ctx, s_win], axis=-1),
                     sink_kg[None, :, :, None, None, None]).astype(v_x.dtype)
    o_x = (jnp.einsum('bkgnij,bkjd->bkgnid', p[..., :n_ctx], v_c)
           + jnp.einsum('bkgnij,bknjd->bkgnid', p[..., n_ctx:], vw))
    return merge_q(o_c), merge_q(o_x.reshape(b, kh, grp, tl, d))


def short_conv(bg, cg, xv, conv_w):
    u = cg * xv
    up = jnp.pad(u, ((0, 0), (1, 1), (0, 0)))
    z = up[:, :-2] * conv_w[0] + up[:, 1:-1] * conv_w[1] + up[:, 2:] * conv_w[2]
    return bg * z


def mla_group(pc, px, q_norm_w, kv_norm_w, w_uq, w_ukv, row, col):
    def project(cq, ckv, kr):
        q = to_heads(rms_norm(cq, q_norm_w) @ w_uq, MLA_HEADS)
        kv = to_heads(rms_norm(ckv, kv_norm_w) @ w_ukv, MLA_HEADS)
        return q[..., :MLA_NOPE], q[..., MLA_NOPE:], kv[..., :MLA_NOPE], kv[..., MLA_NOPE:], kr[:, None]

    qn_c, qr_c, kn_c, v_c, kr_c = project(*pc)
    qn_x, qr_x, kn_x, v_x, kr_x = project(*px)
    qr_x = rope_axial(qr_x, row, col)
    kr_x = rope_axial(kr_x, row, col)
    sc = (MLA_NOPE + MLA_ROPE) ** -0.5

    def join(qn, qr, kn, kr):
        q = jnp.concatenate([qn, qr], axis=-1) * sc
        k = jnp.concatenate([kn, jnp.broadcast_to(kr, kn.shape[:-1] + (MLA_ROPE,))], axis=-1)
        return q, k

    q_c, k_c = join(qn_c, qr_c, kn_c, kr_c)
    q_x, k_x = join(qn_x, qr_x, kn_x, kr_x)
    p_c = jax.nn.softmax(jnp.einsum('bhid,bhjd->bhij', q_c, k_c).astype(jnp.float32), axis=-1)
    o_c = jnp.einsum('bhij,bhjd->bhid', p_c.astype(v_c.dtype), v_c)
    keys = jnp.concatenate([k_c, k_x], axis=2)
    vals = jnp.concatenate([v_c, v_x], axis=2)
    b, h, tl, dq = q_x.shape
    nb = tl // MLA_BLOCK
    qb = jnp.moveaxis(q_x.reshape(b, h, nb, MLA_BLOCK, dq), 2, 0)

    def attend(qblk):
        p = jax.nn.softmax(jnp.einsum('bhid,bhjd->bhij', qblk, keys).astype(jnp.float32), axis=-1)
        return jnp.einsum('bhij,bhjd->bhid', p.astype(vals.dtype), vals)

    o_x = jnp.moveaxis(lax.map(attend, qb), 0, 2).reshape(b, h, tl, MLA_V)
    return from_heads(o_c), from_heads(o_x)


def even_mixer(n_c, n_x, w_in, log2_decay, gn_w, sink, pos, row, col):
    pc = split_cols(n_c @ w_in, EVEN_SPLITS)
    px = split_cols(n_x @ w_in, EVEN_SPLITS)
    r_c, r_x = retention_group(pc[:4], px[:4], log2_decay, gn_w, pos)
    a_c, a_x = window_attention_group(pc[4:], px[4:], sink, row, col)
    return jnp.concatenate([r_c, a_c], axis=-1), jnp.concatenate([r_x, a_x], axis=-1)


def odd_mixer(n_c, n_x, w_in, conv_w, q_norm_w, kv_norm_w, w_uq, w_ukv, row, col):
    pc = split_cols(n_c @ w_in, ODD_SPLITS)
    px = split_cols(n_x @ w_in, ODD_SPLITS)
    cv_c = short_conv(pc[0], pc[1], pc[2], conv_w)
    cv_x = short_conv(px[0], px[1], px[2], conv_w)
    m_c, m_x = mla_group(pc[3:], px[3:], q_norm_w, kv_norm_w, w_uq, w_ukv, row, col)
    return jnp.concatenate([cv_c, m_c], axis=-1), jnp.concatenate([cv_x, m_x], axis=-1)


def mlp(h, w1, w2):
    return jnp.square(jax.nn.relu(h @ w1)) @ w2


def setup_inputs(seed: int = 0) -> dict:
    key = jax.random.key(seed)
    ks = iter(jax.random.split(key, 32))
    nrm = lambda shape, s: jax.random.normal(next(ks), shape, jnp.float32) * s
    D = D_MODEL
    return {
        "x": nrm((BATCH, SEQ, D), 1.0),
        "c": nrm((BATCH, D), 1.0),
        "ctx": nrm((BATCH, CTX_LEN, D), 1.0),
        "c_ctx": nrm((D,), 1.0),
        "w_mod": nrm((DEPTH, D, 6 * D), 0.5 * D ** -0.5),
        "b_mod": nrm((DEPTH, 6 * D), 0.02),
        "norm1_w": 1.0 + nrm((DEPTH, D), 0.05),
        "norm2_w": 1.0 + nrm((DEPTH, D), 0.05),
        "mlp_w1": nrm((DEPTH, D, D_FF), D ** -0.5),
        "mlp_w2": nrm((DEPTH, D_FF, D), D_FF ** -0.5),
        "ev_w_in": nrm((N_EVEN, D, EVEN_IN), D ** -0.5),
        "ev_ret_log2_decay": -5.0 - jnp.arange(RET_HEADS, dtype=jnp.float32) + nrm((N_EVEN, 2, RET_HEADS), 0.1),
        "ev_ret_gn_w": 1.0 + nrm((N_EVEN, RET_HEADS * RET_DV), 0.05),
        "ev_sink": nrm((N_EVEN, WIN_HEADS), 1.0),
        "ev_w_out": nrm((N_EVEN, EVEN_MIX, D), EVEN_MIX ** -0.5),
        "od_w_in": nrm((N_ODD, D, ODD_IN), D ** -0.5),
        "od_conv_w": nrm((N_ODD, CONV_K, CONV_WIDTH), CONV_K ** -0.5),
        "od_q_norm_w": 1.0 + nrm((N_ODD, MLA_Q_RANK), 0.05),
        "od_kv_norm_w": 1.0 + nrm((N_ODD, MLA_KV_RANK), 0.05),
        "od_w_uq": nrm((N_ODD, MLA_Q_RANK, MLA_HEADS * (MLA_NOPE + MLA_ROPE)), MLA_Q_RANK ** -0.5),
        "od_w_ukv": nrm((N_ODD, MLA_KV_RANK, MLA_HEADS * (MLA_NOPE + MLA_V)), MLA_KV_RANK ** -0.5),
        "od_w_out": nrm((N_ODD, ODD_MIX, D), ODD_MIX ** -0.5),
        "norm_f": 1.0 + nrm((D,), 0.05),
    }


def reference(x, c, ctx, c_ctx, w_mod, b_mod, norm1_w, norm2_w, mlp_w1, mlp_w2,
              ev_w_in, ev_ret_log2_decay, ev_ret_gn_w, ev_sink, ev_w_out,
              od_w_in, od_conv_w, od_q_norm_w, od_kv_norm_w, od_w_uq, od_w_ukv, od_w_out,
              norm_f):
    tl = x.shape[1]
    ROWS = tl // GRID_W
    row = jnp.repeat(jnp.arange(ROWS, dtype=jnp.int32), GRID_W)
    col = jnp.tile(jnp.arange(GRID_W, dtype=jnp.int32), ROWS)
    pos = jnp.arange(tl, dtype=jnp.int32)
    h_c = ctx
    for layer in range(DEPTH):
        j = layer // 2
        sh1, sc1, g1, sh2, sc2, g2 = modulation(c, w_mod[layer], b_mod[layer])
        csh1, csc1, cg1, csh2, csc2, cg2 = modulation(c_ctx[None], w_mod[layer], b_mod[layer])
        n_x = modulate(rms_norm(x, norm1_w[layer]), sh1, sc1)
        n_c = modulate(rms_norm(h_c, norm1_w[layer]), csh1, csc1)
        if layer % 2 == 0:
            m_c, m_x = even_mixer(n_c, n_x, ev_w_in[j], ev_ret_log2_decay[j], ev_ret_gn_w[j], ev_sink[j],
                                  pos, row, col)
            w_out = ev_w_out[j]
        else:
            m_c, m_x = odd_mixer(n_c, n_x, od_w_in[j], od_conv_w[j], od_q_norm_w[j], od_kv_norm_w[j],
                                 od_w_uq[j], od_w_ukv[j], row, col)
            w_out = od_w_out[j]
        x = x + g1[:, None] * (m_x @ w_out)
        x = x + g2[:, None] * mlp(modulate(rms_norm(x, norm2_w[layer]), sh2, sc2), mlp_w1[layer], mlp_w2[layer])
        if layer < DEPTH - 1:
            h_c = h_c + cg1[:, None] * (m_c @ w_out)
            h_c = h_c + cg2[:, None] * mlp(modulate(rms_norm(h_c, norm2_w[layer]), csh2, csc2),
                                           mlp_w1[layer], mlp_w2[layer])
    return rms_norm(x, norm_f)
```

```cpp
#include <hip/hip_runtime.h>
#include <cstdio>
#include <cstdint>
#define MK_PER_PHASE 0
namespace pg8 {
#define PG8_LAS __attribute__((address_space(3)))
typedef unsigned short bf16_t;
typedef short bf16x8 __attribute__((ext_vector_type(8)));
typedef float f32x4 __attribute__((ext_vector_type(4)));
typedef unsigned u32x4 __attribute__((ext_vector_type(4)));
constexpr int BM = 256, BK = 64, HALF = 128, HTB = HALF * BK * 2  , STAGE_BYTES = 8 * HTB, NXCD = 8, WGM = 4;

__host__ __device__ __forceinline__ int lds_byte(int r, int c) { const int st = (r >> 4) * 2 + (c >> 5), rr = r & 15, cc = c & 31, ob = rr * 64 + cc * 2; return st * 1024 + (ob ^ (((ob >> 9) & 1) << 5)); }
__host__ __device__ __forceinline__ void stage_rc(int b, int& R, int& C) { const int st = b / 1024, sb = b % 1024, swz = sb ^ (((sb >> 9) & 1) << 5); R = (st >> 1) * 16 + swz / 64; C = (st & 1) * 32 + (swz % 64) / 2; }
__host__ __device__ __forceinline__ int perm32(int rho) { const int n = rho >> 4, i = rho & 15; return 8 * (i >> 2) + 4 * n + (i & 3); }

struct Unit { int pm, pn, ks, nt, koff; };
struct Gemm { const bf16_t* A; const bf16_t* Bt; int M, N, K; };

struct StaticOrder {
    int nM, nN, nwg, G, c, ntK;
    __host__ __device__ void init(int M, int N, int G_, int c_, int K_) { nM = M / BM; nN = N / BM; nwg = nM * nN; G = G_; c = c_; ntK = K_ / BK; }
    __host__ __device__ bool next(int i, Unit& u) const {
        const long L = (long)i * G + c; if (L >= nwg) return false;
        int wgid = (int)L; { const int q = nwg / NXCD, r = nwg % NXCD, xcd = wgid % NXCD, off = wgid / NXCD; wgid = (xcd < r ? xcd * (q + 1) : r * (q + 1) + (xcd - r) * q) + off; }
        const int nig = WGM * nN, gid = wgid / nig, fm = gid * WGM, gsz = (nM - fm) < WGM ? (nM - fm) : WGM;
        u.pm = fm + ((wgid % nig) % gsz); u.pn = (wgid % nig) / gsz; u.ks = -1; u.nt = ntK; u.koff = 0; return true;
    }
    __device__ __forceinline__ void a_ready(const Unit&) const {}
    __device__ __forceinline__ void done(const Unit&) const {}
};

__device__ __forceinline__ unsigned cvt_pk_bf16(float lo, float hi) { unsigned r; asm volatile("v_cvt_pk_bf16_f32 %0, %1, %2" : "=v"(r) : "v"(lo), "v"(hi)); return r; }
typedef float f32x2 __attribute__((ext_vector_type(2)));
__device__ __forceinline__ f32x2 gelu_pk(f32x2 v) {
    const f32x2 av = __builtin_elementwise_abs(v), d = av * 0.2316418882f + 1.0f;
    f32x2 t; t.x = __builtin_amdgcn_rcpf(d.x); t.y = __builtin_amdgcn_rcpf(d.y);
    f32x2 q = t * 0.5307027145f + (-0.7265760135f); q = q * t + 0.7107068705f; q = q * t + (-0.142248368f); q = q * t + 0.127414796f; q = q * t;
    const f32x2 s = (v * v) * (-0.72134752044f);
    f32x2 e; e.x = __builtin_amdgcn_exp2f(s.x); e.y = __builtin_amdgcn_exp2f(s.y);
    const f32x2 m = v * (q * e), r = v - m;
    f32x2 o; o.x = v.x < 0.f ? m.x : r.x; o.y = v.y < 0.f ? m.y : r.y; return o;
}


template <int ACT> struct EpiAct {
    static constexpr bool PERM = true, AFTER_DRAIN = false;
    bf16_t* O; int ldc;
    __device__ __forceinline__ void operator()(const f32x4 (&acc)[2][2][4][2], const Unit& u, int wr, int wc, int fr, int fq) const {
        const int row0 = u.pm * BM + wr * 64 + fr, col0 = u.pn * BM + wc * 32 + 8 * fq;
#pragma unroll
        for (int ai = 0; ai < 2; ++ai)
#pragma unroll
            for (int m = 0; m < 4; ++m) { bf16_t* rowp = O + (size_t)(row0 + ai * HALF + m * 16) * ldc + col0;
#pragma unroll
                for (int bj = 0; bj < 2; ++bj) { f32x4 v0 = acc[ai][bj][m][0], v1 = acc[ai][bj][m][1];
                    if (ACT == 1) {
#pragma unroll
                        for (int e = 0; e < 4; ++e) { const float a = fmaxf(v0[e], 0.f), b = fmaxf(v1[e], 0.f); v0[e] = a * a; v1[e] = b * b; } }
                    u32x4 w; w.x = cvt_pk_bf16(v0[0], v0[1]); w.y = cvt_pk_bf16(v0[2], v0[3]); w.z = cvt_pk_bf16(v1[0], v1[1]); w.w = cvt_pk_bf16(v1[2], v1[3]);
                    *(u32x4*)(rowp + bj * HALF) = w; } }
    }
};
struct EpiResGate {
    static constexpr bool PERM = true, AFTER_DRAIN = false;
    bf16_t* H; int ldc; const float* gate0; int set_stride; bf16_t* part; const float* Hx32;
    __device__ __forceinline__ void operator()(const f32x4 (&acc)[2][2][4][2], const Unit& u, int wr, int wc, int fr, int fq) const {
        const int row0 = u.pm * BM + wr * 64 + fr, col0 = u.pn * BM + wc * 32 + 8 * fq;
        if (u.ks >= 0) {
            bf16_t* P = part + (size_t)u.ks * 512 * ldc;
#pragma unroll
            for (int ai = 0; ai < 2; ++ai)
#pragma unroll
                for (int m = 0; m < 4; ++m) { bf16_t* rowp = P + (size_t)(row0 + ai * HALF + m * 16) * ldc + col0;
#pragma unroll
                    for (int bj = 0; bj < 2; ++bj) { const f32x4 v0 = acc[ai][bj][m][0], v1 = acc[ai][bj][m][1];
                        u32x4 o; o.x = cvt_pk_bf16(v0[0], v0[1]); o.y = cvt_pk_bf16(v0[2], v0[3]); o.z = cvt_pk_bf16(v1[0], v1[1]); o.w = cvt_pk_bf16(v1[2], v1[3]);
                        *(u32x4*)(rowp + bj * HALF) = o; } }
            return; }
        const int grow = u.pm * BM; const int set = grow < 512 ? 2 : ((grow - 512) >> 12);
        const float* g = gate0 + (size_t)set * set_stride + col0;
        f32x4 gv[2][2];
#pragma unroll
        for (int bj = 0; bj < 2; ++bj) { gv[bj][0] = *(const f32x4*)(g + bj * HALF); gv[bj][1] = *(const f32x4*)(g + bj * HALF + 4); }
        if (Hx32) {
#pragma unroll
            for (int ai = 0; ai < 2; ++ai) { f32x4 hx[4][2][2];
#pragma unroll
                for (int m = 0; m < 4; ++m)
#pragma unroll
                    for (int bj = 0; bj < 2; ++bj) { const float* ps = Hx32 + (size_t)(row0 + ai * HALF + m * 16) * ldc + col0 - (size_t)512 * ldc + bj * HALF; hx[m][bj][0] = *(const f32x4*)ps; hx[m][bj][1] = *(const f32x4*)(ps + 4); }
#pragma unroll
                for (int m = 0; m < 4; ++m)
#pragma unroll
                    for (int bj = 0; bj < 2; ++bj) { const f32x4 v0 = hx[m][bj][0] + gv[bj][0] * acc[ai][bj][m][0], v1 = hx[m][bj][1] + gv[bj][1] * acc[ai][bj][m][1];
                        u32x4 o; o.x = cvt_pk_bf16(v0[0], v0[1]); o.y = cvt_pk_bf16(v0[2], v0[3]); o.z = cvt_pk_bf16(v1[0], v1[1]); o.w = cvt_pk_bf16(v1[2], v1[3]);
                        *(u32x4*)(H + (size_t)(row0 + ai * HALF + m * 16) * ldc + col0 + bj * HALF) = o; } }
        } else {
#pragma unroll
            for (int ai = 0; ai < 2; ++ai) { u32x4 hw[4][2];
#pragma unroll
                for (int m = 0; m < 4; ++m)
#pragma unroll
                    for (int bj = 0; bj < 2; ++bj) hw[m][bj] = *(const u32x4*)(H + (size_t)(row0 + ai * HALF + m * 16) * ldc + col0 + bj * HALF);
#pragma unroll
                for (int m = 0; m < 4; ++m)
#pragma unroll
                    for (int bj = 0; bj < 2; ++bj) { const u32x4 w = hw[m][bj];
                        const f32x4 h0 = {__uint_as_float(w.x << 16), __uint_as_float(w.x & 0xffff0000u), __uint_as_float(w.y << 16), __uint_as_float(w.y & 0xffff0000u)};
                        const f32x4 h1 = {__uint_as_float(w.z << 16), __uint_as_float(w.z & 0xffff0000u), __uint_as_float(w.w << 16), __uint_as_float(w.w & 0xffff0000u)};
                        const f32x4 v0 = h0 + gv[bj][0] * acc[ai][bj][m][0], v1 = h1 + gv[bj][1] * acc[ai][bj][m][1];
                        u32x4 o; o.x = cvt_pk_bf16(v0[0], v0[1]); o.y = cvt_pk_bf16(v0[2], v0[3]); o.z = cvt_pk_bf16(v1[0], v1[1]); o.w = cvt_pk_bf16(v1[2], v1[3]);
                        *(u32x4*)(H + (size_t)(row0 + ai * HALF + m * 16) * ldc + col0 + bj * HALF) = o; } }
        }
    }
};

struct ResOrder {
    StaticOrder so; int nmain, nsplit, S, nN, ntc, G, c;
    __host__ __device__ void init(int M, int N, int K, int S_, int G_, int c_) { so.init(M - 512, N, G_, c_, K); nmain = so.nwg; S = S_; nN = N / BM; nsplit = 2 * nN * S_; ntc = S_ ? K / S_ / BK : 0; G = G_; c = c_; }
    __host__ __device__ bool next(int i, Unit& u) const {
        const long L = (long)i * G + c;
        if (L < nmain) { so.next(i, u); u.pm += 2; return true; }
        const int s = (int)(L - nmain); if (s >= nsplit) return false;
        u.ks = s % S; const int rest = s / S; u.pn = rest % nN; u.pm = rest / nN; u.nt = ntc; u.koff = u.ks * ntc * BK; return true;
    }
    __device__ __forceinline__ void a_ready(const Unit&) const {}
    __device__ __forceinline__ void done(const Unit&) const {}
};
template <class Epi, class Sched, bool ALIGN_EPI = false, bool SP2 = false>
__device__ __forceinline__ void gemm_phase(PG8_LAS unsigned char* lds, const Gemm g, const Sched& S, const Epi& E, int wave_in) {
    int lane_; asm volatile("v_mbcnt_lo_u32_b32 %0, -1, 0\n\tv_mbcnt_hi_u32_b32 %0, -1, %0" : "=v"(lane_));
    const int wid = wave_in, tid = wid * 64 + lane_, lane = tid & 63, wr = wid >> 2, wc = wid & 3, fr = lane & 15, fq = lane >> 4;
    const int K = g.K;
    unsigned voffA[2], voffB[2];
#pragma unroll
    for (int i = 0; i < 2; ++i) { int R, C; stage_rc(tid * 16 + i * 8192, R, C); const int Rb = Epi::PERM ? ((R & ~31) + perm32(R & 31)) : R;
        voffA[i] = (unsigned)(R * K + C) * 2u; voffB[i] = (unsigned)(Rb * K + C) * 2u; }
    const size_t kstep = (size_t)(BK * 2);
    const size_t hstep = (size_t)HALF * K * 2;
    const size_t tstep = 2 * hstep;
    const unsigned ldsw = (unsigned)wid * 1024u;
    const int aoff = lds_byte(wr * 64 + fr, fq * 8), boff = lds_byte(wc * 32 + fr, fq * 8);
#define PG8_SA(b, h) (((b) * 2 + (h)) * HTB)
#define PG8_SB(b, h) ((4 + (b) * 2 + (h)) * HTB)
#define PG8_STAGE(bufoff, gbase, voff) do { _Pragma("unroll") for (int _i = 0; _i < 2; ++_i) \
        __builtin_amdgcn_global_load_lds((const unsigned*)((const char*)(gbase) + (voff)[_i]), (PG8_LAS unsigned*)(lds + (bufoff) + ldsw + _i * 8192), 16, 0, 0); } while (0)
#define PG8_LDA(dst, b, h) do { _Pragma("unroll") for (int m = 0; m < 4; ++m) _Pragma("unroll") for (int k = 0; k < 2; ++k) dst[m][k] = *(const PG8_LAS bf16x8*)(lds + PG8_SA(b, h) + aoff + m * 2048 + k * 1024); } while (0)
#define PG8_LDB(dst, b, h) do { _Pragma("unroll") for (int n = 0; n < 2; ++n) _Pragma("unroll") for (int k = 0; k < 2; ++k) dst[n][k] = *(const PG8_LAS bf16x8*)(lds + PG8_SB(b, h) + boff + n * 2048 + k * 1024); } while (0)
#define PG8_MMA(ai, bj, At, Bt) do { __builtin_amdgcn_s_setprio(1); _Pragma("unroll") for (int m = 0; m < 4; ++m) _Pragma("unroll") for (int n = 0; n < 2; ++n) _Pragma("unroll") for (int k = 0; k < 2; ++k) \
        acc[ai][bj][m][n] = __builtin_amdgcn_mfma_f32_16x16x32_bf16(Bt[n][k], At[m][k], acc[ai][bj][m][n], 0, 0, 0); __builtin_amdgcn_s_setprio(0); } while (0)
#define PG8_WAIT_V(n) asm volatile("s_waitcnt vmcnt(" #n ")" ::: "memory")
#define PG8_WAIT_L(n) asm volatile("s_waitcnt lgkmcnt(" #n ")" ::: "memory")
#define PG8_BAR __builtin_amdgcn_s_barrier()
#define PG8_SCHED __builtin_amdgcn_sched_barrier(0)
    Unit cur, nxt; int ui = 0;
    if (!S.next(0, cur)) return;
    f32x4 acc[2][2][4][2];
#pragma unroll
    for (int a = 0; a < 2; ++a)
#pragma unroll
        for (int b = 0; b < 2; ++b)
#pragma unroll
            for (int m = 0; m < 4; ++m)
#pragma unroll
                for (int n = 0; n < 2; ++n) acc[a][b][m][n] = (f32x4){0.f, 0.f, 0.f, 0.f};
    bf16x8 At[4][2], B0[2][2], B1[2][2];
    const char* cA = (const char*)g.A + (size_t)cur.pm * tstep + (size_t)cur.koff * 2; const char* cB = (const char*)g.Bt + (size_t)cur.pn * tstep + (size_t)cur.koff * 2;
    int nt = cur.nt;
    S.a_ready(cur);
    if constexpr (SP2) {
        PG8_STAGE(PG8_SB(0, 0), cB, voffB); PG8_STAGE(PG8_SB(0, 1), cB + hstep, voffB); PG8_STAGE(PG8_SA(0, 0), cA, voffA); PG8_STAGE(PG8_SA(0, 1), cA + hstep, voffA);
        if (wr == 1) PG8_BAR;
        PG8_WAIT_V(2); PG8_BAR;
        PG8_STAGE(PG8_SB(1, 0), cB + kstep, voffB); PG8_STAGE(PG8_SA(1, 0), cA + kstep, voffA); PG8_STAGE(PG8_SB(1, 1), cB + hstep + kstep, voffB);
        PG8_WAIT_V(6); PG8_BAR;
    } else {
        PG8_STAGE(PG8_SB(0, 0), cB, voffB); PG8_STAGE(PG8_SA(0, 0), cA, voffA); PG8_STAGE(PG8_SB(0, 1), cB + hstep, voffB); PG8_STAGE(PG8_SA(0, 1), cA + hstep, voffA);
        if (wr == 1) PG8_BAR;
        PG8_WAIT_V(4); PG8_BAR;
        PG8_STAGE(PG8_SB(1, 0), cB + kstep, voffB); PG8_STAGE(PG8_SA(1, 0), cA + kstep, voffA); PG8_STAGE(PG8_SB(1, 1), cB + hstep + kstep, voffB);
        PG8_WAIT_V(6); PG8_BAR;
    }
    for (;;) {
        const bool has_next = S.next(ui + 1, nxt);
        const char* nA = has_next ? (const char*)g.A + (size_t)nxt.pm * tstep + (size_t)nxt.koff * 2 : cA; const char* nB = has_next ? (const char*)g.Bt + (size_t)nxt.pn * tstep + (size_t)nxt.koff * 2 : cB;
        asm volatile(".p2align 8" ::: "memory");
        for (int t = 0; t < nt; t += 2) {
            const bool last = (t == nt - 2);
            const char* a1 = cA + (size_t)(t + 1) * kstep;
            const char* a2 = last ? nA : cA + (size_t)(t + 2) * kstep; const char* b2 = last ? nB : cB + (size_t)(t + 2) * kstep;
            const char* a3 = a2 + kstep; const char* b3 = b2 + kstep;
            if (last && has_next) S.a_ready(nxt);
            if constexpr (SP2) {
            PG8_LDB(B0, 0, 0); PG8_LDB(B1, 0, 1); PG8_SCHED; PG8_LDA(At, 0, 0); PG8_STAGE(PG8_SA(1, 1), a1 + hstep, voffA);
            PG8_WAIT_V(8); PG8_WAIT_L(0); PG8_BAR; PG8_MMA(0, 0, At, B0); PG8_MMA(0, 1, At, B1); PG8_BAR; PG8_SCHED;
            PG8_LDA(At, 0, 1); PG8_STAGE(PG8_SB(0, 0), b2, voffB); PG8_STAGE(PG8_SB(0, 1), b2 + hstep, voffB); PG8_STAGE(PG8_SA(0, 0), a2, voffA);
            PG8_WAIT_V(8); PG8_WAIT_L(0); PG8_BAR; PG8_MMA(1, 0, At, B0); PG8_MMA(1, 1, At, B1); PG8_BAR; PG8_SCHED;
            PG8_LDB(B0, 1, 0); PG8_LDB(B1, 1, 1); PG8_SCHED; PG8_LDA(At, 1, 0); PG8_STAGE(PG8_SA(0, 1), a2 + hstep, voffA);
            PG8_WAIT_V(8); PG8_WAIT_L(0); PG8_BAR; PG8_MMA(0, 0, At, B0); PG8_MMA(0, 1, At, B1); PG8_BAR; PG8_SCHED;
            PG8_LDA(At, 1, 1); PG8_STAGE(PG8_SB(1, 0), b3, voffB); PG8_STAGE(PG8_SB(1, 1), b3 + hstep, voffB); PG8_STAGE(PG8_SA(1, 0), a3, voffA);
            PG8_WAIT_V(8); PG8_WAIT_L(0); PG8_BAR; PG8_MMA(1, 0, At, B0); PG8_MMA(1, 1, At, B1); PG8_BAR; PG8_SCHED;
            } else {
            PG8_LDB(B0, 0, 0); PG8_SCHED; PG8_LDA(At, 0, 0); PG8_STAGE(PG8_SA(1, 1), a1 + hstep, voffA);
            PG8_WAIT_L(8); PG8_BAR; PG8_WAIT_L(0); PG8_MMA(0, 0, At, B0); PG8_BAR; PG8_SCHED;
            PG8_LDB(B1, 0, 1); PG8_STAGE(PG8_SB(0, 0), b2, voffB);
            PG8_BAR; PG8_WAIT_L(0); PG8_MMA(0, 1, At, B1); PG8_BAR;
            PG8_LDA(At, 0, 1); PG8_STAGE(PG8_SA(0, 0), a2, voffA);
            PG8_BAR; PG8_WAIT_L(0); PG8_MMA(1, 0, At, B0); PG8_BAR; PG8_SCHED;
            PG8_STAGE(PG8_SB(0, 1), b2 + hstep, voffB);
            PG8_WAIT_V(6); PG8_BAR; PG8_MMA(1, 1, At, B1); PG8_BAR;
            PG8_LDB(B0, 1, 0); PG8_SCHED; PG8_LDA(At, 1, 0); PG8_STAGE(PG8_SA(0, 1), a2 + hstep, voffA);
            PG8_WAIT_L(8); PG8_BAR; PG8_WAIT_L(0); PG8_MMA(0, 0, At, B0); PG8_BAR; PG8_SCHED;
            PG8_LDB(B1, 1, 1); PG8_STAGE(PG8_SB(1, 0), b3, voffB);
            PG8_BAR; PG8_WAIT_L(0); PG8_MMA(0, 1, At, B1); PG8_BAR;
            PG8_LDA(At, 1, 1); PG8_STAGE(PG8_SA(1, 0), a3, voffA);
            PG8_BAR; PG8_WAIT_L(0); PG8_MMA(1, 0, At, B0); PG8_BAR; PG8_SCHED;
            PG8_STAGE(PG8_SB(1, 1), b3 + hstep, voffB);
            PG8_WAIT_V(6); PG8_BAR; PG8_MMA(1, 1, At, B1); PG8_BAR;
            }
        }
        if constexpr (ALIGN_EPI) { if (wr == 0) PG8_BAR; }
        if constexpr (!Epi::AFTER_DRAIN) { E(acc, cur, wr, wc, fr, fq); S.done(cur); }
        if (!has_next) break;
#pragma unroll
        for (int a = 0; a < 2; ++a)
#pragma unroll
            for (int b = 0; b < 2; ++b)
#pragma unroll
                for (int m = 0; m < 4; ++m)
#pragma unroll
                    for (int n = 0; n < 2; ++n) acc[a][b][m][n] = (f32x4){0.f, 0.f, 0.f, 0.f};
        cur = nxt; cA = nA; cB = nB; ++ui; nt = cur.nt;
        if constexpr (ALIGN_EPI) { if (wr == 1) PG8_BAR; }
    }
    PG8_WAIT_V(0);
    if constexpr (!ALIGN_EPI) { if (wr == 0) PG8_BAR; }
    PG8_BAR;
    if constexpr (Epi::AFTER_DRAIN) { E.fused(acc, cur, wr, wc, fr, fq, lds, wid, lane); S.done(cur); }
#undef PG8_SA
#undef PG8_SB
#undef PG8_STAGE
#undef PG8_LDA
#undef PG8_LDB
#undef PG8_MMA
#undef PG8_WAIT_V
#undef PG8_WAIT_L
#undef PG8_BAR
#undef PG8_SCHED
}
}

#ifndef PG8_SP2
#define PG8_SP2 true
#endif
#ifndef PG8_ALIGN
#define PG8_ALIGN true
#endif

constexpr int DM = 2048, NB = 2, TL = 4096, TC = 256, DEPTH = 4, DFF = 8192;
constexpr int RC = NB * TC;
constexpr int RALL = RC + NB * TL;
constexpr int NKEY = TC + TL;
constexpr int EV_IN = 5632, OD_IN = 3904, OD_INP = 3840;
constexpr int E_QR = 0, E_KR = 1024, E_VR = 2048, E_GR = 3072, E_QW = 4096, E_KW = 5120, E_VW = 5376;
constexpr int O_BG = 0, O_CG = 1024, O_XV = 2048, O_CQ = 3072, O_CKV = 3584, O_KR = 3840;
constexpr int NCH = 34;
constexpr float EPS = 1e-6f;
constexpr float LOG2E = 1.4426950408889634f;

constexpr size_t MiB = 1u << 20;
constexpr size_t WS_CTL = 0, CTL_ZERO_BYTES = 32 * 1024;
constexpr size_t WS_MOD = 1 * MiB;
constexpr size_t WS_T1C = 2 * MiB, WS_T1S = 3 * MiB;
constexpr size_t WS_T2 = 4 * MiB;
constexpr size_t WS_W1T = 8 * MiB, WS_W2T = 136 * MiB, WS_EWIN = 264 * MiB, WS_EWOUT = 308 * MiB, WS_OWIN = 324 * MiB, WS_OWOUT = 356 * MiB, WS_UQT = 372 * MiB, WS_UKVT = 375 * MiB;
constexpr size_t WS_H = 384 * MiB, WS_A1 = 452 * MiB, WS_PRJ = 486 * MiB, WS_MIX = 580 * MiB, WS_HID = 614 * MiB, WS_KVST = 750 * MiB, WS_ST = 818 * MiB;
constexpr size_t WS_VTW = 852 * MiB, WS_VTM = 857 * MiB, WS_CQN = 874 * MiB, WS_CKVN = 883 * MiB, WS_QRAW = 888 * MiB, WS_KVRAW = 914 * MiB, WS_PARTO = 948 * MiB, WS_PARTM = 980 * MiB, WS_WKRT = 1044 * MiB, WS_KR = 1045 * MiB, WS_END = 1047 * MiB;
constexpr int S_OUT = 4, S_MLP = 8;
constexpr int CW_BAR = 4096;

constexpr int LDS_BYTES = 147456;
constexpr int MISC_OFF = 143360;
constexpr int NWAVES = 8, NTHR = 512;

#define GAS __attribute__((address_space(1)))
#define LAS __attribute__((address_space(3)))
typedef unsigned short bf16;
typedef unsigned v4u __attribute__((ext_vector_type(4)));
typedef unsigned v2u __attribute__((ext_vector_type(2)));
typedef float f32x4 __attribute__((ext_vector_type(4)));
typedef float f32x16 __attribute__((ext_vector_type(16)));
typedef short bf16x8 __attribute__((ext_vector_type(8)));
#define LDS_WAIT() asm volatile("s_waitcnt lgkmcnt(0)" ::: "memory")
#define VM_WAIT() asm volatile("s_waitcnt vmcnt(0)" ::: "memory")

__device__ __forceinline__ unsigned pk2(float lo, float hi) { unsigned r; asm volatile("v_cvt_pk_bf16_f32 %0, %1, %2" : "=v"(r) : "v"(lo), "v"(hi)); return r; }
__device__ __forceinline__ float bflo(unsigned w) { return __uint_as_float(w << 16); }
__device__ __forceinline__ float bfhi(unsigned w) { return __uint_as_float(w & 0xffff0000u); }
__device__ __forceinline__ float bf2f(unsigned short b) { return __uint_as_float(((unsigned)b) << 16); }
__device__ __forceinline__ unsigned short f2bf(float f) { return (unsigned short)(pk2(f, 0.f) & 0xffffu); }
__device__ __forceinline__ float wave_sum(float v) {
#pragma unroll
    for (int o = 1; o < 64; o <<= 1) v += __shfl_xor(v, o);
    return v;
}
__device__ __forceinline__ float fexp2(float x) { return __builtin_amdgcn_exp2f(x); }
__device__ __forceinline__ int row_set(int r) { return r < RC ? 2 : ((r - RC) >> 12); }

#define XB_TMO      128
#define XB_XCNT(j)  (256  + 64 * (j))
#define XB_XSUB(j)  (1280 + 64 * (j))
#define XB_XGEN(j)  (2304 + 64 * (j))
#define XB_TOP      3328
#define XB_TOPGEN   3392
#define XCD_BAR_WORDS 3456
#define XB_SPIN_CAP (1u << 18)

__device__ __forceinline__ unsigned xb_ld(unsigned* p)              { return __hip_atomic_load(p, __ATOMIC_RELAXED, __HIP_MEMORY_SCOPE_AGENT); }
__device__ __forceinline__ unsigned xb_add(unsigned* p, unsigned v) { return __hip_atomic_fetch_add(p, v, __ATOMIC_RELAXED, __HIP_MEMORY_SCOPE_AGENT); }
__device__ __forceinline__ unsigned xb_xcc_id() { return (unsigned)__builtin_amdgcn_s_getreg((3 << 11) | 20) & 0xFu; }
#define XB_SPIN(cond, bar) do { unsigned _sp = 0; while (cond) { __builtin_amdgcn_s_sleep(1); \
    if ((++_sp & 255u) == 0u) { if (xb_ld(&(bar)[XB_TMO])) break; if (_sp > XB_SPIN_CAP) { atomicAdd(&(bar)[XB_TMO], 1u); break; } } } } while (0)

struct XcdBarrier {
    unsigned* bar; unsigned x;
    volatile LAS unsigned* st;
};

__device__ __forceinline__ XcdBarrier xcd_barrier_post(unsigned* bar, volatile LAS unsigned* st) {
    XcdBarrier b; b.bar = bar; b.x = xb_xcc_id(); b.st = st;
    if (threadIdx.x == 0) (void)xb_add(&bar[XB_XCNT(b.x)], 1u);
    return b;
}
__device__ __forceinline__ void xcd_barrier_complete(unsigned* bar, unsigned x, unsigned& nloc, unsigned& nx) {
    const unsigned G = gridDim.x * gridDim.y * gridDim.z;
    unsigned sum, cnt, mine, sp = 0u;
    for (;;) {
        sum = 0u; cnt = 0u; mine = 0u;
#pragma unroll
        for (unsigned j = 0; j < 16; ++j) { const unsigned c = xb_ld(&bar[XB_XCNT(j)]); sum += c; cnt += (c > 0u) ? 1u : 0u; mine = (j == x) ? c : mine; }
        if (sum == G) break;
        __builtin_amdgcn_s_sleep(1);
        if ((++sp & 255u) == 0u) { if (xb_ld(&bar[XB_TMO])) break; if (sp > XB_SPIN_CAP) { atomicAdd(&bar[XB_TMO], 1u); break; } }
    }
    nloc = mine > 0u ? mine : 1u; nx = cnt > 0u ? cnt : 1u;
}

__device__ __forceinline__ void xcd_barrier(const XcdBarrier& b) {
    asm volatile("s_waitcnt vmcnt(0)" ::: "memory");
    __syncthreads();
    if (threadIdx.x == 0) {
        unsigned* bar = b.bar;
        __builtin_amdgcn_s_waitcnt(0);
        unsigned nloc = b.st[0], nx = b.st[1];
        if (nloc == 0u) { xcd_barrier_complete(bar, b.x, nloc, nx); b.st[0] = nloc; b.st[1] = nx; }
        const unsigned old = xb_add(&bar[XB_XSUB(b.x)], 1u);
        const unsigned gen = old / nloc;
        if (old + 1u == (gen + 1u) * nloc) {
            __builtin_amdgcn_fence(__ATOMIC_RELEASE, "agent");
            asm volatile("s_waitcnt vmcnt(0)" ::: "memory");
            const unsigned og = xb_add(&bar[XB_TOP], 1u);
            const unsigned tg = og / nx;
            if (og + 1u == (tg + 1u) * nx) xb_add(&bar[XB_TOPGEN], 1u);
            else XB_SPIN(xb_ld(&bar[XB_TOPGEN]) == tg, bar);
            __builtin_amdgcn_fence(__ATOMIC_ACQUIRE, "agent");
            xb_add(&bar[XB_XGEN(b.x)], 1u);
            asm volatile("s_waitcnt vmcnt(0)" ::: "memory");
        } else {
            XB_SPIN(xb_ld(&bar[XB_XGEN(b.x)]) == gen, bar);
            __builtin_amdgcn_fence(__ATOMIC_ACQUIRE, "agent");
            asm volatile("s_waitcnt vmcnt(0)" ::: "memory");
        }
    }
    __syncthreads();
}

struct Args {
    const float *x, *c, *ctx, *c_ctx, *w_mod, *b_mod, *norm1_w, *norm2_w, *mlp_w1, *mlp_w2, *ev_w_in, *ev_decay, *ev_gn_w, *ev_sink, *ev_w_out,
                *od_w_in, *od_conv_w, *od_qn_w, *od_kvn_w, *od_w_uq, *od_w_ukv, *od_w_out, *norm_f;
    float* out; unsigned char* ws; int ph_lo, ph_hi;
};

__device__ __forceinline__ void unpack8(const v4u w, float (&f)[8]) {
#pragma unroll
    for (int i = 0; i < 4; ++i) { f[2 * i] = bflo(w[i]); f[2 * i + 1] = bfhi(w[i]); }
}
__device__ __forceinline__ v4u pack8(const float (&f)[8]) { v4u w; w.x = pk2(f[0], f[1]); w.y = pk2(f[2], f[3]); w.z = pk2(f[4], f[5]); w.w = pk2(f[6], f[7]); return w; }
__device__ __forceinline__ void ld8f(const float* p, float (&f)[8]) { const f32x4 a = *(const f32x4*)p, b = *(const f32x4*)(p + 4);
    f[0] = a.x; f[1] = a.y; f[2] = a.z; f[3] = a.w; f[4] = b.x; f[5] = b.y; f[6] = b.z; f[7] = b.w; }
__device__ __forceinline__ float lam_of(float log2_decay) { const float x = -fexp2(log2_decay);
    float s = -1.f / 8.f; s = s * x + 1.f / 7.f; s = s * x - 1.f / 6.f; s = s * x + 1.f / 5.f; s = s * x - 1.f / 4.f; s = s * x + 1.f / 3.f; s = s * x - 0.5f; s = s * x + 1.f; return s * x; }
__device__ __forceinline__ f32x4 mfma16(bf16x8 a, bf16x8 b, f32x4 c) { return __builtin_amdgcn_mfma_f32_16x16x32_bf16(a, b, c, 0, 0, 0); }
__device__ __forceinline__ f32x16 mfma32(bf16x8 a, bf16x8 b, f32x16 c) { return __builtin_amdgcn_mfma_f32_32x32x16_bf16(a, b, c, 0, 0, 0); }

struct P0Item { const float* W; bf16* WT; int K, N, item; };
__device__ __forceinline__ void p0_item_load(const P0Item& d, int lane, float (&ld)[32]) {
    const int nblk = d.N / 32, kb = d.item / nblk, nb = d.item % nblk; const float* src = d.W + (size_t)(64 * kb + (lane >> 5)) * d.N + 32 * nb + (lane & 31);
#pragma unroll
    for (int i = 0; i < 32; ++i) ld[i] = __builtin_nontemporal_load(src + (size_t)(2 * i) * d.N);
}
__device__ __forceinline__ void p0_item_finish(const P0Item& d, int lane, const float (&ld)[32], LAS float* scr) {
    const int nblk = d.N / 32, kb = d.item / nblk, nb = d.item % nblk, k0 = 64 * kb, n0 = 32 * nb;
#pragma unroll
    for (int i = 0; i < 32; ++i) scr[(2 * i + (lane >> 5)) * 33 + (lane & 31)] = ld[i];
    LDS_WAIT(); asm volatile("" ::: "memory");
    const int c = lane & 7;
#pragma unroll
    for (int j = 0; j < 4; ++j) { const int n = (lane >> 3) + 8 * j; const LAS float* s = scr + (8 * c) * 33 + n;
        v4u o; o.x = pk2(s[0 * 33], s[1 * 33]); o.y = pk2(s[2 * 33], s[3 * 33]); o.z = pk2(s[4 * 33], s[5 * 33]); o.w = pk2(s[6 * 33], s[7 * 33]);
        __builtin_nontemporal_store(o, (GAS v4u*)(d.WT + (size_t)(n0 + n) * d.K + k0 + 8 * c)); }
    LDS_WAIT(); asm volatile("" ::: "memory");
}
struct ProIn { const float *x, *c, *ctx, *c_ctx, *w_mod, *b_mod, *mlp_w1, *mlp_w2, *ev_w_in, *ev_w_out, *od_w_in, *od_w_out, *od_w_uq, *od_w_ukv; };
__device__ __forceinline__ void ph_prologue(const ProIn a, unsigned char* ws, LAS unsigned char* lds, int tid, int wave, int lane, int wg, int G) {
    float* mod = (float*)(ws + WS_MOD);
    for (int u = wg; u < 192; u += G) {
        LAS float* sl = (LAS float*)lds;
        LAS float* red = (LAS float*)(lds + 24576);
        for (int i = tid; i < 3 * DM; i += NTHR) { const int s = i >> 11, k = i & 2047; const float cv = (s < 2) ? a.c[s * DM + k] : a.c_ctx[k]; sl[i] = cv / (1.f + __expf(-cv)); }
        __syncthreads();
        const int l = u / 48, j0 = (u % 48) * 256;
        const float* wp = a.w_mod + ((size_t)l * DM + wave * 256) * 12288 + j0 + 4 * lane;
        f32x4 a0 = {0.f, 0.f, 0.f, 0.f}, a1 = a0, a2 = a0;
#pragma unroll 8
        for (int k = 0; k < 256; ++k) { const f32x4 w = *(const f32x4*)(wp + (size_t)k * 12288); const int kk = wave * 256 + k;
            a0 += sl[kk] * w; a1 += sl[DM + kk] * w; a2 += sl[2 * DM + kk] * w; }
        *(LAS f32x4*)(red + (wave * 3 + 0) * 256 + 4 * lane) = a0; *(LAS f32x4*)(red + (wave * 3 + 1) * 256 + 4 * lane) = a1; *(LAS f32x4*)(red + (wave * 3 + 2) * 256 + 4 * lane) = a2;
        __syncthreads();
        for (int i = tid; i < 768; i += NTHR) { const int s = i >> 8, col = i & 255; float v = a.b_mod[l * 12288 + j0 + col];
#pragma unroll
            for (int w = 0; w < 8; ++w) v += red[(w * 3 + s) * 256 + col];
            mod[(size_t)(l * 3 + s) * 12288 + j0 + col] = v; }
        __syncthreads();
    }
    {
        LAS float* scr = (LAS float*)(lds + wave * 16384);
        const int gw = wg * NWAVES + wave, NGW = G * NWAVES;
        constexpr int I_W1 = 32 * 256, I_W2 = 128 * 64, I_EI = 32 * 176, I_EO = 32 * 64, I_OI = 32 * 122, I_OO = 32 * 64, I_UQ = 8 * 48, I_UKV = 4 * 64;
        constexpr int NIT = 4 * I_W1 + 4 * I_W2 + 2 * (I_EI + I_EO + I_OI + I_OO + I_UQ + I_UKV);
#define P0_DECODE(it_, d) do { int r = (it_); \
            if (r < 4 * I_W1) { const int l = r / I_W1; d = P0Item{a.mlp_w1 + (size_t)l * DM * DFF, (bf16*)(ws + WS_W1T) + (size_t)l * DFF * DM, DM, DFF, r % I_W1}; break; } r -= 4 * I_W1; \
            if (r < 4 * I_W2) { const int l = r / I_W2; d = P0Item{a.mlp_w2 + (size_t)l * DFF * DM, (bf16*)(ws + WS_W2T) + (size_t)l * DM * DFF, DFF, DM, r % I_W2}; break; } r -= 4 * I_W2; \
            if (r < 2 * I_EI) { const int l = r / I_EI; d = P0Item{a.ev_w_in + (size_t)l * DM * EV_IN, (bf16*)(ws + WS_EWIN) + (size_t)l * EV_IN * DM, DM, EV_IN, r % I_EI}; break; } r -= 2 * I_EI; \
            if (r < 2 * I_EO) { const int l = r / I_EO; d = P0Item{a.ev_w_out + (size_t)l * DM * DM, (bf16*)(ws + WS_EWOUT) + (size_t)l * DM * DM, DM, DM, r % I_EO}; break; } r -= 2 * I_EO; \
            if (r < 2 * I_OI) { const int l = r / I_OI, it2 = r % I_OI, nb = it2 % 122;     \
                bf16* dst = nb < 120 ? (bf16*)(ws + WS_OWIN) + (size_t)l * OD_INP * DM : (bf16*)(ws + WS_WKRT) + (size_t)l * 64 * DM - (size_t)OD_INP * DM; \
                d = P0Item{a.od_w_in + (size_t)l * DM * OD_IN, dst, DM, OD_IN, it2}; break; } r -= 2 * I_OI; \
            if (r < 2 * I_OO) { const int l = r / I_OO; d = P0Item{a.od_w_out + (size_t)l * DM * DM, (bf16*)(ws + WS_OWOUT) + (size_t)l * DM * DM, DM, DM, r % I_OO}; break; } r -= 2 * I_OO; \
            if (r < 2 * I_UQ) { const int l = r / I_UQ; d = P0Item{a.od_w_uq + (size_t)l * 512 * 1536, (bf16*)(ws + WS_UQT) + (size_t)l * 1536 * 512, 512, 1536, r % I_UQ}; break; } r -= 2 * I_UQ; \
            { const int l = r / I_UKV; d = P0Item{a.od_w_ukv + (size_t)l * 256 * 2048, (bf16*)(ws + WS_UKVT) + (size_t)l * 2048 * 256, 256, 2048, r % I_UKV}; } } while (0)
        P0Item dA, dB; float ldA[32], ldB[32];
        int it = gw;
        if (it < NIT) { P0_DECODE(it, dA); p0_item_load(dA, lane, ldA); }
        while (it < NIT) {
            if (it + NGW < NIT) { P0_DECODE(it + NGW, dB); p0_item_load(dB, lane, ldB); }
            p0_item_finish(dA, lane, ldA, scr);
            it += NGW;
            if (it >= NIT) break;
            if (it + NGW < NIT) { P0_DECODE(it + NGW, dA); p0_item_load(dA, lane, ldA); }
            p0_item_finish(dB, lane, ldB, scr);
            it += NGW;
        }
#undef P0_DECODE
    }
    const int gt = wg * NTHR + tid, NGT = G * NTHR;
    {
        const double INV2PI = 0.15915494309189533576888;
        const float L2B = 13.287712379549449f;
        float* t1c = (float*)(ws + WS_T1C); float* t1s = (float*)(ws + WS_T1S);
        for (int i = gt; i < TL * 64; i += NGT) { const int pos = i >> 6, f = i & 63; const float inv = fexp2(-(float)(2 * f) / 128.f * L2B); const float ang = (float)pos * inv;
            double rev = (double)ang * INV2PI; rev -= __builtin_rint(rev); const float fr = (float)rev; t1c[i] = __builtin_amdgcn_cosf(fr); t1s[i] = __builtin_amdgcn_sinf(fr); }
        float* t2c = (float*)(ws + WS_T2); float* t2s = t2c + 64 * 32; float* t3c = t2s + 64 * 32; float* t3s = t3c + 64 * 16;
        for (int i = gt; i < 64 * 32; i += NGT) { const int pos = i >> 5, f = i & 31; const float inv = fexp2(-(float)(2 * f) / 64.f * L2B); const float ang = (float)pos * inv;
            double rev = (double)ang * INV2PI; rev -= __builtin_rint(rev); const float fr = (float)rev; t2c[i] = __builtin_amdgcn_cosf(fr); t2s[i] = __builtin_amdgcn_sinf(fr); }
        for (int i = gt; i < 64 * 16; i += NGT) { const int pos = i >> 4, f = i & 15; const float inv = fexp2(-(float)(2 * f) / 32.f * L2B); const float ang = (float)pos * inv;
            double rev = (double)ang * INV2PI; rev -= __builtin_rint(rev); const float fr = (float)rev; t3c[i] = __builtin_amdgcn_cosf(fr); t3s[i] = __builtin_amdgcn_sinf(fr); }
    }
}

__device__ __forceinline__ void ph_norm(bool src32, const float* Hc, const float* Hx, const bf16* Hb, const float* nw, const float* mod_l, int ch_sh, int ch_sc, bf16* A, int row_lo, LAS unsigned char* lds, int tid, int gw, int NGW, int lane) {
    LAS float* comb = (LAS float*)(lds + 1024);
    for (int i = tid; i < 3 * DM; i += NTHR) { const int set = i >> 11, col = i & 2047; comb[(set * 2 + 0) * DM + col] = nw[col] * (1.f + mod_l[(size_t)(set * 6 + ch_sc) * DM + col]); comb[(set * 2 + 1) * DM + col] = mod_l[(size_t)(set * 6 + ch_sh) * DM + col]; }
    __syncthreads();
#define NORM_ROW_OUT(vv, r_) do { float ss = 0.f; \
        _Pragma("unroll") for (int j = 0; j < 8; ++j) ss += (vv[j].x * vv[j].x + vv[j].y * vv[j].y) + (vv[j].z * vv[j].z + vv[j].w * vv[j].w); \
        ss = wave_sum(ss); \
        const float rs = 1.f / sqrtf(ss * (1.f / DM) + EPS); \
        const LAS float* ca = comb + (row_set(r_) * 2) * DM; const LAS float* cb = ca + DM; \
        v2u* o = (v2u*)(A + (size_t)(r_) * DM) + lane; \
        _Pragma("unroll") for (int j = 0; j < 8; ++j) { const int col = 256 * j + 4 * lane; const f32x4 w = *(const LAS f32x4*)(ca + col), t = *(const LAS f32x4*)(cb + col); \
            const f32x4 y = (vv[j] * rs) * w + t; v2u q; q.x = pk2(y.x, y.y); q.y = pk2(y.z, y.w); o[64 * j] = q; } } while (0)
    if (src32) {
        for (int r0 = row_lo + gw; r0 < RALL; r0 += 2 * NGW) {
            f32x4 va[8], vb[8]; const int r1 = r0 + NGW; const bool h1 = r1 < RALL;
            { const f32x4* xr = (const f32x4*)(r0 < RC ? Hc + (size_t)r0 * DM : Hx + (size_t)(r0 - RC) * DM) + lane;
#pragma unroll
              for (int j = 0; j < 8; ++j) va[j] = xr[64 * j]; }
            if (h1) { const f32x4* xr = (const f32x4*)(r1 < RC ? Hc + (size_t)r1 * DM : Hx + (size_t)(r1 - RC) * DM) + lane;
#pragma unroll
              for (int j = 0; j < 8; ++j) vb[j] = xr[64 * j]; }
            NORM_ROW_OUT(va, r0);
            if (h1) NORM_ROW_OUT(vb, r1);
        }
    } else {
        for (int r0 = row_lo + gw; r0 < RALL; r0 += 5 * NGW) {
            v2u pk[5][8];
#pragma unroll
            for (int b = 0; b < 5; ++b) { const int r = r0 + b * NGW; if (r < RALL) { const v2u* xr = (const v2u*)(Hb + (size_t)r * DM) + lane;
#pragma unroll
                for (int j = 0; j < 8; ++j) pk[b][j] = xr[64 * j]; } }
#pragma unroll
            for (int b = 0; b < 5; ++b) { const int r = r0 + b * NGW; if (r < RALL) { f32x4 v[8];
#pragma unroll
                for (int j = 0; j < 8; ++j) v[j] = (f32x4){bflo(pk[b][j].x), bfhi(pk[b][j].x), bflo(pk[b][j].y), bfhi(pk[b][j].y)};
                NORM_ROW_OUT(v, r); } }
        }
    }
#undef NORM_ROW_OUT
    __syncthreads();
}
template <int NPART> __device__ __forceinline__ void ph_norm_ctx(const float* Hin32, bf16* H, const float* nw, const float* mod_l, int ch_sh, int ch_sc, bf16* A, const bf16* part, const float* pgate, LAS unsigned char* lds, int tid, int wave, int lane, int wg, int G) {
    LAS float* red = (LAS float*)lds;
    const float* sh = mod_l + (size_t)(2 * 6 + ch_sh) * DM; const float* sc = mod_l + (size_t)(2 * 6 + ch_sc) * DM;
    const int col = 256 * wave + 4 * lane;
    for (int r = wg; r < RC; r += G) {
        f32x4 h;
        if (Hin32) h = *(const f32x4*)(Hin32 + (size_t)r * DM + col);
        else { const v2u w = *(const v2u*)(H + (size_t)r * DM + col); h = (f32x4){bflo(w.x), bfhi(w.x), bflo(w.y), bfhi(w.y)}; }
        f32x4 acc = {0.f, 0.f, 0.f, 0.f};
        v2u pw[NPART];
#pragma unroll
        for (int s = 0; s < NPART; ++s) pw[s] = *(const v2u*)(part + ((size_t)s * RC + r) * DM + col);
#pragma unroll
        for (int s = 0; s < NPART; ++s) acc += (f32x4){bflo(pw[s].x), bfhi(pw[s].x), bflo(pw[s].y), bfhi(pw[s].y)};
        h += *(const f32x4*)(pgate + col) * acc;
        { v2u w; w.x = pk2(h.x, h.y); w.y = pk2(h.z, h.w); *(v2u*)(H + (size_t)r * DM + col) = w;
          h = (f32x4){bflo(w.x), bfhi(w.x), bflo(w.y), bfhi(w.y)}; }
        float ss = wave_sum((h.x * h.x + h.y * h.y) + (h.z * h.z + h.w * h.w));
        if (lane == 0) red[wave] = ss;
        __syncthreads();
        float tot = 0.f;
#pragma unroll
        for (int w = 0; w < 8; ++w) tot += red[w];
        __syncthreads();
        const float rs = 1.f / sqrtf(tot * (1.f / DM) + EPS);
        const f32x4 w4 = *(const f32x4*)(nw + col), s4 = *(const f32x4*)(sc + col), t4 = *(const f32x4*)(sh + col);
        const f32x4 y = (h * rs) * w4 * (s4 + 1.f) + t4; v2u q; q.x = pk2(y.x, y.y); q.y = pk2(y.z, y.w);
        *(v2u*)(A + (size_t)r * DM + col) = q;
    }
}
__device__ __forceinline__ void ph_final(const bf16* H, const float* nw, float* out, int gw, int NGW, int lane) {
    f32x4 wv[8];
#pragma unroll
    for (int j = 0; j < 8; ++j) wv[j] = *(const f32x4*)(nw + 256 * j + 4 * lane);
    for (int r0 = gw; r0 < NB * TL; r0 += 4 * NGW) {
        v2u pk[4][8];
#pragma unroll
        for (int b = 0; b < 4; ++b) { const int r = r0 + b * NGW; if (r < NB * TL) { const v2u* xr = (const v2u*)(H + (size_t)(RC + r) * DM) + lane;
#pragma unroll
            for (int j = 0; j < 8; ++j) pk[b][j] = xr[64 * j]; } }
#pragma unroll
        for (int b = 0; b < 4; ++b) { const int r = r0 + b * NGW; if (r < NB * TL) { f32x4 v[8]; float ss = 0.f;
#pragma unroll
            for (int j = 0; j < 8; ++j) { v[j] = (f32x4){bflo(pk[b][j].x), bfhi(pk[b][j].x), bflo(pk[b][j].y), bfhi(pk[b][j].y)}; ss += (v[j].x * v[j].x + v[j].y * v[j].y) + (v[j].z * v[j].z + v[j].w * v[j].w); }
            ss = wave_sum(ss);
            const float rs = 1.f / sqrtf(ss * (1.f / DM) + EPS);
            f32x4* o = (f32x4*)(out + (size_t)r * DM) + lane;
#pragma unroll
            for (int j = 0; j < 8; ++j) o[64 * j] = (v[j] * rs) * wv[j]; } }
    }
}

__device__ __forceinline__ void vt_tile(const bf16* src, int ld_src, bf16* dst, LAS unsigned char* scr, int lane) {
#pragma unroll
    for (int it = 0; it < 8; ++it) { const int key = it * 8 + (lane >> 3), pc = lane & 7;
        const v4u w = *(const v4u*)(src + (size_t)key * ld_src + pc * 8); *(LAS v4u*)(scr + key * 144 + pc * 16) = w; }
    LDS_WAIT(); asm volatile("" ::: "memory");
#pragma unroll
    for (int q = 0; q < 8; ++q) { unsigned e[8];
#pragma unroll
        for (int i = 0; i < 8; ++i) e[i] = *(const LAS unsigned short*)(scr + (16 * (q >> 1) + 4 * (q & 1) + 8 * (i >> 2) + (i & 3)) * 144 + lane * 2);
        v4u w; w.x = e[0] | (e[1] << 16); w.y = e[2] | (e[3] << 16); w.z = e[4] | (e[5] << 16); w.w = e[6] | (e[7] << 16);
        *(v4u*)(dst + (size_t)lane * NKEY + 8 * q) = w; }
    LDS_WAIT(); asm volatile("" ::: "memory");
}
__device__ __forceinline__ int key_row(int b, int kk) { return kk < TC ? b * TC + kk : RC + b * TL + (kk - TC); }

__device__ __forceinline__ void post_win_tile(unsigned char* ws, LAS unsigned char* lds, int pm, int pn, int tid, int wave, int lane) {
    bf16* prj = (bf16*)(ws + WS_PRJ);
    if (pn >= 16 && pn <= 20) {
        if (pm < 2) return;
        const float* t2c = (const float*)(ws + WS_T2); const float* t2s = t2c + 64 * 32;
        for (int idx0 = tid; idx0 < 256 * 16; idx0 += 4 * NTHR) {
            v4u w1[4], w2[4]; bf16* bp[4]; int tb[4];
#pragma unroll
            for (int q = 0; q < 4; ++q) { const int idx = idx0 + q * NTHR; const int p = idx & 3, half = (idx >> 2) & 1, hh = (idx >> 3) & 1, i = idx >> 4;
                const int r = pm * 256 + i, t = (r - RC) & (TL - 1), posv = half ? (t & 63) : (t >> 6);
                bp[q] = prj + (size_t)r * EV_IN + 256 * pn + hh * 128 + half * 64 + 8 * p; tb[q] = posv * 32 + 8 * p;
                w1[q] = *(const v4u*)bp[q]; w2[q] = *(const v4u*)(bp[q] + 32); }
#pragma unroll
            for (int q = 0; q < 4; ++q) { float x1[8], x2[8], cs[8], sn[8], o1[8], o2[8];
                unpack8(w1[q], x1); unpack8(w2[q], x2); ld8f(t2c + tb[q], cs); ld8f(t2s + tb[q], sn);
#pragma unroll
                for (int e = 0; e < 8; ++e) { o1[e] = x1[e] * cs[e] - x2[e] * sn[e]; o2[e] = x2[e] * cs[e] + x1[e] * sn[e]; }
                *(v4u*)bp[q] = pack8(o1); *(v4u*)(bp[q] + 32) = pack8(o2); }
        }
    } else if (pn == 21) {
        bf16* vtw = (bf16*)(ws + WS_VTW); LAS unsigned char* scr = lds + wave * 16384;
        const int b = pm < 2 ? pm : ((pm - 2) >> 4), kt0 = pm < 2 ? 0 : 4 + ((pm - 2) & 15) * 4;
        for (int q = 0; q < 2; ++q) { const int it = wave * 2 + q, dvh = it & 1, kvh = (it >> 1) & 1, kt = kt0 + (it >> 2);
            const int row0 = key_row(b, 64 * kt);
            vt_tile(prj + (size_t)row0 * EV_IN + E_VW + kvh * 128 + dvh * 64, EV_IN, vtw + ((size_t)(b * 2 + kvh) * 128 + dvh * 64) * NKEY + 64 * kt, scr, lane); }
    }
}

__device__ __forceinline__ void ret_kv_unit(unsigned char* ws, const float* dec, LAS unsigned char* lds, int tid, int wave, int lane, int u) {
    const int bh = u / NCH, c = u % NCH, b = bh >> 3, h = bh & 7;
    const bool isctx = c < 2;
    const int row0 = isctx ? b * TC + c * 128 : RC + b * TL + (c - 2) * 128, pos0 = isctx ? 0 : (c - 2) * 128;
    const bf16* prj = (const bf16*)(ws + WS_PRJ);
    const float* t1c = (const float*)(ws + WS_T1C); const float* t1s = (const float*)(ws + WS_T1S);
    const float lf2 = lam_of(dec[h]) * LOG2E, lb2 = lam_of(dec[8 + h]) * LOG2E;
    LAS bf16* KTf = (LAS bf16*)lds; LAS bf16* KTb = KTf + 128 * 136; LAS bf16* VTs = KTb + 128 * 136;
    for (int it = tid; it < 1024; it += NTHR) { const int t = it & 127, p = it >> 7;
        const bf16* kr = prj + (size_t)(row0 + t) * EV_IN + E_KR + h * 128 + 8 * p;
        float x1[8], x2[8]; unpack8(*(const v4u*)kr, x1); unpack8(*(const v4u*)(kr + 64), x2);
        if (!isctx) { float cs[8], sn[8]; ld8f(t1c + (size_t)(pos0 + t) * 64 + 8 * p, cs); ld8f(t1s + (size_t)(pos0 + t) * 64 + 8 * p, sn);
#pragma unroll
            for (int e = 0; e < 8; ++e) { const float a1 = x1[e] * cs[e] - x2[e] * sn[e], a2 = x2[e] * cs[e] + x1[e] * sn[e]; x1[e] = a1; x2[e] = a2; } }
        const float ft = fexp2(lf2 * (float)(127 - t)), bt = fexp2(lb2 * (float)t);
#pragma unroll
        for (int e = 0; e < 8; ++e) { KTf[(8 * p + e) * 136 + t] = f2bf(x1[e] * ft); KTf[(64 + 8 * p + e) * 136 + t] = f2bf(x2[e] * ft);
            KTb[(8 * p + e) * 136 + t] = f2bf(x1[e] * bt); KTb[(64 + 8 * p + e) * 136 + t] = f2bf(x2[e] * bt); }
    }
    for (int it = tid; it < 2048; it += NTHR) { const int t = it & 127, p = it >> 7;
        const v4u w = *(const v4u*)(prj + (size_t)(row0 + t) * EV_IN + E_VR + h * 128 + 8 * p);
#pragma unroll
        for (int i = 0; i < 4; ++i) { VTs[(8 * p + 2 * i) * 136 + t] = (bf16)(w[i] & 0xffffu); VTs[(8 * p + 2 * i + 1) * 136 + t] = (bf16)(w[i] >> 16); }
    }
    __syncthreads();
    const int dir = wave >> 2, dvb = (wave & 3) * 32, fr = lane & 15, fq = lane >> 4;
    const LAS bf16* KT = dir ? KTb : KTf;
    f32x4 acc[2][8];
#pragma unroll
    for (int m = 0; m < 2; ++m)
#pragma unroll
        for (int n = 0; n < 8; ++n) acc[m][n] = (f32x4){0.f, 0.f, 0.f, 0.f};
#pragma unroll
    for (int s = 0; s < 4; ++s) {
        bf16x8 af[2];
#pragma unroll
        for (int m = 0; m < 2; ++m) af[m] = *(const LAS bf16x8*)(VTs + (dvb + 16 * m + fr) * 136 + 32 * s + 8 * fq);
#pragma unroll
        for (int n = 0; n < 8; ++n) { const bf16x8 bfr = *(const LAS bf16x8*)(KT + (16 * n + fr) * 136 + 32 * s + 8 * fq);
#pragma unroll
            for (int m = 0; m < 2; ++m) acc[m][n] = mfma16(af[m], bfr, acc[m][n]); }
    }
    float* o = (float*)(ws + WS_KVST) + ((size_t)(dir * 16 + bh) * NCH + c) * 16384;
#pragma unroll
    for (int m = 0; m < 2; ++m)
#pragma unroll
        for (int n = 0; n < 8; ++n)
#pragma unroll
            for (int r = 0; r < 4; ++r) o[(dvb + 16 * m + 4 * fq + r) * 128 + 16 * n + fr] = acc[m][n][r];
    __syncthreads();
}
__device__ __forceinline__ void ph_ret_scan(unsigned char* ws, const float* dec, int tid, int wg, int G) {
    for (int w = wg; w < 256; w += G) {
        const int s = w >> 3, slice = w & 7, dir = s >> 4, bh = s & 15, h = bh & 7;
        const float g = fexp2(lam_of(dec[dir * 8 + h]) * LOG2E * 128.f);
        const size_t e0 = (size_t)slice * 2048 + tid * 4;
        const float* kv = (const float*)(ws + WS_KVST) + (size_t)(dir * 16 + bh) * NCH * 16384 + e0;
        bf16* st = (bf16*)(ws + WS_ST) + (size_t)(dir * 16 + bh) * NCH * 16384 + e0;
        f32x4 S = {0.f, 0.f, 0.f, 0.f};
#pragma unroll
        for (int half = 0; half < 2; ++half) {
            f32x4 buf[17];
#pragma unroll
            for (int i = 0; i < 17; ++i) { const int k = half * 17 + i; const int c = dir ? (k == 0 ? 1 : (k == 1 ? 0 : 35 - k)) : k; buf[i] = *(const f32x4*)(kv + (size_t)c * 16384); }
#pragma unroll
            for (int i = 0; i < 17; ++i) { const int k = half * 17 + i; const int c = dir ? (k == 0 ? 1 : (k == 1 ? 0 : 35 - k)) : k;
                v2u q; q.x = pk2(S.x, S.y); q.y = pk2(S.z, S.w); *(v2u*)(st + (size_t)c * 16384) = q; S = S * g + buf[i]; }
        }
    }
}
__device__ __forceinline__ void ret_out_unit(unsigned char* ws, const float* dec, const float* gnw, LAS unsigned char* lds, int tid, int wave, int lane, int u) {
    const int bh = u / NCH, c = u % NCH, b = bh >> 3, h = bh & 7;
    const bool isctx = c < 2;
    const int row0 = isctx ? b * TC + c * 128 : RC + b * TL + (c - 2) * 128, pos0 = isctx ? 0 : (c - 2) * 128;
    const bf16* prj = (const bf16*)(ws + WS_PRJ);
    const float* t1c = (const float*)(ws + WS_T1C); const float* t1s = (const float*)(ws + WS_T1S);
    const float lf2 = lam_of(dec[h]) * LOG2E, lb2 = lam_of(dec[8 + h]) * LOG2E;
    const float scale = 0.088388347648318440f;
    LAS bf16* Qs = (LAS bf16*)lds; LAS bf16* Ks = Qs + 128 * 136; LAS bf16* VTs = Ks + 128 * 136; LAS bf16* Ps = VTs + 128 * 136;
    for (int it = tid; it < 1024; it += NTHR) { const int t = it >> 3, p = it & 7;
        const bf16* qr = prj + (size_t)(row0 + t) * EV_IN + E_QR + h * 128 + 8 * p; const bf16* kr = qr + (E_KR - E_QR);
        float q1[8], q2[8], k1[8], k2[8]; unpack8(*(const v4u*)qr, q1); unpack8(*(const v4u*)(qr + 64), q2); unpack8(*(const v4u*)kr, k1); unpack8(*(const v4u*)(kr + 64), k2);
        if (!isctx) { float cs[8], sn[8]; ld8f(t1c + (size_t)(pos0 + t) * 64 + 8 * p, cs); ld8f(t1s + (size_t)(pos0 + t) * 64 + 8 * p, sn);
#pragma unroll
            for (int e = 0; e < 8; ++e) { const float a1 = q1[e] * cs[e] - q2[e] * sn[e], a2 = q2[e] * cs[e] + q1[e] * sn[e]; q1[e] = a1; q2[e] = a2;
                const float b1 = k1[e] * cs[e] - k2[e] * sn[e], b2 = k2[e] * cs[e] + k1[e] * sn[e]; k1[e] = b1; k2[e] = b2; } }
        *(LAS v4u*)(Qs + t * 136 + 8 * p) = pack8(q1); *(LAS v4u*)(Qs + t * 136 + 64 + 8 * p) = pack8(q2);
        *(LAS v4u*)(Ks + t * 136 + 8 * p) = pack8(k1); *(LAS v4u*)(Ks + t * 136 + 64 + 8 * p) = pack8(k2);
    }
    for (int it = tid; it < 2048; it += NTHR) { const int t = it & 127, p = it >> 7;
        const v4u w = *(const v4u*)(prj + (size_t)(row0 + t) * EV_IN + E_VR + h * 128 + 8 * p);
#pragma unroll
        for (int i = 0; i < 4; ++i) { VTs[(8 * p + 2 * i) * 136 + t] = (bf16)(w[i] & 0xffffu); VTs[(8 * p + 2 * i + 1) * 136 + t] = (bf16)(w[i] >> 16); }
    }
    __syncthreads();
    v4u streg[2][4];
    { const bf16* st0 = (const bf16*)(ws + WS_ST) + ((size_t)bh * NCH + c) * 16384;
#pragma unroll
      for (int dir = 0; dir < 2; ++dir)
#pragma unroll
          for (int j = 0; j < 4; ++j) streg[dir][j] = *(const v4u*)(st0 + (size_t)dir * 16 * NCH * 16384 + (size_t)(tid + NTHR * j) * 8); }
    const int i0 = 16 * wave, fr = lane & 15, fq = lane >> 4;
    bf16x8 qa[4];
#pragma unroll
    for (int s = 0; s < 4; ++s) qa[s] = *(const LAS bf16x8*)(Qs + (i0 + fr) * 136 + 32 * s + 8 * fq);
#pragma unroll
    for (int n = 0; n < 8; ++n) { f32x4 sa = {0.f, 0.f, 0.f, 0.f};
#pragma unroll
        for (int s = 0; s < 4; ++s) { const bf16x8 kb = *(const LAS bf16x8*)(Ks + (16 * n + fr) * 136 + 32 * s + 8 * fq); sa = mfma16(qa[s], kb, sa); }
#pragma unroll
        for (int r = 0; r < 4; ++r) { const int d = (i0 + 4 * fq + r) - (16 * n + fr);
            const float dcy = d >= 0 ? fexp2(lf2 * (float)d) : fexp2(lb2 * (float)(-d));
            Ps[(i0 + 4 * fq + r) * 136 + 16 * n + fr] = f2bf(sa[r] * scale * dcy); }
    }
    LDS_WAIT(); asm volatile("" ::: "memory");
    f32x4 O[8];
#pragma unroll
    for (int n = 0; n < 8; ++n) O[n] = (f32x4){0.f, 0.f, 0.f, 0.f};
#pragma unroll
    for (int s = 0; s < 4; ++s) { const bf16x8 pa = *(const LAS bf16x8*)(Ps + (i0 + fr) * 136 + 32 * s + 8 * fq);
#pragma unroll
        for (int n = 0; n < 8; ++n) { const bf16x8 vb = *(const LAS bf16x8*)(VTs + (16 * n + fr) * 136 + 32 * s + 8 * fq); O[n] = mfma16(pa, vb, O[n]); } }
    __syncthreads();
#pragma unroll
    for (int dir = 0; dir < 2; ++dir)
#pragma unroll
        for (int j = 0; j < 4; ++j) { const int e = (tid + NTHR * j) * 8, dvr = e >> 7, dkc = e & 127; *(LAS v4u*)((dir ? Qs : Ks) + dvr * 136 + dkc) = streg[dir][j]; }
    __syncthreads();
#pragma unroll
    for (int dir = 0; dir < 2; ++dir) {
        const LAS bf16* st = dir ? Qs : Ks;
        f32x4 T[8];
#pragma unroll
        for (int n = 0; n < 8; ++n) T[n] = (f32x4){0.f, 0.f, 0.f, 0.f};
#pragma unroll
        for (int s = 0; s < 4; ++s)
#pragma unroll
            for (int n = 0; n < 8; ++n) { const bf16x8 sb = *(const LAS bf16x8*)(st + (16 * n + fr) * 136 + 32 * s + 8 * fq); T[n] = mfma16(qa[s], sb, T[n]); }
#pragma unroll
        for (int r = 0; r < 4; ++r) { const int il = i0 + 4 * fq + r; const float fac = scale * (dir == 0 ? fexp2(lf2 * (float)(il + 1)) : fexp2(lb2 * (float)(128 - il)));
#pragma unroll
            for (int n = 0; n < 8; ++n) O[n][r] += T[n][r] * fac; }
    }
    bf16* mix = (bf16*)(ws + WS_MIX);
    unsigned short gtv[4][8]; float gw8[8];
#pragma unroll
    for (int n = 0; n < 8; ++n) gw8[n] = gnw[h * 128 + 16 * n + fr];
#pragma unroll
    for (int r = 0; r < 4; ++r)
#pragma unroll
        for (int n = 0; n < 8; ++n) gtv[r][n] = prj[(size_t)(row0 + i0 + 4 * fq + r) * EV_IN + E_GR + h * 128 + 16 * n + fr];
#pragma unroll
    for (int r = 0; r < 4; ++r) {
        float s1 = 0.f;
#pragma unroll
        for (int n = 0; n < 8; ++n) s1 += O[n][r];
        s1 += __shfl_xor(s1, 1); s1 += __shfl_xor(s1, 2); s1 += __shfl_xor(s1, 4); s1 += __shfl_xor(s1, 8);
        const float mu = s1 * (1.f / 128.f);
        float s2 = 0.f;
#pragma unroll
        for (int n = 0; n < 8; ++n) { const float d = O[n][r] - mu; s2 += d * d; }
        s2 += __shfl_xor(s2, 1); s2 += __shfl_xor(s2, 2); s2 += __shfl_xor(s2, 4); s2 += __shfl_xor(s2, 8);
        const float rstd = 1.f / sqrtf(s2 * (1.f / 128.f) + EPS);
        const int row = row0 + i0 + 4 * fq + r;
#pragma unroll
        for (int n = 0; n < 8; ++n) { const int dv = 16 * n + fr; const float gt = bf2f(gtv[r][n]);
            const float y = (O[n][r] - mu) * rstd * gw8[n] * (gt / (1.f + __expf(-gt)));
            mix[(size_t)row * DM + h * 128 + dv] = f2bf(y); }
    }
    __syncthreads();
}

template <int DQK, bool WINDOW, bool SINK>
__device__ __forceinline__ void attn_unit(LAS unsigned char* lds, int tid, int wave, int lane,
        const bf16* Qp, int ldq, const bf16* Kc, const bf16* Kl, int ldk, const bf16* K2c, const bf16* K2l, int ldk2, const bf16* VT,
        int nctx, int tlo, int thi, int q0, float sc_log2, float sink_log2, bf16* Op, int ldo) {
    constexpr int KS = DQK * 2 + 16, KT_BYTES = 64 * KS, VS = 144, VT_BYTES = 128 * VS, BUF = KT_BYTES + VT_BYTES;
    constexpr int NS = DQK / 16, KPT = DQK / 64;
    const int c = lane & 31, h = lane >> 5;
    bf16x8 qf[NS];
    { const bf16* qr = Qp + (size_t)(wave * 32 + c) * ldq + 8 * h;
#pragma unroll
      for (int s = 0; s < NS; ++s) qf[s] = *(const bf16x8*)(qr + 16 * s); }
    f32x16 oT[4];
#pragma unroll
    for (int dt = 0; dt < 4; ++dt)
#pragma unroll
        for (int r = 0; r < 16; ++r) oT[dt][r] = 0.f;
    float m_run = SINK ? sink_log2 : -1e30f, l_run = (SINK && h == 0) ? 1.f : 0.f;
    const int ntile = nctx + (thi - tlo);
    v4u kregA[KPT], vregA[2], kregB[KPT], vregB[2];
    const unsigned koff0 = (unsigned)((tid >> 4) * ldk + (tid & 15) * 8), koff1 = koff0 + 32u * (unsigned)ldk, koff2 = (unsigned)((tid >> 3) * ldk2 + (tid & 7) * 8);
    const unsigned voff0 = (unsigned)((tid >> 3) * NKEY + (tid & 7) * 8), voff1 = voff0 + 64u * NKEY;
    const int klds0 = (tid >> 4) * KS + (tid & 15) * 16, klds2 = (tid >> 3) * KS + 256 + (tid & 7) * 16, vlds0 = (tid >> 3) * VS + (tid & 7) * 16;
#define ATT_LOAD(i_, kreg, vreg) do { int _i = (i_); if (_i > ntile - 1) _i = ntile - 1; const bool _cx = _i < nctx; const int _t = _cx ? _i : tlo + (_i - nctx); \
        const bf16* _k = (_cx ? Kc : Kl) + (size_t)(64 * _t) * ldk; const int _vc = _cx ? 64 * _t : TC + 64 * _t; \
        kreg[0] = *(const v4u*)(_k + koff0); kreg[1] = *(const v4u*)(_k + koff1); \
        if (DQK > 128) { const bf16* _k2 = (_cx ? K2c : K2l) + (size_t)(64 * _t) * ldk2; kreg[KPT - 1] = *(const v4u*)(_k2 + koff2); } \
        vreg[0] = *(const v4u*)(VT + voff0 + _vc); vreg[1] = *(const v4u*)(VT + voff1 + _vc); } while (0)
#define ATT_STORE(buf_, kreg, vreg) do { LAS unsigned char* _kb = lds + (buf_) * BUF; LAS unsigned char* _vb = _kb + KT_BYTES; \
        *(LAS v4u*)(_kb + klds0) = kreg[0]; *(LAS v4u*)(_kb + klds0 + 32 * KS) = kreg[1]; \
        if (DQK > 128) *(LAS v4u*)(_kb + klds2) = kreg[KPT - 1]; \
        *(LAS v4u*)(_vb + vlds0) = vreg[0]; *(LAS v4u*)(_vb + vlds0 + 64 * VS) = vreg[1]; } while (0)
#define ATT_THR 8.0f
#define ATT_COMPUTE(i) do { \
        if (WINDOW && (i) >= nctx) { const int _k0 = 64 * (tlo + ((i) - nctx)), _qw = q0 + wave * 32; if (_k0 > _qw + 159 || _k0 + 63 < _qw - 128) break; }     \
        const LAS unsigned char* kb = lds + (i & 1) * BUF; const LAS unsigned char* vb = kb + KT_BYTES; \
        f32x16 sT[2]; \
        _Pragma("unroll") \
        for (int kt = 0; kt < 2; ++kt) \
        _Pragma("unroll") \
            for (int r = 0; r < 16; ++r) sT[kt][r] = 0.f; \
        { \
            constexpr int PF = 4, NQ = 2 * NS; \
            bf16x8 kf[PF]; \
        _Pragma("unroll") \
            for (int n = 0; n < PF; ++n) kf[n] = *(const LAS bf16x8*)(kb + (32 * (n / NS) + c) * KS + (16 * (n % NS) + 8 * h) * 2); \
        _Pragma("unroll") \
            for (int n = 0; n < NQ; ++n) { const bf16x8 ka = kf[n % PF]; \
                if (n + PF < NQ) kf[n % PF] = *(const LAS bf16x8*)(kb + (32 * ((n + PF) / NS) + c) * KS + (16 * ((n + PF) % NS) + 8 * h) * 2); \
                sT[n / NS] = mfma32(ka, qf[n % NS], sT[n / NS]); } \
        } \
        const bool msk = WINDOW && (i >= nctx); \
        const int kpos0 = 64 * (tlo + (i - nctx)), qpos = q0 + wave * 32 + c; \
        float mx = -1e38f; \
        _Pragma("unroll") \
        for (int kt = 0; kt < 2; ++kt) \
        _Pragma("unroll") \
            for (int r = 0; r < 16; ++r) { \
                if (WINDOW) { const int kpos = kpos0 + 32 * kt + (r & 3) + 8 * (r >> 2) + 4 * h; const int dd = qpos - kpos; if (msk && (dd > 128 || dd < -128)) sT[kt][r] = -1e38f; } \
                mx = fmaxf(mx, sT[kt][r]); } \
        mx = fmaxf(mx, __shfl_xor(mx, 32)); \
        const float mxs = mx * sc_log2; \
        if (__builtin_amdgcn_ballot_w64(mxs > m_run + ATT_THR) != 0ull) {     \
            const float mn = fmaxf(m_run, mxs), alpha = fexp2(m_run - mn); \
            m_run = mn; l_run *= alpha; \
            _Pragma("unroll") \
            for (int dt = 0; dt < 4; ++dt) \
            _Pragma("unroll") \
                for (int r = 0; r < 16; ++r) oT[dt][r] *= alpha; \
        } \
        float ps = 0.f; \
        _Pragma("unroll") \
        for (int kt = 0; kt < 2; ++kt) \
        _Pragma("unroll") \
            for (int r = 0; r < 16; ++r) { const float pv = fexp2(fmaf(sT[kt][r], sc_log2, -m_run)); sT[kt][r] = pv; ps += pv; } \
        l_run += ps; \
        bf16x8 pf[4]; \
        _Pragma("unroll") \
        for (int s = 0; s < 4; ++s) { const int kt = s >> 1, s8 = (s & 1) * 8; v4u w; \
            w.x = pk2(sT[kt][s8 + 0], sT[kt][s8 + 1]); w.y = pk2(sT[kt][s8 + 2], sT[kt][s8 + 3]); w.z = pk2(sT[kt][s8 + 4], sT[kt][s8 + 5]); w.w = pk2(sT[kt][s8 + 6], sT[kt][s8 + 7]); \
            pf[s] = __builtin_bit_cast(bf16x8, w); } \
        { \
            constexpr int PF = 4; \
            v4u vf[PF]; \
        _Pragma("unroll") \
            for (int n = 0; n < PF; ++n) vf[n] = *(const LAS v4u*)(vb + (32 * (n >> 2) + c) * VS + (16 * (n & 3) + 8 * h) * 2); \
        _Pragma("unroll") \
            for (int n = 0; n < 16; ++n) { const v4u va = vf[n % PF]; \
                if (n + PF < 16) { const int n2 = n + PF; vf[n % PF] = *(const LAS v4u*)(vb + (32 * (n2 >> 2) + c) * VS + (16 * (n2 & 3) + 8 * h) * 2); } \
                oT[n >> 2] = mfma32(__builtin_bit_cast(bf16x8, va), pf[n & 3], oT[n >> 2]); } \
        } \
    } while (0)
    if (ntile > 0) { ATT_LOAD(0, kregA, vregA); ATT_STORE(0, kregA, vregA); ATT_LOAD(1, kregB, vregB); }
    __syncthreads();
    for (int i = 0; i < ntile; i += 2) {
        ATT_LOAD(i + 2, kregA, vregA);
        ATT_COMPUTE(i);
        ATT_STORE((i + 1) & 1, kregB, vregB);
        __syncthreads();
        if (i + 1 < ntile) {
            ATT_LOAD(i + 3, kregB, vregB);
            ATT_COMPUTE(i + 1);
            ATT_STORE(i & 1, kregA, vregA);
            __syncthreads();
        }
    }
#undef ATT_COMPUTE
#undef ATT_THR
#undef ATT_LOAD
#undef ATT_STORE
    const float lt = l_run + __shfl_xor(l_run, 32), inv = 1.f / lt;
    bf16* orow = Op + (size_t)(wave * 32 + c) * ldo + 4 * h;
#pragma unroll
    for (int dt = 0; dt < 4; ++dt)
#pragma unroll
        for (int rq = 0; rq < 4; ++rq) { v2u w; w.x = pk2(oT[dt][4 * rq] * inv, oT[dt][4 * rq + 1] * inv); w.y = pk2(oT[dt][4 * rq + 2] * inv, oT[dt][4 * rq + 3] * inv);
            *(v2u*)(orow + 32 * dt + 8 * rq) = w; }
}

__device__ __forceinline__ void ph_win(unsigned char* ws, const float* sink, LAS unsigned char* lds, int tid, int wave, int lane, int wg, int G) {
    const bf16* prj = (const bf16*)(ws + WS_PRJ); bf16* mix = (bf16*)(ws + WS_MIX); const bf16* vtw = (const bf16*)(ws + WS_VTW);
    const float scl = 0.088388347648318440f * LOG2E;
    for (int u = wg; u < 272; u += G) {
        const bool cx = u >= 256;
        const int pair = cx ? (u - 256) : ((u & 7) * 2 + (u >> 7)), qb = (u >> 3) & 15, b = pair >> 3, hq = pair & 7, kvh = hq >> 2;
        const int q0 = cx ? 0 : qb * 256; int tlo = (q0 - 128) / 64; if (tlo < 0) tlo = 0; int thi = (q0 + 383) / 64 + 1; if (thi > 64) thi = 64; if (cx) { tlo = 0; thi = 0; }
        const int qrow = cx ? b * TC : RC + b * TL + q0;
        attn_unit<128, true, true>(lds, tid, wave, lane, prj + (size_t)qrow * EV_IN + E_QW + hq * 128, EV_IN,
            prj + (size_t)(b * TC) * EV_IN + E_KW + kvh * 128, prj + (size_t)(RC + b * TL) * EV_IN + E_KW + kvh * 128, EV_IN, nullptr, nullptr, 0,
            vtw + (size_t)(b * 2 + kvh) * 128 * NKEY, 4, tlo, thi, q0, scl, sink[hq] * LOG2E, mix + (size_t)qrow * DM + 1024 + hq * 128, DM);
    }
}
__device__ __forceinline__ void ph_ret_out(unsigned char* ws, const float* dec, const float* gnw, LAS unsigned char* lds, int tid, int wave, int lane, int wg, int G) {
    for (int u = (wg + G - 32) % G; u < 16 * NCH; u += G) ret_out_unit(ws, dec, gnw, lds, tid, wave, lane, u);
}

__device__ __forceinline__ void ph_prep_odd(unsigned char* ws, LAS unsigned char* lds, const float* convw, const float* qnw, const float* kvnw, int jl, int tid, int wave, int lane, int wg, int G) {
    const bf16* prj = (const bf16*)(ws + WS_PRJ); bf16* mix = (bf16*)(ws + WS_MIX);
    {
        const bf16* a1 = (const bf16*)(ws + WS_A1); const bf16* wk = (const bf16*)(ws + WS_WKRT) + (size_t)jl * 64 * DM; bf16* kr = (bf16*)(ws + WS_KR);
        const int fr = lane & 15, fq = lane >> 4;
        LAS f32x4* red = (LAS f32x4*)lds;
        for (int t = wg; t < RALL / 32; t += G) {
            f32x4 acc[2][4];
#pragma unroll
            for (int m = 0; m < 2; ++m)
#pragma unroll
                for (int n = 0; n < 4; ++n) acc[m][n] = (f32x4){0.f, 0.f, 0.f, 0.f};
            const bf16* ap = a1 + (size_t)(32 * t + fr) * DM + 256 * wave + 8 * fq; const bf16* bp = wk + (size_t)fr * DM + 256 * wave + 8 * fq;
#pragma unroll
            for (int s = 0; s < 8; ++s) { bf16x8 af[2], bfr[4];
#pragma unroll
                for (int m = 0; m < 2; ++m) af[m] = *(const bf16x8*)(ap + (size_t)(16 * m) * DM + 32 * s);
#pragma unroll
                for (int n = 0; n < 4; ++n) bfr[n] = *(const bf16x8*)(bp + (size_t)(16 * n) * DM + 32 * s);
#pragma unroll
                for (int m = 0; m < 2; ++m)
#pragma unroll
                    for (int n = 0; n < 4; ++n) acc[m][n] = mfma16(af[m], bfr[n], acc[m][n]); }
#pragma unroll
            for (int m = 0; m < 2; ++m)
#pragma unroll
                for (int n = 0; n < 4; ++n) red[(wave * 8 + m * 4 + n) * 64 + lane] = acc[m][n];
            __syncthreads();
            { const int m = wave >> 2, n = wave & 3; f32x4 sacc = red[(0 * 8 + wave) * 64 + lane];
#pragma unroll
              for (int w = 1; w < 8; ++w) sacc += red[(w * 8 + wave) * 64 + lane];
#pragma unroll
              for (int r = 0; r < 4; ++r) kr[(size_t)(32 * t + 16 * m + 4 * fq + r) * 64 + 16 * n + fr] = f2bf(sacc[r]); }
            __syncthreads();
        }
    }
    const int gt = wg * NTHR + tid, NGT = G * NTHR;
    const bool wfix = (NGT & 127) == 0;
    float w0[8], w1[8], w2[8];
    if (wfix) { const int c0 = (gt & 127) * 8; ld8f(convw + c0, w0); ld8f(convw + 1024 + c0, w1); ld8f(convw + 2048 + c0, w2); }
    for (int idx0 = gt; idx0 < RALL * 128; idx0 += 3 * NGT) {
        v4u wb[3], wc[3][3], wx[3][3];
#pragma unroll
        for (int b = 0; b < 3; ++b) { const int idx = idx0 + b * NGT; if (idx < RALL * 128) {
            const int r = idx >> 7, c0 = (idx & 127) * 8;
            int t, T; if (r < RC) { t = r & (TC - 1); T = TC; } else { t = (r - RC) & (TL - 1); T = TL; }
            const bf16* pr = prj + (size_t)r * OD_INP;
            wb[b] = *(const v4u*)(pr + O_BG + c0); wc[b][1] = *(const v4u*)(pr + O_CG + c0); wx[b][1] = *(const v4u*)(pr + O_XV + c0);
            if (t > 0) { wc[b][0] = *(const v4u*)(pr - OD_INP + O_CG + c0); wx[b][0] = *(const v4u*)(pr - OD_INP + O_XV + c0); } else { wc[b][0] = (v4u){0u, 0u, 0u, 0u}; wx[b][0] = wc[b][0]; }
            if (t < T - 1) { wc[b][2] = *(const v4u*)(pr + OD_INP + O_CG + c0); wx[b][2] = *(const v4u*)(pr + OD_INP + O_XV + c0); } else { wc[b][2] = (v4u){0u, 0u, 0u, 0u}; wx[b][2] = wc[b][2]; } } }
#pragma unroll
        for (int b = 0; b < 3; ++b) { const int idx = idx0 + b * NGT; if (idx < RALL * 128) {
            const int r = idx >> 7, c0 = (idx & 127) * 8;
            float bg[8], u0[8], u1[8], u2[8], a[8], b2[8], y[8];
            unpack8(wb[b], bg);
            unpack8(wc[b][0], a); unpack8(wx[b][0], b2);
#pragma unroll
            for (int e = 0; e < 8; ++e) u0[e] = a[e] * b2[e];
            unpack8(wc[b][1], a); unpack8(wx[b][1], b2);
#pragma unroll
            for (int e = 0; e < 8; ++e) u1[e] = a[e] * b2[e];
            unpack8(wc[b][2], a); unpack8(wx[b][2], b2);
#pragma unroll
            for (int e = 0; e < 8; ++e) u2[e] = a[e] * b2[e];
            if (!wfix) { ld8f(convw + c0, w0); ld8f(convw + 1024 + c0, w1); ld8f(convw + 2048 + c0, w2); }
#pragma unroll
            for (int e = 0; e < 8; ++e) y[e] = bg[e] * (u0[e] * w0[e] + u1[e] * w1[e] + u2[e] * w2[e]);
            *(v4u*)(mix + (size_t)r * DM + c0) = pack8(y); } }
    }
    bf16* cqn = (bf16*)(ws + WS_CQN); bf16* ckvn = (bf16*)(ws + WS_CKVN);
    const int gw = wg * NWAVES + wave, NGW = G * NWAVES;
    float qw8[8]; ld8f(qnw + 8 * lane, qw8); const f32x4 kw4 = *(const f32x4*)(kvnw + 4 * lane);
    for (int r0 = gw; r0 < RALL; r0 += 5 * NGW) {
        v4u wq[5]; v2u wk[5];
#pragma unroll
        for (int b = 0; b < 5; ++b) { const int r = r0 + b * NGW; if (r < RALL) { const bf16* pr = prj + (size_t)r * OD_INP; wq[b] = *(const v4u*)(pr + O_CQ + 8 * lane); wk[b] = *(const v2u*)(pr + O_CKV + 4 * lane); } }
#pragma unroll
        for (int b = 0; b < 5; ++b) { const int r = r0 + b * NGW; if (r < RALL) {
            float q[8]; unpack8(wq[b], q);
            float ss = 0.f;
#pragma unroll
            for (int e = 0; e < 8; ++e) ss += q[e] * q[e];
            ss = wave_sum(ss);
            const float rs = 1.f / sqrtf(ss * (1.f / 512.f) + EPS);
#pragma unroll
            for (int e = 0; e < 8; ++e) q[e] = q[e] * rs * qw8[e];
            *(v4u*)(cqn + (size_t)r * 512 + 8 * lane) = pack8(q);
            const v2u kw = wk[b];
            const float k0 = bflo(kw.x), k1 = bfhi(kw.x), k2 = bflo(kw.y), k3 = bfhi(kw.y);
            float s2 = wave_sum(k0 * k0 + k1 * k1 + k2 * k2 + k3 * k3);
            const float rs2 = 1.f / sqrtf(s2 * (1.f / 256.f) + EPS);
            v2u o; o.x = pk2(k0 * rs2 * kw4.x, k1 * rs2 * kw4.y); o.y = pk2(k2 * rs2 * kw4.z, k3 * rs2 * kw4.w);
            *(v2u*)(ckvn + (size_t)r * 256 + 4 * lane) = o; } }
    }
}
__device__ __forceinline__ void rope64_item(bf16* blk, int t, int half, int p, const float* t3c, const float* t3s) {
    const int posv = half ? (t & 63) : (t >> 6); bf16* bp = blk + half * 32 + 8 * p; const int tb = posv * 16 + 8 * p;
    const v4u w1 = *(const v4u*)bp, w2 = *(const v4u*)(bp + 16);
    float x1[8], x2[8], cs[8], sn[8], o1[8], o2[8];
    unpack8(w1, x1); unpack8(w2, x2); ld8f(t3c + tb, cs); ld8f(t3s + tb, sn);
#pragma unroll
    for (int e = 0; e < 8; ++e) { o1[e] = x1[e] * cs[e] - x2[e] * sn[e]; o2[e] = x2[e] * cs[e] + x1[e] * sn[e]; }
    *(v4u*)bp = pack8(o1); *(v4u*)(bp + 16) = pack8(o2);
}
__device__ __forceinline__ void ph_rope_kr(unsigned char* ws, int tid, int wg, int G) {
    bf16* krb = (bf16*)(ws + WS_KR); const float* t3c = (const float*)(ws + WS_T2) + 2 * 64 * 32; const float* t3s = t3c + 64 * 16;
    for (int idx = wg * NTHR + tid; idx < NB * TL * 4; idx += G * NTHR) { const int p = idx & 1, half = (idx >> 1) & 1, rl = idx >> 2;
        rope64_item(krb + (size_t)(RC + rl) * 64, rl & (TL - 1), half, p, t3c, t3s); }
}
__device__ __forceinline__ void post_q_tile(unsigned char* ws, int pm, int pn, int tid) {
    if (pm < 2) return;
    bf16* qraw = (bf16*)(ws + WS_QRAW); const float* t3c = (const float*)(ws + WS_T2) + 2 * 64 * 32; const float* t3s = t3c + 64 * 16;
    for (int h = 0; h < 8; ++h) { const int c0 = 192 * h + 128; if (c0 < 256 * pn || c0 >= 256 * pn + 256) continue;
        for (int idx = tid; idx < 1024; idx += NTHR) { const int p = idx & 1, half = (idx >> 1) & 1, i = idx >> 2; const int r = pm * 256 + i;
            rope64_item(qraw + (size_t)r * 1536 + c0, (r - RC) & (TL - 1), half, p, t3c, t3s); } }
}
__device__ __forceinline__ void post_v_tile(unsigned char* ws, LAS unsigned char* lds, int b, int hh, int kt0, int wave, int lane) {
    const bf16* kvraw = (const bf16*)(ws + WS_KVRAW); bf16* vtm = (bf16*)(ws + WS_VTM); LAS unsigned char* scr = lds + wave * 16384;
    const int kt = kt0 + (wave >> 1), dvh = wave & 1, row0 = key_row(b, 64 * kt);
    vt_tile(kvraw + (size_t)row0 * 2048 + hh * 256 + 128 + dvh * 64, 2048, vtm + ((size_t)(b * 8 + hh) * 128 + dvh * 64) * NKEY + 64 * kt, scr, lane);
}
__device__ __forceinline__ void ph_mix_odd(unsigned char* ws, LAS unsigned char* lds, int nunits, int tid, int wave, int lane, int wg, int G) {
    const bf16* krb = (const bf16*)(ws + WS_KR); bf16* mix = (bf16*)(ws + WS_MIX); const bf16* vtm = (const bf16*)(ws + WS_VTM);
    const bf16* qraw = (const bf16*)(ws + WS_QRAW); const bf16* kvraw = (const bf16*)(ws + WS_KVRAW);
    const float scl = 0.072168783648703220f * LOG2E;
    for (int u = wg; u < nunits; u += G) {
        const bool cx = u >= 256;
        const int pair = cx ? (u - 256) : ((u & 7) * 2 + (u >> 7)), qb = (u >> 3) & 15, b = pair >> 3, hh = pair & 7;
        const int q0 = cx ? 0 : qb * 256, qrow = cx ? b * TC : RC + b * TL + q0;
        attn_unit<192, false, false>(lds, tid, wave, lane, qraw + (size_t)qrow * 1536 + hh * 192, 1536,
            kvraw + (size_t)(b * TC) * 2048 + hh * 256, kvraw + (size_t)(RC + b * TL) * 2048 + hh * 256, 2048,
            krb + (size_t)(b * TC) * 64, krb + (size_t)(RC + b * TL) * 64, 64,
            vtm + (size_t)(b * 8 + hh) * 128 * NKEY, 4, 0, cx ? 0 : 64, q0, scl, 0.f, mix + (size_t)qrow * DM + 1024 + hh * 128, DM);
    }
}

#define NOINL static __device__ __forceinline__
typedef const GAS float* gcf;
typedef GAS unsigned char* gws;
typedef const GAS unsigned short* gcb;
__device__ __forceinline__ int mk_lane() { int l; asm volatile("v_mbcnt_lo_u32_b32 %0, -1, 0\n\tv_mbcnt_hi_u32_b32 %0, -1, %0" : "=v"(l)); return l; }
#define PH_IDS int wv_ = wave_in; asm volatile("" : "+s"(wv_)); const int wave = wv_, lane = mk_lane(), tid = wave * 64 + lane, G = gridDim.x, wg = blockIdx.x; (void)lane; (void)wave; (void)G; (void)wg; (void)tid
#define PH_GW const int gw = wg * NWAVES + wave, NGW = G * NWAVES

__device__ __forceinline__ int uni(int v) { return __builtin_amdgcn_readfirstlane(v); }
template <class T> __device__ __forceinline__ GAS T* uni(GAS T* p) { const unsigned long long v = (unsigned long long)p; const unsigned lo = (unsigned)__builtin_amdgcn_readfirstlane((int)(unsigned)v), hi = (unsigned)__builtin_amdgcn_readfirstlane((int)(unsigned)(v >> 32));
    return (GAS T*)(((unsigned long long)hi << 32) | lo); }
template <class T> __device__ __forceinline__ LAS T* uni(LAS T* p) { return (LAS T*)(unsigned)__builtin_amdgcn_readfirstlane((int)(unsigned)(unsigned long long)p); }
#define U(x) x = uni(x)
#define OPQ(x) asm volatile("" : "+s"(x))

NOINL void f_prologue(int wave_in, gws ws, LAS unsigned char* lds, gcf x, gcf c, gcf ctx, gcf c_ctx, gcf w_mod, gcf b_mod, gcf mlp_w1, gcf mlp_w2, gcf ev_w_in, gcf ev_w_out, gcf od_w_in, gcf od_w_out, gcf od_w_uq, gcf od_w_ukv) {
    PH_IDS; U(ws); U(lds); U(x); U(c); U(ctx); U(c_ctx); U(w_mod); U(b_mod); U(mlp_w1); U(mlp_w2); U(ev_w_in); U(ev_w_out); U(od_w_in); U(od_w_out); U(od_w_uq); U(od_w_ukv);
    ProIn p{(const float*)x, (const float*)c, (const float*)ctx, (const float*)c_ctx, (const float*)w_mod, (const float*)b_mod, (const float*)mlp_w1, (const float*)mlp_w2, (const float*)ev_w_in, (const float*)ev_w_out,
            (const float*)od_w_in, (const float*)od_w_out, (const float*)od_w_uq, (const float*)od_w_ukv};
    ph_prologue(p, (unsigned char*)ws, lds, tid, wave, lane, wg, G);
}
NOINL void f_norm(int wave_in, gws ws, LAS unsigned char* lds, gcf nw, gcf ctx32, gcf x32, int layer, int ch_sh, int ch_sc, int mode) {
    PH_IDS; PH_GW; U(ws); U(lds); U(nw); U(ctx32); U(x32); U(layer); U(ch_sh); U(ch_sc); U(mode);
    const float* mod_l = (const float*)(ws + WS_MOD) + (size_t)layer * 3 * 12288;
    bf16* Hb = (bf16*)(ws + WS_H);
    if (mode == 1) ph_norm_ctx<S_MLP>(nullptr, Hb, (const float*)nw, mod_l, ch_sh, ch_sc, (bf16*)(ws + WS_A1), (const bf16*)(ws + WS_PARTM), mod_l - 3 * 12288 + (2 * 6 + 5) * DM, lds, tid, wave, lane, wg, G);
    if (mode == 2) ph_norm_ctx<S_OUT>(layer == 0 ? (const float*)ctx32 : nullptr, Hb, (const float*)nw, mod_l, ch_sh, ch_sc, (bf16*)(ws + WS_A1), (const bf16*)(ws + WS_PARTO), mod_l + (2 * 6 + 2) * DM, lds, tid, wave, lane, wg, G);
    __syncthreads();
    ph_norm(mode == 0, (const float*)ctx32, (const float*)x32, Hb, (const float*)nw, mod_l, ch_sh, ch_sc, (bf16*)(ws + WS_A1), mode == 0 ? 0 : RC, lds, tid, gw, NGW, lane);
}
NOINL void f_final(int wave_in, gws ws, gcf nw, GAS float* out) { PH_IDS; PH_GW; U(ws); U(nw); U(out); ph_final((const bf16*)(ws + WS_H), (const float*)nw, (float*)out, gw, NGW, lane); }
NOINL void f_post_win(int wave_in, gws ws, LAS unsigned char* lds) { PH_IDS; U(ws); U(lds); VM_WAIT(); __syncthreads();
    pg8::StaticOrder S; S.init(RALL, EV_IN, G, wg, DM); pg8::Unit u;
    for (int i = 0; S.next(i, u); ++i) { post_win_tile((unsigned char*)ws, lds, u.pm, u.pn, tid, wave, lane); } }
NOINL void f_ret_kv(int wave_in, gws ws, LAS unsigned char* lds, gcf dec) { PH_IDS; U(ws); U(lds); U(dec); for (int u = wg; u < 16 * NCH; u += G) ret_kv_unit((unsigned char*)ws, (const float*)dec, lds, tid, wave, lane, u); }
NOINL void f_ret_scan(int wave_in, gws ws, gcf dec) { PH_IDS; U(ws); U(dec); ph_ret_scan((unsigned char*)ws, (const float*)dec, tid, wg, G); }
NOINL void f_win(int wave_in, gws ws, LAS unsigned char* lds, gcf sink) { PH_IDS; U(ws); U(lds); U(sink); ph_win((unsigned char*)ws, (const float*)sink, lds, tid, wave, lane, wg, G); }
NOINL void f_ret_out(int wave_in, gws ws, LAS unsigned char* lds, gcf dec, gcf gnw) { PH_IDS; U(ws); U(lds); U(dec); U(gnw); ph_ret_out((unsigned char*)ws, (const float*)dec, (const float*)gnw, lds, tid, wave, lane, wg, G); }
NOINL void f_prep_odd(int wave_in, gws ws, LAS unsigned char* lds, gcf convw, gcf qnw, gcf kvnw, int jl) { PH_IDS; U(ws); U(lds); U(convw); U(qnw); U(kvnw); U(jl); ph_prep_odd((unsigned char*)ws, lds, (const float*)convw, (const float*)qnw, (const float*)kvnw, jl, tid, wave, lane, wg, G); }
NOINL void f_rope_kr(int wave_in, gws ws) { PH_IDS; U(ws); ph_rope_kr((unsigned char*)ws, tid, wg, G); }
NOINL void f_post_q(int wave_in, gws ws) { PH_IDS; U(ws); VM_WAIT(); __syncthreads();
    pg8::StaticOrder S; S.init(RALL, 1536, G, wg, 512); pg8::Unit u; for (int i = 0; S.next(i, u); ++i) post_q_tile((unsigned char*)ws, u.pm, u.pn, tid); }
NOINL void f_post_v(int wave_in, gws ws, LAS unsigned char* lds) { PH_IDS; U(ws); U(lds); VM_WAIT(); __syncthreads();
    pg8::Unit u;
    { pg8::StaticOrder S; S.init(RC, 2048, G, ((wg - 204) % G + G) % G, 256); for (int i = 0; S.next(i, u); ++i) post_v_tile((unsigned char*)ws, lds, u.pm, u.pn, 0, wave, lane); }
    { pg8::StaticOrder S; S.init(RALL - RC, 2048, G, wg, 256); for (int i = 0; S.next(i, u); ++i) post_v_tile((unsigned char*)ws, lds, u.pm >> 4, u.pn, 4 + (u.pm & 15) * 4, wave, lane); }
}
NOINL void f_mla(int wave_in, gws ws, LAS unsigned char* lds, int nunits) { PH_IDS; U(ws); U(lds); U(nunits); ph_mix_odd((unsigned char*)ws, lds, nunits, tid, wave, lane, wg, G); }
template <int ACT> NOINL void f_gemm_act(int wave_in, LAS unsigned char* lds, gcb A, gcb Bt, GAS unsigned short* O, int M, int N, int K, int ldc, int wg_shift = 0) {
    PH_IDS; U(lds); U(A); U(Bt); U(O); U(M); U(N); U(K); U(ldc); U(wg_shift); OPQ(M); OPQ(N); OPQ(K); OPQ(ldc);
    pg8::Gemm g{(const pg8::bf16_t*)A, (const pg8::bf16_t*)Bt, M, N, K}; pg8::StaticOrder S; S.init(M, N, G, ((wg - wg_shift) % G + G) % G, K);
    pg8::EpiAct<ACT> E{(pg8::bf16_t*)O, ldc};
    pg8::gemm_phase<pg8::EpiAct<ACT>, pg8::StaticOrder, PG8_ALIGN, PG8_SP2>((PG8_LAS unsigned char*)lds, g, S, E, wave);
}
NOINL void f_gemm_res(int wave_in, LAS unsigned char* lds, gcb A, gcb Bt, GAS unsigned short* Hp, gcf x32, gcf gate0, GAS unsigned short* part, int M, int N, int K, int S) {
    PH_IDS; U(lds); U(A); U(Bt); U(Hp); U(x32); U(gate0); U(part); U(M); U(N); U(K); U(S); OPQ(M); OPQ(N); OPQ(K); OPQ(S);
    pg8::Gemm g{(const pg8::bf16_t*)A, (const pg8::bf16_t*)Bt, M, N, K}; pg8::ResOrder S_; S_.init(M, N, K, S, G, wg);
    pg8::EpiResGate E{(pg8::bf16_t*)Hp, N, (const float*)gate0, 6 * DM, (pg8::bf16_t*)part, (const float*)x32};
    pg8::gemm_phase<pg8::EpiResGate, pg8::ResOrder, PG8_ALIGN, PG8_SP2>((PG8_LAS unsigned char*)lds, g, S_, E, wave);
}

constexpr int PH_END = 50;
#ifndef MK_PER_PHASE
#define MK_PER_PHASE 0
#endif
__global__ void __launch_bounds__(NTHR, 2) mk_fwd(Args a) {
    extern __shared__ __attribute__((aligned(16))) unsigned char lds_raw[];
    LAS unsigned char* lds = (LAS unsigned char*)lds_raw;
    const int tid = threadIdx.x;
    const int wv = __builtin_amdgcn_readfirstlane(tid >> 6);
    gws ws = (gws)a.ws;
    volatile LAS unsigned* MISC = (volatile LAS unsigned*)(lds + MISC_OFF);
    for (int u = tid; u < (LDS_BYTES - MISC_OFF) / 4; u += NTHR) ((LAS unsigned*)(lds + MISC_OFF))[u] = 0u;
    __syncthreads();
    const int lo = a.ph_lo, hi = a.ph_hi;
    XcdBarrier bar; bar.bar = (unsigned*)(a.ws + WS_CTL) + CW_BAR; bar.x = 0; bar.st = MISC + 8;
    if (hi - lo > 1) bar = xcd_barrier_post((unsigned*)(a.ws + WS_CTL) + CW_BAR, MISC + 8);
#define IN(k) (lo <= (k) && (k) < hi)
#define SEAM(k) do { if ((k) + 1 < hi) xcd_barrier(bar); } while (0)

    if (IN(0)) { f_prologue(wv, ws, lds, (gcf)a.x, (gcf)a.c, (gcf)a.ctx, (gcf)a.c_ctx, (gcf)a.w_mod, (gcf)a.b_mod, (gcf)a.mlp_w1, (gcf)a.mlp_w2, (gcf)a.ev_w_in, (gcf)a.ev_w_out, (gcf)a.od_w_in, (gcf)a.od_w_out, (gcf)a.od_w_uq, (gcf)a.od_w_ukv);


        SEAM(0); }

#pragma nounroll
    for (int l = 0; l < DEPTH; ++l) {
        const int j = l >> 1, pb = 1 + 12 * l;
        const int row_off = (l == DEPTH - 1) ? RC : 0, Mr = RALL - row_off;
        if (IN(pb + 0)) { f_norm(wv, ws, lds, (gcf)(a.norm1_w + l * DM), (gcf)a.ctx, (gcf)a.x, l, 0, 1, l == 0 ? 0 : 1); SEAM(pb + 0); }
        if (!(l & 1)) {
            if (IN(pb + 1)) { f_gemm_act<0>(wv, lds, (gcb)(ws + WS_A1), (gcb)(ws + WS_EWIN) + (size_t)j * EV_IN * DM, (GAS unsigned short*)(ws + WS_PRJ), RALL, EV_IN, DM, EV_IN);
                f_post_win(wv, ws, lds);
                SEAM(pb + 1); }
            if (IN(pb + 2)) { f_ret_kv(wv, ws, lds, (gcf)(a.ev_decay + j * 16)); SEAM(pb + 2); }
            if (IN(pb + 4)) { f_ret_scan(wv, ws, (gcf)(a.ev_decay + j * 16)); SEAM(pb + 4); }
            if (IN(pb + 5)) { f_win(wv, ws, lds, (gcf)(a.ev_sink + j * 8)); __syncthreads(); f_ret_out(wv, ws, lds, (gcf)(a.ev_decay + j * 16), (gcf)(a.ev_gn_w + j * 1024));


                SEAM(pb + 5); }
        } else {
            if (IN(pb + 1)) { f_gemm_act<0>(wv, lds, (gcb)(ws + WS_A1), (gcb)(ws + WS_OWIN) + (size_t)j * OD_INP * DM, (GAS unsigned short*)(ws + WS_PRJ), RALL, OD_INP, DM, OD_INP);
                SEAM(pb + 1); }
            if (IN(pb + 2)) { f_prep_odd(wv, ws, lds, (gcf)(a.od_conv_w + j * 3 * 1024), (gcf)(a.od_qn_w + j * 512), (gcf)(a.od_kvn_w + j * 256), j); SEAM(pb + 2); }
            if (IN(pb + 3)) {
                f_rope_kr(wv, ws);
                f_gemm_act<0>(wv, lds, (gcb)(ws + WS_CQN), (gcb)(ws + WS_UQT) + (size_t)j * 1536 * 512, (GAS unsigned short*)(ws + WS_QRAW), RALL, 1536, 512, 1536);
                f_post_q(wv, ws);
                __syncthreads();
                f_gemm_act<0>(wv, lds, (gcb)(ws + WS_CKVN), (gcb)(ws + WS_UKVT) + (size_t)j * 2048 * 256, (GAS unsigned short*)(ws + WS_KVRAW), RC, 2048, 256, 2048, 204);
                __syncthreads();
                f_gemm_act<0>(wv, lds, (gcb)(ws + WS_CKVN) + (size_t)RC * 256, (gcb)(ws + WS_UKVT) + (size_t)j * 2048 * 256, (GAS unsigned short*)(ws + WS_KVRAW) + (size_t)RC * 2048, RALL - RC, 2048, 256, 2048);
                f_post_v(wv, ws, lds);
                SEAM(pb + 3); }
            if (IN(pb + 6)) { f_mla(wv, ws, lds, row_off ? 256 : 272); SEAM(pb + 6); }
        }
        if (IN(pb + 7)) { gcb wo = (l & 1) ? (gcb)(ws + WS_OWOUT) + (size_t)j * DM * DM : (gcb)(ws + WS_EWOUT) + (size_t)j * DM * DM;
            f_gemm_res(wv, lds, (gcb)(ws + WS_MIX), wo, (GAS unsigned short*)(ws + WS_H), l == 0 ? (gcf)a.x : (gcf)nullptr, (gcf)(ws + WS_MOD) + (size_t)l * 3 * 12288 + 2 * DM, (GAS unsigned short*)(ws + WS_PARTO), RALL, DM, DM, row_off ? 0 : S_OUT);
            SEAM(pb + 7); }
        if (IN(pb + 8)) { f_norm(wv, ws, lds, (gcf)(a.norm2_w + l * DM), (gcf)a.ctx, (gcf)a.x, l, 3, 4, row_off ? 3 : 2); SEAM(pb + 8); }
        if (IN(pb + 9)) { f_gemm_act<1>(wv, lds, (gcb)(ws + WS_A1) + (size_t)row_off * DM, (gcb)(ws + WS_W1T) + (size_t)l * DFF * DM, (GAS unsigned short*)(ws + WS_HID) + (size_t)row_off * DFF, Mr, DFF, DM, DFF);

            SEAM(pb + 9); }
        if (IN(pb + 10)) { f_gemm_res(wv, lds, (gcb)(ws + WS_HID), (gcb)(ws + WS_W2T) + (size_t)l * DM * DFF, (GAS unsigned short*)(ws + WS_H), (gcf)nullptr, (gcf)(ws + WS_MOD) + (size_t)l * 3 * 12288 + 5 * DM, (GAS unsigned short*)(ws + WS_PARTM), RALL, DM, DFF, row_off ? 0 : S_MLP);
            SEAM(pb + 10); }
    }
    if (IN(49)) f_final(wv, ws, (gcf)a.norm_f, (GAS float*)a.out);
#undef IN
#undef SEAM
}

extern "C" void kernel_launch(void* const* d_in, const int* in_sizes, int n_in, void* d_out, int out_size, void* d_ws, size_t ws_size, hipStream_t stream) {
    static int grid = 0;
    if (grid == 0) {
        if (n_in != 23 || out_size != NB * TL * DM || ws_size < WS_END) { fprintf(stderr, "kernel_launch: unexpected shapes (n_in %d, out %d, ws %zu); nothing launched\n", n_in, out_size, ws_size); grid = -1; return; }
        int dev = 0, cus = 0, per_cu = 0;
        if (hipGetDevice(&dev) != hipSuccess || hipDeviceGetAttribute(&cus, hipDeviceAttributeMultiprocessorCount, dev) != hipSuccess) { grid = -1; return; }
        if (hipFuncSetAttribute((const void*)mk_fwd, hipFuncAttributeMaxDynamicSharedMemorySize, LDS_BYTES) != hipSuccess) { fprintf(stderr, "kernel_launch: hipFuncSetAttribute failed\n"); grid = -1; return; }
        if (hipOccupancyMaxActiveBlocksPerMultiprocessor(&per_cu, (const void*)mk_fwd, NTHR, LDS_BYTES) != hipSuccess || per_cu < 1) { fprintf(stderr, "kernel_launch: occupancy query reports %d blocks per CU; nothing launched\n", per_cu); grid = -1; (void)hipGetLastError(); return; }
        grid = cus;
    }
    if (grid < 0) return;
    if (hipMemsetAsync((char*)d_ws + WS_CTL, 0, CTL_ZERO_BYTES, stream) != hipSuccess) return;
    Args a{};
    const float** ap = (const float**)&a;
    for (int i = 0; i < 23; ++i) ap[i] = (const float*)d_in[i];
    a.out = (float*)d_out; a.ws = (unsigned char*)d_ws;
#if MK_PER_PHASE
    for (int p = 0; p < PH_END; ++p) { a.ph_lo = p; a.ph_hi = p + 1; hipLaunchKernelGGL(mk_fwd, dim3(grid), dim3(NTHR), LDS_BYTES, stream, a); }
#else
    a.ph_lo = 0; a.ph_hi = PH_END;
    hipLaunchKernelGGL(mk_fwd, dim3(grid), dim3(NTHR), LDS_BYTES, stream, a);
#endif
    const hipError_t le = hipPeekAtLastError();
    if (le != hipSuccess) fprintf(stderr, "kernel_launch: launch failed: %s\n", hipGetErrorName(le));
}
```

```cpp
#include <hip/hip_runtime.h>
#include <cstdio>
#include <cstdint>
#define MK_PER_PHASE 0
namespace pg8 {
#define PG8_LAS __attribute__((address_space(3)))
typedef unsigned short bf16_t;
typedef short bf16x8 __attribute__((ext_vector_type(8)));
typedef float f32x4 __attribute__((ext_vector_type(4)));
typedef unsigned u32x4 __attribute__((ext_vector_type(4)));
constexpr int BM = 256, BK = 64, HALF = 128, HTB = HALF * BK * 2  , STAGE_BYTES = 8 * HTB, NXCD = 8, WGM = 4;

__host__ __device__ __forceinline__ int lds_byte(int r, int c) { const int st = (r >> 4) * 2 + (c >> 5), rr = r & 15, cc = c & 31, ob = rr * 64 + cc * 2; return st * 1024 + (ob ^ (((ob >> 9) & 1) << 5)); }
__host__ __device__ __forceinline__ void stage_rc(int b, int& R, int& C) { const int st = b / 1024, sb = b % 1024, swz = sb ^ (((sb >> 9) & 1) << 5); R = (st >> 1) * 16 + swz / 64; C = (st & 1) * 32 + (swz % 64) / 2; }
__host__ __device__ __forceinline__ int perm32(int rho) { const int n = rho >> 4, i = rho & 15; return 8 * (i >> 2) + 4 * n + (i & 3); }

struct Unit { int pm, pn, ks, nt, koff; };
struct Gemm { const bf16_t* A; const bf16_t* Bt; int M, N, K; };

struct StaticOrder {
    int nM, nN, nwg, G, c, ntK;
    __host__ __device__ void init(int M, int N, int G_, int c_, int K_) { nM = M / BM; nN = N / BM; nwg = nM * nN; G = G_; c = c_; ntK = K_ / BK; }
    __host__ __device__ bool next(int i, Unit& u) const {
        const long L = (long)i * G + c; if (L >= nwg) return false;
        int wgid = (int)L; { const int q = nwg / NXCD, r = nwg % NXCD, xcd = wgid % NXCD, off = wgid / NXCD; wgid = (xcd < r ? xcd * (q + 1) : r * (q + 1) + (xcd - r) * q) + off; }
        const int nig = WGM * nN, gid = wgid / nig, fm = gid * WGM, gsz = (nM - fm) < WGM ? (nM - fm) : WGM;
        u.pm = fm + ((wgid % nig) % gsz); u.pn = (wgid % nig) / gsz; u.ks = -1; u.nt = ntK; u.koff = 0; return true;
    }
    __device__ __forceinline__ void a_ready(const Unit&) const {}
    __device__ __forceinline__ void done(const Unit&) const {}
};

__device__ __forceinline__ unsigned cvt_pk_bf16(float lo, float hi) { unsigned r; asm volatile("v_cvt_pk_bf16_f32 %0, %1, %2" : "=v"(r) : "v"(lo), "v"(hi)); return r; }
typedef float f32x2 __attribute__((ext_vector_type(2)));
__device__ __forceinline__ f32x2 gelu_pk(f32x2 v) {
    const f32x2 av = __builtin_elementwise_abs(v), d = av * 0.2316418882f + 1.0f;
    f32x2 t; t.x = __builtin_amdgcn_rcpf(d.x); t.y = __builtin_amdgcn_rcpf(d.y);
    f32x2 q = t * 0.5307027145f + (-0.7265760135f); q = q * t + 0.7107068705f; q = q * t + (-0.142248368f); q = q * t + 0.127414796f; q = q * t;
    const f32x2 s = (v * v) * (-0.72134752044f);
    f32x2 e; e.x = __builtin_amdgcn_exp2f(s.x); e.y = __builtin_amdgcn_exp2f(s.y);
    const f32x2 m = v * (q * e), r = v - m;
    f32x2 o; o.x = v.x < 0.f ? m.x : r.x; o.y = v.y < 0.f ? m.y : r.y; return o;
}


template <int ACT> struct EpiAct {
    static constexpr bool PERM = true, AFTER_DRAIN = false;
    bf16_t* O; int ldc;
    __device__ __forceinline__ void operator()(const f32x4 (&acc)[2][2][4][2], const Unit& u, int wr, int wc, int fr, int fq) const {
        const int row0 = u.pm * BM + wr * 64 + fr, col0 = u.pn * BM + wc * 32 + 8 * fq;
#pragma unroll
        for (int ai = 0; ai < 2; ++ai)
#pragma unroll
            for (int m = 0; m < 4; ++m) { bf16_t* rowp = O + (size_t)(row0 + ai * HALF + m * 16) * ldc + col0;
#pragma unroll
                for (int bj = 0; bj < 2; ++bj) { f32x4 v0 = acc[ai][bj][m][0], v1 = acc[ai][bj][m][1];
                    if (ACT == 1) {
#pragma unroll
                        for (int e = 0; e < 4; ++e) { const float a = fmaxf(v0[e], 0.f), b = fmaxf(v1[e], 0.f); v0[e] = a * a; v1[e] = b * b; } }
                    u32x4 w; w.x = cvt_pk_bf16(v0[0], v0[1]); w.y = cvt_pk_bf16(v0[2], v0[3]); w.z = cvt_pk_bf16(v1[0], v1[1]); w.w = cvt_pk_bf16(v1[2], v1[3]);
                    *(u32x4*)(rowp + bj * HALF) = w; } }
    }
};
struct EpiResGate {
    static constexpr bool PERM = true, AFTER_DRAIN = false;
    bf16_t* H; int ldc; const float* gate0; int set_stride; bf16_t* part; const float* Hx32;
    __device__ __forceinline__ void operator()(const f32x4 (&acc)[2][2][4][2], const Unit& u, int wr, int wc, int fr, int fq) const {
        const int row0 = u.pm * BM + wr * 64 + fr, col0 = u.pn * BM + wc * 32 + 8 * fq;
        if (u.ks >= 0) {
            bf16_t* P = part + (size_t)u.ks * 512 * ldc;
#pragma unroll
            for (int ai = 0; ai < 2; ++ai)
#pragma unroll
                for (int m = 0; m < 4; ++m) { bf16_t* rowp = P + (size_t)(row0 + ai * HALF + m * 16) * ldc + col0;
#pragma unroll
                    for (int bj = 0; bj < 2; ++bj) { const f32x4 v0 = acc[ai][bj][m][0], v1 = acc[ai][bj][m][1];
                        u32x4 o; o.x = cvt_pk_bf16(v0[0], v0[1]); o.y = cvt_pk_bf16(v0[2], v0[3]); o.z = cvt_pk_bf16(v1[0], v1[1]); o.w = cvt_pk_bf16(v1[2], v1[3]);
                        *(u32x4*)(rowp + bj * HALF) = o; } }
            return; }
        const int grow = u.pm * BM; const int set = grow < 512 ? 2 : ((grow - 512) >> 12);
        const float* g = gate0 + (size_t)set * set_stride + col0;
        f32x4 gv[2][2];
#pragma unroll
        for (int bj = 0; bj < 2; ++bj) { gv[bj][0] = *(const f32x4*)(g + bj * HALF); gv[bj][1] = *(const f32x4*)(g + bj * HALF + 4); }
        if (Hx32) {
#pragma unroll
            for (int ai = 0; ai < 2; ++ai) { f32x4 hx[4][2][2];
#pragma unroll
                for (int m = 0; m < 4; ++m)
#pragma unroll
                    for (int bj = 0; bj < 2; ++bj) { const float* ps = Hx32 + (size_t)(row0 + ai * HALF + m * 16) * ldc + col0 - (size_t)512 * ldc + bj * HALF; hx[m][bj][0] = *(const f32x4*)ps; hx[m][bj][1] = *(const f32x4*)(ps + 4); }
#pragma unroll
                for (int m = 0; m < 4; ++m)
#pragma unroll
                    for (int bj = 0; bj < 2; ++bj) { const f32x4 v0 = hx[m][bj][0] + gv[bj][0] * acc[ai][bj][m][0], v1 = hx[m][bj][1] + gv[bj][1] * acc[ai][bj][m][1];
                        u32x4 o; o.x = cvt_pk_bf16(v0[0], v0[1]); o.y = cvt_pk_bf16(v0[2], v0[3]); o.z = cvt_pk_bf16(v1[0], v1[1]); o.w = cvt_pk_bf16(v1[2], v1[3]);
                        *(u32x4*)(H + (size_t)(row0 + ai * HALF + m * 16) * ldc + col0 + bj * HALF) = o; } }
        } else {
#pragma unroll
            for (int ai = 0; ai < 2; ++ai) { u32x4 hw[4][2];
#pragma unroll
                for (int m = 0; m < 4; ++m)
#pragma unroll
                    for (int bj = 0; bj < 2; ++bj) hw[m][bj] = *(const u32x4*)(H + (size_t)(row0 + ai * HALF + m * 16) * ldc + col0 + bj * HALF);
#pragma unroll
                for (int m = 0; m < 4; ++m)
#pragma unroll
                    for (int bj = 0; bj < 2; ++bj) { const u32x4 w = hw[m][bj];
                        const f32x4 h0 = {__uint_as_float(w.x << 16), __uint_as_float(w.x & 0xffff0000u), __uint_as_float(w.y << 16), __uint_as_float(w.y & 0xffff0000u)};
                        const f32x4 h1 = {__uint_as_float(w.z << 16), __uint_as_float(w.z & 0xffff0000u), __uint_as_float(w.w << 16), __uint_as_float(w.w & 0xffff0000u)};
                        const f32x4 v0 = h0 + gv[bj][0] * acc[ai][bj][m][0], v1 = h1 + gv[bj][1] * acc[ai][bj][m][1];
                        u32x4 o; o.x = cvt_pk_bf16(v0[0], v0[1]); o.y = cvt_pk_bf16(v0[2], v0[3]); o.z = cvt_pk_bf16(v1[0], v1[1]); o.w = cvt_pk_bf16(v1[2], v1[3]);
                        *(u32x4*)(H + (size_t)(row0 + ai * HALF + m * 16) * ldc + col0 + bj * HALF) = o; } }
        }
    }
};

struct ResOrder {
    StaticOrder so; int nmain, nsplit, S, nN, ntc, G, c;
    __host__ __device__ void init(int M, int N, int K, int S_, int G_, int c_) { so.init(M - 512, N, G_, c_, K); nmain = so.nwg; S = S_; nN = N / BM; nsplit = 2 * nN * S_; ntc = S_ ? K / S_ / BK : 0; G = G_; c = c_; }
    __host__ __device__ bool next(int i, Unit& u) const {
        const long L = (long)i * G + c;
        if (L < nmain) { so.next(i, u); u.pm += 2; return true; }
        const int s = (int)(L - nmain); if (s >= nsplit) return false;
        u.ks = s % S; const int rest = s / S; u.pn = rest % nN; u.pm = rest / nN; u.nt = ntc; u.koff = u.ks * ntc * BK; return true;
    }
    __device__ __forceinline__ void a_ready(const Unit&) const {}
    __device__ __forceinline__ void done(const Unit&) const {}
};
template <class Epi, class Sched, bool ALIGN_EPI = false, bool SP2 = false>
__device__ __forceinline__ void gemm_phase(PG8_LAS unsigned char* lds, const Gemm g, const Sched& S, const Epi& E, int wave_in) {
    int lane_; asm volatile("v_mbcnt_lo_u32_b32 %0, -1, 0\n\tv_mbcnt_hi_u32_b32 %0, -1, %0" : "=v"(lane_));
    const int wid = wave_in, tid = wid * 64 + lane_, lane = tid & 63, wr = wid >> 2, wc = wid & 3, fr = lane & 15, fq = lane >> 4;
    const int K = g.K;
    unsigned voffA[2], voffB[2];
#pragma unroll
    for (int i = 0; i < 2; ++i) { int R, C; stage_rc(tid * 16 + i * 8192, R, C); const int Rb = Epi::PERM ? ((R & ~31) + perm32(R & 31)) : R;
        voffA[i] = (unsigned)(R * K + C) * 2u; voffB[i] = (unsigned)(Rb * K + C) * 2u; }
    const size_t kstep = (size_t)(BK * 2);
    const size_t hstep = (size_t)HALF * K * 2;
    const size_t tstep = 2 * hstep;
    const unsigned ldsw = (unsigned)wid * 1024u;
    const int aoff = lds_byte(wr * 64 + fr, fq * 8), boff = lds_byte(wc * 32 + fr, fq * 8);
#define PG8_SA(b, h) (((b) * 2 + (h)) * HTB)
#define PG8_SB(b, h) ((4 + (b) * 2 + (h)) * HTB)
#define PG8_STAGE(bufoff, gbase, voff) do { _Pragma("unroll") for (int _i = 0; _i < 2; ++_i) \
        __builtin_amdgcn_global_load_lds((const unsigned*)((const char*)(gbase) + (voff)[_i]), (PG8_LAS unsigned*)(lds + (bufoff) + ldsw + _i * 8192), 16, 0, 0); } while (0)
#define PG8_LDA(dst, b, h) do { _Pragma("unroll") for (int m = 0; m < 4; ++m) _Pragma("unroll") for (int k = 0; k < 2; ++k) dst[m][k] = *(const PG8_LAS bf16x8*)(lds + PG8_SA(b, h) + aoff + m * 2048 + k * 1024); } while (0)
#define PG8_LDB(dst, b, h) do { _Pragma("unroll") for (int n = 0; n < 2; ++n) _Pragma("unroll") for (int k = 0; k < 2; ++k) dst[n][k] = *(const PG8_LAS bf16x8*)(lds + PG8_SB(b, h) + boff + n * 2048 + k * 1024); } while (0)
#define PG8_MMA(ai, bj, At, Bt) do { __builtin_amdgcn_s_setprio(1); _Pragma("unroll") for (int m = 0; m < 4; ++m) _Pragma("unroll") for (int n = 0; n < 2; ++n) _Pragma("unroll") for (int k = 0; k < 2; ++k) \
        acc[ai][bj][m][n] = __builtin_amdgcn_mfma_f32_16x16x32_bf16(Bt[n][k], At[m][k], acc[ai][bj][m][n], 0, 0, 0); __builtin_amdgcn_s_setprio(0); } while (0)
#define PG8_WAIT_V(n) asm volatile("s_waitcnt vmcnt(" #n ")" ::: "memory")
#define PG8_WAIT_L(n) asm volatile("s_waitcnt lgkmcnt(" #n ")" ::: "memory")
#define PG8_BAR __builtin_amdgcn_s_barrier()
#define PG8_SCHED __builtin_amdgcn_sched_barrier(0)
    Unit cur, nxt; int ui = 0;
    if (!S.next(0, cur)) return;
    f32x4 acc[2][2][4][2];
#pragma unroll
    for (int a = 0; a < 2; ++a)
#pragma unroll
        for (int b = 0; b < 2; ++b)
#pragma unroll
            for (int m = 0; m < 4; ++m)
#pragma unroll
                for (int n = 0; n < 2; ++n) acc[a][b][m][n] = (f32x4){0.f, 0.f, 0.f, 0.f};
    bf16x8 At[4][2], B0[2][2], B1[2][2];
    const char* cA = (const char*)g.A + (size_t)cur.pm * tstep + (size_t)cur.koff * 2; const char* cB = (const char*)g.Bt + (size_t)cur.pn * tstep + (size_t)cur.koff * 2;
    int nt = cur.nt;
    S.a_ready(cur);
    if constexpr (SP2) {
        PG8_STAGE(PG8_SB(0, 0), cB, voffB); PG8_STAGE(PG8_SB(0, 1), cB + hstep, voffB); PG8_STAGE(PG8_SA(0, 0), cA, voffA); PG8_STAGE(PG8_SA(0, 1), cA + hstep, voffA);
        if (wr == 1) PG8_BAR;
        PG8_WAIT_V(2); PG8_BAR;
        PG8_STAGE(PG8_SB(1, 0), cB + kstep, voffB); PG8_STAGE(PG8_SA(1, 0), cA + kstep, voffA); PG8_STAGE(PG8_SB(1, 1), cB + hstep + kstep, voffB);
        PG8_WAIT_V(6); PG8_BAR;
    } else {
        PG8_STAGE(PG8_SB(0, 0), cB, voffB); PG8_STAGE(PG8_SA(0, 0), cA, voffA); PG8_STAGE(PG8_SB(0, 1), cB + hstep, voffB); PG8_STAGE(PG8_SA(0, 1), cA + hstep, voffA);
        if (wr == 1) PG8_BAR;
        PG8_WAIT_V(4); PG8_BAR;
        PG8_STAGE(PG8_SB(1, 0), cB + kstep, voffB); PG8_STAGE(PG8_SA(1, 0), cA + kstep, voffA); PG8_STAGE(PG8_SB(1, 1), cB + hstep + kstep, voffB);
        PG8_WAIT_V(6); PG8_BAR;
    }
    for (;;) {
        const bool has_next = S.next(ui + 1, nxt);
        const char* nA = has_next ? (const char*)g.A + (size_t)nxt.pm * tstep + (size_t)nxt.koff * 2 : cA; const char* nB = has_next ? (const char*)g.Bt + (size_t)nxt.pn * tstep + (size_t)nxt.koff * 2 : cB;
        asm volatile(".p2align 8" ::: "memory");
        for (int t = 0; t < nt; t += 2) {
            const bool last = (t == nt - 2);
            const char* a1 = cA + (size_t)(t + 1) * kstep;
            const char* a2 = last ? nA : cA + (size_t)(t + 2) * kstep; const char* b2 = last ? nB : cB + (size_t)(t + 2) * kstep;
            const char* a3 = a2 + kstep; const char* b3 = b2 + kstep;
            if (last && has_next) S.a_ready(nxt);
            if constexpr (SP2) {
            PG8_LDB(B0, 0, 0); PG8_LDB(B1, 0, 1); PG8_SCHED; PG8_LDA(At, 0, 0); PG8_STAGE(PG8_SA(1, 1), a1 + hstep, voffA);
            PG8_WAIT_V(8); PG8_WAIT_L(0); PG8_BAR; PG8_MMA(0, 0, At, B0); PG8_MMA(0, 1, At, B1); PG8_BAR; PG8_SCHED;
            PG8_LDA(At, 0, 1); PG8_STAGE(PG8_SB(0, 0), b2, voffB); PG8_STAGE(PG8_SB(0, 1), b2 + hstep, voffB); PG8_STAGE(PG8_SA(0, 0), a2, voffA);
            PG8_WAIT_V(8); PG8_WAIT_L(0); PG8_BAR; PG8_MMA(1, 0, At, B0); PG8_MMA(1, 1, At, B1); PG8_BAR; PG8_SCHED;
            PG8_LDB(B0, 1, 0); PG8_LDB(B1, 1, 1); PG8_SCHED; PG8_LDA(At, 1, 0); PG8_STAGE(PG8_SA(0, 1), a2 + hstep, voffA);
            PG8_WAIT_V(8); PG8_WAIT_L(0); PG8_BAR; PG8_MMA(0, 0, At, B0); PG8_MMA(0, 1, At, B1); PG8_BAR; PG8_SCHED;
            PG8_LDA(At, 1, 1); PG8_STAGE(PG8_SB(1, 0), b3, voffB); PG8_STAGE(PG8_SB(1, 1), b3 + hstep, voffB); PG8_STAGE(PG8_SA(1, 0), a3, voffA);
            PG8_WAIT_V(8); PG8_WAIT_L(0); PG8_BAR; PG8_MMA(1, 0, At, B0); PG8_MMA(1, 1, At, B1); PG8_BAR; PG8_SCHED;
            } else {
            PG8_LDB(B0, 0, 0); PG8_SCHED; PG8_LDA(At, 0, 0); PG8_STAGE(PG8_SA(1, 1), a1 + hstep, voffA);
            PG8_WAIT_L(8); PG8_BAR; PG8_WAIT_L(0); PG8_MMA(0, 0, At, B0); PG8_BAR; PG8_SCHED;
            PG8_LDB(B1, 0, 1); PG8_STAGE(PG8_SB(0, 0), b2, voffB);
            PG8_BAR; PG8_WAIT_L(0); PG8_MMA(0, 1, At, B1); PG8_BAR;
            PG8_LDA(At, 0, 1); PG8_STAGE(PG8_SA(0, 0), a2, voffA);
            PG8_BAR; PG8_WAIT_L(0); PG8_MMA(1, 0, At, B0); PG8_BAR; PG8_SCHED;
            PG8_STAGE(PG8_SB(0, 1), b2 + hstep, voffB);
            PG8_WAIT_V(6); PG8_BAR; PG8_MMA(1, 1, At, B1); PG8_BAR;
            PG8_LDB(B0, 1, 0); PG8_SCHED; PG8_LDA(At, 1, 0); PG8_STAGE(PG8_SA(0, 1), a2 + hstep, voffA);
            PG8_WAIT_L(8); PG8_BAR; PG8_WAIT_L(0); PG8_MMA(0, 0, At, B0); PG8_BAR; PG8_SCHED;
            PG8_LDB(B1, 1, 1); PG8_STAGE(PG8_SB(1, 0), b3, voffB);
            PG8_BAR; PG8_WAIT_L(0); PG8_MMA(0, 1, At, B1); PG8_BAR;
            PG8_LDA(At, 1, 1); PG8_STAGE(PG8_SA(1, 0), a3, voffA);
            PG8_BAR; PG8_WAIT_L(0); PG8_MMA(1, 0, At, B0); PG8_BAR; PG8_SCHED;
            PG8_STAGE(PG8_SB(1, 1), b3 + hstep, voffB);
            PG8_WAIT_V(6); PG8_BAR; PG8_MMA(1, 1, At, B1); PG8_BAR;
            }
        }
        if constexpr (ALIGN_EPI) { if (wr == 0) PG8_BAR; }
        if constexpr (!Epi::AFTER_DRAIN) { E(acc, cur, wr, wc, fr, fq); S.done(cur); }
        if (!has_next) break;
#pragma unroll
        for (int a = 0; a < 2; ++a)
#pragma unroll
            for (int b = 0; b < 2; ++b)
#pragma unroll
                for (int m = 0; m < 4; ++m)
#pragma unroll
                    for (int n = 0; n < 2; ++n) acc[a][b][m][n] = (f32x4){0.f, 0.f, 0.f, 0.f};
        cur = nxt; cA = nA; cB = nB; ++ui; nt = cur.nt;
        if constexpr (ALIGN_EPI) { if (wr == 1) PG8_BAR; }
    }
    PG8_WAIT_V(0);
    if constexpr (!ALIGN_EPI) { if (wr == 0) PG8_BAR; }
    PG8_BAR;
    if constexpr (Epi::AFTER_DRAIN) { E.fused(acc, cur, wr, wc, fr, fq, lds, wid, lane); S.done(cur); }
#undef PG8_SA
#undef PG8_SB
#undef PG8_STAGE
#undef PG8_LDA
#undef PG8_LDB
#undef PG8_MMA
#undef PG8_WAIT_V
#undef PG8_WAIT_L
#undef PG8_BAR
#undef PG8_SCHED
}
}

#ifndef PG8_SP2
#define PG8_SP2 true
#endif
#ifndef PG8_ALIGN
#define PG8_ALIGN true
#endif

constexpr int DM = 2048, NB = 2, TL = 4096, TC = 256, DEPTH = 4, DFF = 8192;
constexpr int RC = NB * TC;
constexpr int RALL = RC + NB * TL;
constexpr int NKEY = TC + TL;
constexpr int EV_IN = 5632, OD_IN = 3904, OD_INP = 3840;
constexpr int E_QR = 0, E_KR = 1024, E_VR = 2048, E_GR = 3072, E_QW = 4096, E_KW = 5120, E_VW = 5376;
constexpr int O_BG = 0, O_CG = 1024, O_XV = 2048, O_CQ = 3072, O_CKV = 3584, O_KR = 3840;
constexpr int NCH = 34;
constexpr float EPS = 1e-6f;
constexpr float LOG2E = 1.4426950408889634f;

constexpr size_t MiB = 1u << 20;
constexpr size_t WS_CTL = 0, CTL_ZERO_BYTES = 1 * MiB;
constexpr size_t WS_MOD = 1 * MiB;
constexpr size_t WS_T1C = 2 * MiB, WS_T1S = 3 * MiB;
constexpr size_t WS_T2 = 4 * MiB;
constexpr size_t WS_W1T = 8 * MiB, WS_W2T = 136 * MiB, WS_EWIN = 264 * MiB, WS_EWOUT = 308 * MiB, WS_OWIN = 324 * MiB, WS_OWOUT = 356 * MiB, WS_UQT = 372 * MiB, WS_UKVT = 375 * MiB;
constexpr size_t WS_H = 384 * MiB, WS_A1 = 452 * MiB, WS_PRJ = 486 * MiB, WS_MIX = 580 * MiB, WS_HID = 614 * MiB, WS_KVST = 750 * MiB, WS_ST = 818 * MiB;
constexpr size_t WS_VTW = 852 * MiB, WS_VTM = 857 * MiB, WS_CQN = 874 * MiB, WS_CKVN = 883 * MiB, WS_QRAW = 888 * MiB, WS_KVRAW = 914 * MiB, WS_PARTO = 948 * MiB, WS_PARTM = 980 * MiB, WS_WKRT = 1044 * MiB, WS_KR = 1045 * MiB, WS_END = 1047 * MiB;
constexpr int S_OUT = 4, S_MLP = 8;
constexpr int CW_BAR = 4096;

constexpr int LDS_BYTES = 147456;
constexpr int MISC_OFF = 143360;
constexpr int NWAVES = 8, NTHR = 512;

#define GAS __attribute__((address_space(1)))
#define LAS __attribute__((address_space(3)))
typedef unsigned short bf16;
typedef unsigned v4u __attribute__((ext_vector_type(4)));
typedef unsigned v2u __attribute__((ext_vector_type(2)));
typedef float f32x4 __attribute__((ext_vector_type(4)));
typedef float f32x16 __attribute__((ext_vector_type(16)));
typedef short bf16x8 __attribute__((ext_vector_type(8)));
#define LDS_WAIT() asm volatile("s_waitcnt lgkmcnt(0)" ::: "memory")
#define VM_WAIT() asm volatile("s_waitcnt vmcnt(0)" ::: "memory")

__device__ __forceinline__ unsigned pk2(float lo, float hi) { unsigned r; asm volatile("v_cvt_pk_bf16_f32 %0, %1, %2" : "=v"(r) : "v"(lo), "v"(hi)); return r; }
__device__ __forceinline__ float bflo(unsigned w) { return __uint_as_float(w << 16); }
__device__ __forceinline__ float bfhi(unsigned w) { return __uint_as_float(w & 0xffff0000u); }
__device__ __forceinline__ float bf2f(unsigned short b) { return __uint_as_float(((unsigned)b) << 16); }
__device__ __forceinline__ unsigned short f2bf(float f) { return (unsigned short)(pk2(f, 0.f) & 0xffffu); }
__device__ __forceinline__ float wave_sum(float v) {
#pragma unroll
    for (int o = 1; o < 64; o <<= 1) v += __shfl_xor(v, o);
    return v;
}
__device__ __forceinline__ float fexp2(float x) { return __builtin_amdgcn_exp2f(x); }
__device__ __forceinline__ int row_set(int r) { return r < RC ? 2 : ((r - RC) >> 12); }

#define XB_TMO      128
#define XB_XCNT(j)  (256  + 64 * (j))
#define XB_XSUB(j)  (1280 + 64 * (j))
#define XB_XGEN(j)  (2304 + 64 * (j))
#define XB_TOP      3328
#define XB_TOPGEN   3392
#define XCD_BAR_WORDS 3456
#define XB_SPIN_CAP (1u << 18)

__device__ __forceinline__ unsigned xb_ld(unsigned* p)              { return __hip_atomic_load(p, __ATOMIC_RELAXED, __HIP_MEMORY_SCOPE_AGENT); }
__device__ __forceinline__ unsigned xb_add(unsigned* p, unsigned v) { return __hip_atomic_fetch_add(p, v, __ATOMIC_RELAXED, __HIP_MEMORY_SCOPE_AGENT); }
__device__ __forceinline__ unsigned xb_xcc_id() { return (unsigned)__builtin_amdgcn_s_getreg((3 << 11) | 20) & 0xFu; }
#define XB_SPIN(cond, bar) do { unsigned _sp = 0; while (cond) { __builtin_amdgcn_s_sleep(1); \
    if ((++_sp & 255u) == 0u) { if (xb_ld(&(bar)[XB_TMO])) break; if (_sp > XB_SPIN_CAP) { atomicAdd(&(bar)[XB_TMO], 1u); break; } } } } while (0)

struct XcdBarrier {
    unsigned* bar; unsigned x;
    volatile LAS unsigned* st;
};

__device__ __forceinline__ XcdBarrier xcd_barrier_post(unsigned* bar, volatile LAS unsigned* st) {
    XcdBarrier b; b.bar = bar; b.x = xb_xcc_id(); b.st = st;
    if (threadIdx.x == 0) (void)xb_add(&bar[XB_XCNT(b.x)], 1u);
    return b;
}
__device__ __forceinline__ void xcd_barrier_complete(unsigned* bar, unsigned x, unsigned& nloc, unsigned& nx) {
    const unsigned G = gridDim.x * gridDim.y * gridDim.z;
    unsigned sum, cnt, mine, sp = 0u;
    for (;;) {
        sum = 0u; cnt = 0u; mine = 0u;
#pragma unroll
        for (unsigned j = 0; j < 16; ++j) { const unsigned c = xb_ld(&bar[XB_XCNT(j)]); sum += c; cnt += (c > 0u) ? 1u : 0u; mine = (j == x) ? c : mine; }
        if (sum == G) break;
        __builtin_amdgcn_s_sleep(1);
        if ((++sp & 255u) == 0u) { if (xb_ld(&bar[XB_TMO])) break; if (sp > XB_SPIN_CAP) { atomicAdd(&bar[XB_TMO], 1u); break; } }
    }
    nloc = mine > 0u ? mine : 1u; nx = cnt > 0u ? cnt : 1u;
}

__device__ __forceinline__ void xcd_barrier(const XcdBarrier& b) {
    asm volatile("s_waitcnt vmcnt(0)" ::: "memory");
    __syncthreads();
    if (threadIdx.x == 0) {
        unsigned* bar = b.bar;
        __builtin_amdgcn_s_waitcnt(0);
        unsigned nloc = b.st[0], nx = b.st[1];
        if (nloc == 0u) { xcd_barrier_complete(bar, b.x, nloc, nx); b.st[0] = nloc; b.st[1] = nx; }
        const unsigned old = xb_add(&bar[XB_XSUB(b.x)], 1u);
        const unsigned gen = old / nloc;
        if (old + 1u == (gen + 1u) * nloc) {
            __builtin_amdgcn_fence(__ATOMIC_RELEASE, "agent");
            asm volatile("s_waitcnt vmcnt(0)" ::: "memory");
            const unsigned og = xb_add(&bar[XB_TOP], 1u);
            const unsigned tg = og / nx;
            if (og + 1u == (tg + 1u) * nx) xb_add(&bar[XB_TOPGEN], 1u);
            else XB_SPIN(xb_ld(&bar[XB_TOPGEN]) == tg, bar);
            __builtin_amdgcn_fence(__ATOMIC_ACQUIRE, "agent");
            xb_add(&bar[XB_XGEN(b.x)], 1u);
            asm volatile("s_waitcnt vmcnt(0)" ::: "memory");
        } else {
            XB_SPIN(xb_ld(&bar[XB_XGEN(b.x)]) == gen, bar);
            __builtin_amdgcn_fence(__ATOMIC_ACQUIRE, "agent");
            asm volatile("s_waitcnt vmcnt(0)" ::: "memory");
        }
    }
    __syncthreads();
}

struct Args {
    const float *x, *c, *ctx, *c_ctx, *w_mod, *b_mod, *norm1_w, *norm2_w, *mlp_w1, *mlp_w2, *ev_w_in, *ev_decay, *ev_gn_w, *ev_sink, *ev_w_out,
                *od_w_in, *od_conv_w, *od_qn_w, *od_kvn_w, *od_w_uq, *od_w_ukv, *od_w_out, *norm_f;
    float* out; unsigned char* ws; int ph_lo, ph_hi;
};

__device__ __forceinline__ void unpack8(const v4u w, float (&f)[8]) {
#pragma unroll
    for (int i = 0; i < 4; ++i) { f[2 * i] = bflo(w[i]); f[2 * i + 1] = bfhi(w[i]); }
}
__device__ __forceinline__ v4u pack8(const float (&f)[8]) { v4u w; w.x = pk2(f[0], f[1]); w.y = pk2(f[2], f[3]); w.z = pk2(f[4], f[5]); w.w = pk2(f[6], f[7]); return w; }
__device__ __forceinline__ void ld8f(const float* p, float (&f)[8]) { const f32x4 a = *(const f32x4*)p, b = *(const f32x4*)(p + 4);
    f[0] = a.x; f[1] = a.y; f[2] = a.z; f[3] = a.w; f[4] = b.x; f[5] = b.y; f[6] = b.z; f[7] = b.w; }
__device__ __forceinline__ float lam_of(float log2_decay) { const float x = -fexp2(log2_decay);
    float s = -1.f / 8.f; s = s * x + 1.f / 7.f; s = s * x - 1.f / 6.f; s = s * x + 1.f / 5.f; s = s * x - 1.f / 4.f; s = s * x + 1.f / 3.f; s = s * x - 0.5f; s = s * x + 1.f; return s * x; }
__device__ __forceinline__ f32x4 mfma16(bf16x8 a, bf16x8 b, f32x4 c) { return __builtin_amdgcn_mfma_f32_16x16x32_bf16(a, b, c, 0, 0, 0); }
__device__ __forceinline__ f32x16 mfma32(bf16x8 a, bf16x8 b, f32x16 c) { return __builtin_amdgcn_mfma_f32_32x32x16_bf16(a, b, c, 0, 0, 0); }

struct P0Item { const float* W; bf16* WT; int K, N, item; };
__device__ __forceinline__ void p0_item_load(const P0Item& d, int lane, float (&ld)[32]) {
    const int nblk = d.N / 32, kb = d.item / nblk, nb = d.item % nblk; const float* src = d.W + (size_t)(64 * kb + (lane >> 5)) * d.N + 32 * nb + (lane & 31);
#pragma unroll
    for (int i = 0; i < 32; ++i) ld[i] = __builtin_nontemporal_load(src + (size_t)(2 * i) * d.N);
}
__device__ __forceinline__ void p0_item_finish(const P0Item& d, int lane, const float (&ld)[32], LAS float* scr) {
    const int nblk = d.N / 32, kb = d.item / nblk, nb = d.item % nblk, k0 = 64 * kb, n0 = 32 * nb;
#pragma unroll
    for (int i = 0; i < 32; ++i) scr[(2 * i + (lane >> 5)) * 33 + (lane & 31)] = ld[i];
    LDS_WAIT(); asm volatile("" ::: "memory");
    const int c = lane & 7;
#pragma unroll
    for (int j = 0; j < 4; ++j) { const int n = (lane >> 3) + 8 * j; const LAS float* s = scr + (8 * c) * 33 + n;
        v4u o; o.x = pk2(s[0 * 33], s[1 * 33]); o.y = pk2(s[2 * 33], s[3 * 33]); o.z = pk2(s[4 * 33], s[5 * 33]); o.w = pk2(s[6 * 33], s[7 * 33]);
        __builtin_nontemporal_store(o, (GAS v4u*)(d.WT + (size_t)(n0 + n) * d.K + k0 + 8 * c)); }
    LDS_WAIT(); asm volatile("" ::: "memory");
}
struct ProIn { const float *x, *c, *ctx, *c_ctx, *w_mod, *b_mod, *mlp_w1, *mlp_w2, *ev_w_in, *ev_w_out, *od_w_in, *od_w_out, *od_w_uq, *od_w_ukv; };
__device__ __forceinline__ void ph_prologue(const ProIn a, unsigned char* ws, LAS unsigned char* lds, int tid, int wave, int lane, int wg, int G) {
    float* mod = (float*)(ws + WS_MOD);
    for (int u = wg; u < 192; u += G) {
        LAS float* sl = (LAS float*)lds;
        LAS float* red = (LAS float*)(lds + 24576);
        for (int i = tid; i < 3 * DM; i += NTHR) { const int s = i >> 11, k = i & 2047; const float cv = (s < 2) ? a.c[s * DM + k] : a.c_ctx[k]; sl[i] = cv / (1.f + __expf(-cv)); }
        __syncthreads();
        const int l = u / 48, j0 = (u % 48) * 256;
        const float* wp = a.w_mod + ((size_t)l * DM + wave * 256) * 12288 + j0 + 4 * lane;
        f32x4 a0 = {0.f, 0.f, 0.f, 0.f}, a1 = a0, a2 = a0;
#pragma unroll 8
        for (int k = 0; k < 256; ++k) { const f32x4 w = *(const f32x4*)(wp + (size_t)k * 12288); const int kk = wave * 256 + k;
            a0 += sl[kk] * w; a1 += sl[DM + kk] * w; a2 += sl[2 * DM + kk] * w; }
        *(LAS f32x4*)(red + (wave * 3 + 0) * 256 + 4 * lane) = a0; *(LAS f32x4*)(red + (wave * 3 + 1) * 256 + 4 * lane) = a1; *(LAS f32x4*)(red + (wave * 3 + 2) * 256 + 4 * lane) = a2;
        __syncthreads();
        for (int i = tid; i < 768; i += NTHR) { const int s = i >> 8, col = i & 255; float v = a.b_mod[l * 12288 + j0 + col];
#pragma unroll
            for (int w = 0; w < 8; ++w) v += red[(w * 3 + s) * 256 + col];
            mod[(size_t)(l * 3 + s) * 12288 + j0 + col] = v; }
        __syncthreads();
    }
    {
        LAS float* scr = (LAS float*)(lds + wave * 16384);
        const int gw = wg * NWAVES + wave, NGW = G * NWAVES;
        constexpr int I_W1 = 32 * 256, I_W2 = 128 * 64, I_EI = 32 * 176, I_EO = 32 * 64, I_OI = 32 * 122, I_OO = 32 * 64, I_UQ = 8 * 48, I_UKV = 4 * 64;
        constexpr int NIT = 4 * I_W1 + 4 * I_W2 + 2 * (I_EI + I_EO + I_OI + I_OO + I_UQ + I_UKV);
#define P0_DECODE(it_, d) do { int r = (it_); \
            if (r < 4 * I_W1) { const int l = r / I_W1; d = P0Item{a.mlp_w1 + (size_t)l * DM * DFF, (bf16*)(ws + WS_W1T) + (size_t)l * DFF * DM, DM, DFF, r % I_W1}; break; } r -= 4 * I_W1; \
            if (r < 4 * I_W2) { const int l = r / I_W2; d = P0Item{a.mlp_w2 + (size_t)l * DFF * DM, (bf16*)(ws + WS_W2T) + (size_t)l * DM * DFF, DFF, DM, r % I_W2}; break; } r -= 4 * I_W2; \
            if (r < 2 * I_EI) { const int l = r / I_EI; d = P0Item{a.ev_w_in + (size_t)l * DM * EV_IN, (bf16*)(ws + WS_EWIN) + (size_t)l * EV_IN * DM, DM, EV_IN, r % I_EI}; break; } r -= 2 * I_EI; \
            if (r < 2 * I_EO) { const int l = r / I_EO; d = P0Item{a.ev_w_out + (size_t)l * DM * DM, (bf16*)(ws + WS_EWOUT) + (size_t)l * DM * DM, DM, DM, r % I_EO}; break; } r -= 2 * I_EO; \
            if (r < 2 * I_OI) { const int l = r / I_OI, it2 = r % I_OI, nb = it2 % 122;     \
                bf16* dst = nb < 120 ? (bf16*)(ws + WS_OWIN) + (size_t)l * OD_INP * DM : (bf16*)(ws + WS_WKRT) + (size_t)l * 64 * DM - (size_t)OD_INP * DM; \
                d = P0Item{a.od_w_in + (size_t)l * DM * OD_IN, dst, DM, OD_IN, it2}; break; } r -= 2 * I_OI; \
            if (r < 2 * I_OO) { const int l = r / I_OO; d = P0Item{a.od_w_out + (size_t)l * DM * DM, (bf16*)(ws + WS_OWOUT) + (size_t)l * DM * DM, DM, DM, r % I_OO}; break; } r -= 2 * I_OO; \
            if (r < 2 * I_UQ) { const int l = r / I_UQ; d = P0Item{a.od_w_uq + (size_t)l * 512 * 1536, (bf16*)(ws + WS_UQT) + (size_t)l * 1536 * 512, 512, 1536, r % I_UQ}; break; } r -= 2 * I_UQ; \
            { const int l = r / I_UKV; d = P0Item{a.od_w_ukv + (size_t)l * 256 * 2048, (bf16*)(ws + WS_UKVT) + (size_t)l * 2048 * 256, 256, 2048, r % I_UKV}; } } while (0)
        P0Item dA, dB; float ldA[32], ldB[32];
        int it = gw;
        if (it < NIT) { P0_DECODE(it, dA); p0_item_load(dA, lane, ldA); }
        while (it < NIT) {
            if (it + NGW < NIT) { P0_DECODE(it + NGW, dB); p0_item_load(dB, lane, ldB); }
            p0_item_finish(dA, lane, ldA, scr);
            it += NGW;
            if (it >= NIT) break;
            if (it + NGW < NIT) { P0_DECODE(it + NGW, dA); p0_item_load(dA, lane, ldA); }
            p0_item_finish(dB, lane, ldB, scr);
            it += NGW;
        }
#undef P0_DECODE
    }
    const int gt = wg * NTHR + tid, NGT = G * NTHR;
    {
        const double INV2PI = 0.15915494309189533576888;
        const float L2B = 13.287712379549449f;
        float* t1c = (float*)(ws + WS_T1C); float* t1s = (float*)(ws + WS_T1S);
        for (int i = gt; i < TL * 64; i += NGT) { const int pos = i >> 6, f = i & 63; const float inv = fexp2(-(float)(2 * f) / 128.f * L2B); const float ang = (float)pos * inv;
            double rev = (double)ang * INV2PI; rev -= __builtin_rint(rev); const float fr = (float)rev; t1c[i] = __builtin_amdgcn_cosf(fr); t1s[i] = __builtin_amdgcn_sinf(fr); }
        float* t2c = (float*)(ws + WS_T2); float* t2s = t2c + 64 * 32; float* t3c = t2s + 64 * 32; float* t3s = t3c + 64 * 16;
        for (int i = gt; i < 64 * 32; i += NGT) { const int pos = i >> 5, f = i & 31; const float inv = fexp2(-(float)(2 * f) / 64.f * L2B); const float ang = (float)pos * inv;
            double rev = (double)ang * INV2PI; rev -= __builtin_rint(rev); const float fr = (float)rev; t2c[i] = __builtin_amdgcn_cosf(fr); t2s[i] = __builtin_amdgcn_sinf(fr); }
        for (int i = gt; i < 64 * 16; i += NGT) { const int pos = i >> 4, f = i & 15; const float inv = fexp2(-(float)(2 * f) / 32.f * L2B); const float ang = (float)pos * inv;
            double rev = (double)ang * INV2PI; rev -= __builtin_rint(rev); const float fr = (float)rev; t3c[i] = __builtin_amdgcn_cosf(fr); t3s[i] = __builtin_amdgcn_sinf(fr); }
    }
}

__device__ __forceinline__ void ph_norm(bool src32, const float* Hc, const float* Hx, const bf16* Hb, const float* nw, const float* mod_l, int ch_sh, int ch_sc, bf16* A, int row_lo, LAS unsigned char* lds, int tid, int gw, int NGW, int lane) {
    LAS float* comb = (LAS float*)(lds + 1024);
    for (int i = tid; i < 3 * DM; i += NTHR) { const int set = i >> 11, col = i & 2047; comb[(set * 2 + 0) * DM + col] = nw[col] * (1.f + mod_l[(size_t)(set * 6 + ch_sc) * DM + col]); comb[(set * 2 + 1) * DM + col] = mod_l[(size_t)(set * 6 + ch_sh) * DM + col]; }
    __syncthreads();
#define NORM_ROW_OUT(vv, r_) do { float ss = 0.f; \
        _Pragma("unroll") for (int j = 0; j < 8; ++j) ss += (vv[j].x * vv[j].x + vv[j].y * vv[j].y) + (vv[j].z * vv[j].z + vv[j].w * vv[j].w); \
        ss = wave_sum(ss); \
        const float rs = 1.f / sqrtf(ss * (1.f / DM) + EPS); \
        const LAS float* ca = comb + (row_set(r_) * 2) * DM; const LAS float* cb = ca + DM; \
        v2u* o = (v2u*)(A + (size_t)(r_) * DM) + lane; \
        _Pragma("unroll") for (int j = 0; j < 8; ++j) { const int col = 256 * j + 4 * lane; const f32x4 w = *(const LAS f32x4*)(ca + col), t = *(const LAS f32x4*)(cb + col); \
            const f32x4 y = (vv[j] * rs) * w + t; v2u q; q.x = pk2(y.x, y.y); q.y = pk2(y.z, y.w); o[64 * j] = q; } } while (0)
    if (src32) {
        for (int r0 = row_lo + gw; r0 < RALL; r0 += 2 * NGW) {
            f32x4 va[8], vb[8]; const int r1 = r0 + NGW; const bool h1 = r1 < RALL;
            { const f32x4* xr = (const f32x4*)(r0 < RC ? Hc + (size_t)r0 * DM : Hx + (size_t)(r0 - RC) * DM) + lane;
#pragma unroll
              for (int j = 0; j < 8; ++j) va[j] = xr[64 * j]; }
            if (h1) { const f32x4* xr = (const f32x4*)(r1 < RC ? Hc + (size_t)r1 * DM : Hx + (size_t)(r1 - RC) * DM) + lane;
#pragma unroll
              for (int j = 0; j < 8; ++j) vb[j] = xr[64 * j]; }
            NORM_ROW_OUT(va, r0);
            if (h1) NORM_ROW_OUT(vb, r1);
        }
    } else {
        for (int r0 = row_lo + gw; r0 < RALL; r0 += 5 * NGW) {
            v2u pk[5][8];
#pragma unroll
            for (int b = 0; b < 5; ++b) { const int r = r0 + b * NGW; if (r < RALL) { const v2u* xr = (const v2u*)(Hb + (size_t)r * DM) + lane;
#pragma unroll
                for (int j = 0; j < 8; ++j) pk[b][j] = xr[64 * j]; } }
#pragma unroll
            for (int b = 0; b < 5; ++b) { const int r = r0 + b * NGW; if (r < RALL) { f32x4 v[8];
#pragma unroll
                for (int j = 0; j < 8; ++j) v[j] = (f32x4){bflo(pk[b][j].x), bfhi(pk[b][j].x), bflo(pk[b][j].y), bfhi(pk[b][j].y)};
                NORM_ROW_OUT(v, r); } }
        }
    }
#undef NORM_ROW_OUT
    __syncthreads();
}
template <int NPART> __device__ __forceinline__ void ph_norm_ctx(const float* Hin32, bf16* H, const float* nw, const float* mod_l, int ch_sh, int ch_sc, bf16* A, const bf16* part, const float* pgate, LAS unsigned char* lds, int tid, int wave, int lane, int wg, int G) {
    LAS float* red = (LAS float*)lds;
    const float* sh = mod_l + (size_t)(2 * 6 + ch_sh) * DM; const float* sc = mod_l + (size_t)(2 * 6 + ch_sc) * DM;
    const int col = 256 * wave + 4 * lane;
    for (int r = wg; r < RC; r += G) {
        f32x4 h;
        if (Hin32) h = *(const f32x4*)(Hin32 + (size_t)r * DM + col);
        else { const v2u w = *(const v2u*)(H + (size_t)r * DM + col); h = (f32x4){bflo(w.x), bfhi(w.x), bflo(w.y), bfhi(w.y)}; }
        f32x4 acc = {0.f, 0.f, 0.f, 0.f};
        v2u pw[NPART];
#pragma unroll
        for (int s = 0; s < NPART; ++s) pw[s] = *(const v2u*)(part + ((size_t)s * RC + r) * DM + col);
#pragma unroll
        for (int s = 0; s < NPART; ++s) acc += (f32x4){bflo(pw[s].x), bfhi(pw[s].x), bflo(pw[s].y), bfhi(pw[s].y)};
        h += *(const f32x4*)(pgate + col) * acc;
        { v2u w; w.x = pk2(h.x, h.y); w.y = pk2(h.z, h.w); *(v2u*)(H + (size_t)r * DM + col) = w;
          h = (f32x4){bflo(w.x), bfhi(w.x), bflo(w.y), bfhi(w.y)}; }
        float ss = wave_sum((h.x * h.x + h.y * h.y) + (h.z * h.z + h.w * h.w));
        if (lane == 0) red[wave] = ss;
        __syncthreads();
        float tot = 0.f;
#pragma unroll
        for (int w = 0; w < 8; ++w) tot += red[w];
        __syncthreads();
        const float rs = 1.f / sqrtf(tot * (1.f / DM) + EPS);
        const f32x4 w4 = *(const f32x4*)(nw + col), s4 = *(const f32x4*)(sc + col), t4 = *(const f32x4*)(sh + col);
        const f32x4 y = (h * rs) * w4 * (s4 + 1.f) + t4; v2u q; q.x = pk2(y.x, y.y); q.y = pk2(y.z, y.w);
        *(v2u*)(A + (size_t)r * DM + col) = q;
    }
}
__device__ __forceinline__ void ph_final(const bf16* H, const float* nw, float* out, int gw, int NGW, int lane) {
    f32x4 wv[8];
#pragma unroll
    for (int j = 0; j < 8; ++j) wv[j] = *(const f32x4*)(nw + 256 * j + 4 * lane);
    for (int r0 = gw; r0 < NB * TL; r0 += 4 * NGW) {
        v2u pk[4][8];
#pragma unroll
        for (int b = 0; b < 4; ++b) { const int r = r0 + b * NGW; if (r < NB * TL) { const v2u* xr = (const v2u*)(H + (size_t)(RC + r) * DM) + lane;
#pragma unroll
            for (int j = 0; j < 8; ++j) pk[b][j] = xr[64 * j]; } }
#pragma unroll
        for (int b = 0; b < 4; ++b) { const int r = r0 + b * NGW; if (r < NB * TL) { f32x4 v[8]; float ss = 0.f;
#pragma unroll
            for (int j = 0; j < 8; ++j) { v[j] = (f32x4){bflo(pk[b][j].x), bfhi(pk[b][j].x), bflo(pk[b][j].y), bfhi(pk[b][j].y)}; ss += (v[j].x * v[j].x + v[j].y * v[j].y) + (v[j].z * v[j].z + v[j].w * v[j].w); }
            ss = wave_sum(ss);
            const float rs = 1.f / sqrtf(ss * (1.f / DM) + EPS);
            f32x4* o = (f32x4*)(out + (size_t)r * DM) + lane;
#pragma unroll
            for (int j = 0; j < 8; ++j) o[64 * j] = (v[j] * rs) * wv[j]; } }
    }
}

__device__ __forceinline__ void vt_tile(const bf16* src, int ld_src, bf16* dst, LAS unsigned char* scr, int lane) {
#pragma unroll
    for (int it = 0; it < 8; ++it) { const int key = it * 8 + (lane >> 3), pc = lane & 7;
        const v4u w = *(const v4u*)(src + (size_t)key * ld_src + pc * 8); *(LAS v4u*)(scr + key * 144 + pc * 16) = w; }
    LDS_WAIT(); asm volatile("" ::: "memory");
#pragma unroll
    for (int q = 0; q < 8; ++q) { unsigned e[8];
#pragma unroll
        for (int i = 0; i < 8; ++i) e[i] = *(const LAS unsigned short*)(scr + (16 * (q >> 1) + 4 * (q & 1) + 8 * (i >> 2) + (i & 3)) * 144 + lane * 2);
        v4u w; w.x = e[0] | (e[1] << 16); w.y = e[2] | (e[3] << 16); w.z = e[4] | (e[5] << 16); w.w = e[6] | (e[7] << 16);
        *(v4u*)(dst + (size_t)lane * NKEY + 8 * q) = w; }
    LDS_WAIT(); asm volatile("" ::: "memory");
}
__device__ __forceinline__ int key_row(int b, int kk) { return kk < TC ? b * TC + kk : RC + b * TL + (kk - TC); }

__device__ __forceinline__ void post_win_tile(unsigned char* ws, LAS unsigned char* lds, int pm, int pn, int tid, int wave, int lane) {
    bf16* prj = (bf16*)(ws + WS_PRJ);
    if (pn >= 16 && pn <= 20) {
        if (pm < 2) return;
        const float* t2c = (const float*)(ws + WS_T2); const float* t2s = t2c + 64 * 32;
        for (int idx0 = tid; idx0 < 256 * 16; idx0 += 4 * NTHR) {
            v4u w1[4], w2[4]; bf16* bp[4]; int tb[4];
#pragma unroll
            for (int q = 0; q < 4; ++q) { const int idx = idx0 + q * NTHR; const int p = idx & 3, half = (idx >> 2) & 1, hh = (idx >> 3) & 1, i = idx >> 4;
                const int r = pm * 256 + i, t = (r - RC) & (TL - 1), posv = half ? (t & 63) : (t >> 6);
                bp[q] = prj + (size_t)r * EV_IN + 256 * pn + hh * 128 + half * 64 + 8 * p; tb[q] = posv * 32 + 8 * p;
                w1[q] = *(const v4u*)bp[q]; w2[q] = *(const v4u*)(bp[q] + 32); }
#pragma unroll
            for (int q = 0; q < 4; ++q) { float x1[8], x2[8], cs[8], sn[8], o1[8], o2[8];
                unpack8(w1[q], x1); unpack8(w2[q], x2); ld8f(t2c + tb[q], cs); ld8f(t2s + tb[q], sn);
#pragma unroll
                for (int e = 0; e < 8; ++e) { o1[e] = x1[e] * cs[e] - x2[e] * sn[e]; o2[e] = x2[e] * cs[e] + x1[e] * sn[e]; }
                *(v4u*)bp[q] = pack8(o1); *(v4u*)(bp[q] + 32) = pack8(o2); }
        }
    } else if (pn == 21) {
        bf16* vtw = (bf16*)(ws + WS_VTW); LAS unsigned char* scr = lds + wave * 16384;
        const int b = pm < 2 ? pm : ((pm - 2) >> 4), kt0 = pm < 2 ? 0 : 4 + ((pm - 2) & 15) * 4;
        for (int q = 0; q < 2; ++q) { const int it = wave * 2 + q, dvh = it & 1, kvh = (it >> 1) & 1, kt = kt0 + (it >> 2);
            const int row0 = key_row(b, 64 * kt);
            vt_tile(prj + (size_t)row0 * EV_IN + E_VW + kvh * 128 + dvh * 64, EV_IN, vtw + ((size_t)(b * 2 + kvh) * 128 + dvh * 64) * NKEY + 64 * kt, scr, lane); }
    }
}

__device__ __forceinline__ void ret_kv_unit(unsigned char* ws, const float* dec, LAS unsigned char* lds, int tid, int wave, int lane, int u) {
    const int bh = u / NCH, c = u % NCH, b = bh >> 3, h = bh & 7;
    const bool isctx = c < 2;
    const int row0 = isctx ? b * TC + c * 128 : RC + b * TL + (c - 2) * 128, pos0 = isctx ? 0 : (c - 2) * 128;
    const bf16* prj = (const bf16*)(ws + WS_PRJ);
    const float* t1c = (const float*)(ws + WS_T1C); const float* t1s = (const float*)(ws + WS_T1S);
    const float lf2 = lam_of(dec[h]) * LOG2E, lb2 = lam_of(dec[8 + h]) * LOG2E;
    LAS bf16* KTf = (LAS bf16*)lds; LAS bf16* KTb = KTf + 128 * 136; LAS bf16* VTs = KTb + 128 * 136;
    for (int it = tid; it < 1024; it += NTHR) { const int t = it & 127, p = it >> 7;
        const bf16* kr = prj + (size_t)(row0 + t) * EV_IN + E_KR + h * 128 + 8 * p;
        float x1[8], x2[8]; unpack8(*(const v4u*)kr, x1); unpack8(*(const v4u*)(kr + 64), x2);
        if (!isctx) { float cs[8], sn[8]; ld8f(t1c + (size_t)(pos0 + t) * 64 + 8 * p, cs); ld8f(t1s + (size_t)(pos0 + t) * 64 + 8 * p, sn);
#pragma unroll
            for (int e = 0; e < 8; ++e) { const float a1 = x1[e] * cs[e] - x2[e] * sn[e], a2 = x2[e] * cs[e] + x1[e] * sn[e]; x1[e] = a1; x2[e] = a2; } }
        const float ft = fexp2(lf2 * (float)(127 - t)), bt = fexp2(lb2 * (float)t);
#pragma unroll
        for (int e = 0; e < 8; ++e) { KTf[(8 * p + e) * 136 + t] = f2bf(x1[e] * ft); KTf[(64 + 8 * p + e) * 136 + t] = f2bf(x2[e] * ft);
            KTb[(8 * p + e) * 136 + t] = f2bf(x1[e] * bt); KTb[(64 + 8 * p + e) * 136 + t] = f2bf(x2[e] * bt); }
    }
    for (int it = tid; it < 2048; it += NTHR) { const int t = it & 127, p = it >> 7;
        const v4u w = *(const v4u*)(prj + (size_t)(row0 + t) * EV_IN + E_VR + h * 128 + 8 * p);
#pragma unroll
        for (int i = 0; i < 4; ++i) { VTs[(8 * p + 2 * i) * 136 + t] = (bf16)(w[i] & 0xffffu); VTs[(8 * p + 2 * i + 1) * 136 + t] = (bf16)(w[i] >> 16); }
    }
    __syncthreads();
    const int dir = wave >> 2, dvb = (wave & 3) * 32, fr = lane & 15, fq = lane >> 4;
    const LAS bf16* KT = dir ? KTb : KTf;
    f32x4 acc[2][8];
#pragma unroll
    for (int m = 0; m < 2; ++m)
#pragma unroll
        for (int n = 0; n < 8; ++n) acc[m][n] = (f32x4){0.f, 0.f, 0.f, 0.f};
#pragma unroll
    for (int s = 0; s < 4; ++s) {
        bf16x8 af[2];
#pragma unroll
        for (int m = 0; m < 2; ++m) af[m] = *(const LAS bf16x8*)(VTs + (dvb + 16 * m + fr) * 136 + 32 * s + 8 * fq);
#pragma unroll
        for (int n = 0; n < 8; ++n) { const bf16x8 bfr = *(const LAS bf16x8*)(KT + (16 * n + fr) * 136 + 32 * s + 8 * fq);
#pragma unroll
            for (int m = 0; m < 2; ++m) acc[m][n] = mfma16(af[m], bfr, acc[m][n]); }
    }
    float* o = (float*)(ws + WS_KVST) + ((size_t)(dir * 16 + bh) * NCH + c) * 16384;
#pragma unroll
    for (int m = 0; m < 2; ++m)
#pragma unroll
        for (int n = 0; n < 8; ++n)
#pragma unroll
            for (int r = 0; r < 4; ++r) o[(dvb + 16 * m + 4 * fq + r) * 128 + 16 * n + fr] = acc[m][n][r];
    __syncthreads();
}
__device__ __forceinline__ void ph_ret_scan(unsigned char* ws, const float* dec, int tid, int wg, int G) {
    for (int w = wg; w < 256; w += G) {
        const int s = w >> 3, slice = w & 7, dir = s >> 4, bh = s & 15, h = bh & 7;
        const float g = fexp2(lam_of(dec[dir * 8 + h]) * LOG2E * 128.f);
        const size_t e0 = (size_t)slice * 2048 + tid * 4;
        const float* kv = (const float*)(ws + WS_KVST) + (size_t)(dir * 16 + bh) * NCH * 16384 + e0;
        bf16* st = (bf16*)(ws + WS_ST) + (size_t)(dir * 16 + bh) * NCH * 16384 + e0;
        f32x4 S = {0.f, 0.f, 0.f, 0.f};
#pragma unroll
        for (int half = 0; half < 2; ++half) {
            f32x4 buf[17];
#pragma unroll
            for (int i = 0; i < 17; ++i) { const int k = half * 17 + i; const int c = dir ? (k == 0 ? 1 : (k == 1 ? 0 : 35 - k)) : k; buf[i] = *(const f32x4*)(kv + (size_t)c * 16384); }
#pragma unroll
            for (int i = 0; i < 17; ++i) { const int k = half * 17 + i; const int c = dir ? (k == 0 ? 1 : (k == 1 ? 0 : 35 - k)) : k;
                v2u q; q.x = pk2(S.x, S.y); q.y = pk2(S.z, S.w); *(v2u*)(st + (size_t)c * 16384) = q; S = S * g + buf[i]; }
        }
    }
}
__device__ __forceinline__ void ret_out_unit(unsigned char* ws, const float* dec, const float* gnw, LAS unsigned char* lds, int tid, int wave, int lane, int u) {
    const int bh = u / NCH, c = u % NCH, b = bh >> 3, h = bh & 7;
    const bool isctx = c < 2;
    const int row0 = isctx ? b * TC + c * 128 : RC + b * TL + (c - 2) * 128, pos0 = isctx ? 0 : (c - 2) * 128;
    const bf16* prj = (const bf16*)(ws + WS_PRJ);
    const float* t1c = (const float*)(ws + WS_T1C); const float* t1s = (const float*)(ws + WS_T1S);
    const float lf2 = lam_of(dec[h]) * LOG2E, lb2 = lam_of(dec[8 + h]) * LOG2E;
    const float scale = 0.088388347648318440f;
    LAS bf16* Qs = (LAS bf16*)lds; LAS bf16* Ks = Qs + 128 * 136; LAS bf16* VTs = Ks + 128 * 136; LAS bf16* Ps = VTs + 128 * 136;
    for (int it = tid; it < 1024; it += NTHR) { const int t = it >> 3, p = it & 7;
        const bf16* qr = prj + (size_t)(row0 + t) * EV_IN + E_QR + h * 128 + 8 * p; const bf16* kr = qr + (E_KR - E_QR);
        float q1[8], q2[8], k1[8], k2[8]; unpack8(*(const v4u*)qr, q1); unpack8(*(const v4u*)(qr + 64), q2); unpack8(*(const v4u*)kr, k1); unpack8(*(const v4u*)(kr + 64), k2);
        if (!isctx) { float cs[8], sn[8]; ld8f(t1c + (size_t)(pos0 + t) * 64 + 8 * p, cs); ld8f(t1s + (size_t)(pos0 + t) * 64 + 8 * p, sn);
#pragma unroll
            for (int e = 0; e < 8; ++e) { const float a1 = q1[e] * cs[e] - q2[e] * sn[e], a2 = q2[e] * cs[e] + q1[e] * sn[e]; q1[e] = a1; q2[e] = a2;
                const float b1 = k1[e] * cs[e] - k2[e] * sn[e], b2 = k2[e] * cs[e] + k1[e] * sn[e]; k1[e] = b1; k2[e] = b2; } }
        *(LAS v4u*)(Qs + t * 136 + 8 * p) = pack8(q1); *(LAS v4u*)(Qs + t * 136 + 64 + 8 * p) = pack8(q2);
        *(LAS v4u*)(Ks + t * 136 + 8 * p) = pack8(k1); *(LAS v4u*)(Ks + t * 136 + 64 + 8 * p) = pack8(k2);
    }
    for (int it = tid; it < 2048; it += NTHR) { const int t = it & 127, p = it >> 7;
        const v4u w = *(const v4u*)(prj + (size_t)(row0 + t) * EV_IN + E_VR + h * 128 + 8 * p);
#pragma unroll
        for (int i = 0; i < 4; ++i) { VTs[(8 * p + 2 * i) * 136 + t] = (bf16)(w[i] & 0xffffu); VTs[(8 * p + 2 * i + 1) * 136 + t] = (bf16)(w[i] >> 16); }
    }
    __syncthreads();
    v4u streg[2][4];
    { const bf16* st0 = (const bf16*)(ws + WS_ST) + ((size_t)bh * NCH + c) * 16384;
#pragma unroll
      for (int dir = 0; dir < 2; ++dir)
#pragma unroll
          for (int j = 0; j < 4; ++j) streg[dir][j] = *(const v4u*)(st0 + (size_t)dir * 16 * NCH * 16384 + (size_t)(tid + NTHR * j) * 8); }
    const int i0 = 16 * wave, fr = lane & 15, fq = lane >> 4;
    bf16x8 qa[4];
#pragma unroll
    for (int s = 0; s < 4; ++s) qa[s] = *(const LAS bf16x8*)(Qs + (i0 + fr) * 136 + 32 * s + 8 * fq);
#pragma unroll
    for (int n = 0; n < 8; ++n) { f32x4 sa = {0.f, 0.f, 0.f, 0.f};
#pragma unroll
        for (int s = 0; s < 4; ++s) { const bf16x8 kb = *(const LAS bf16x8*)(Ks + (16 * n + fr) * 136 + 32 * s + 8 * fq); sa = mfma16(qa[s], kb, sa); }
#pragma unroll
        for (int r = 0; r < 4; ++r) { const int d = (i0 + 4 * fq + r) - (16 * n + fr);
            const float dcy = d >= 0 ? fexp2(lf2 * (float)d) : fexp2(lb2 * (float)(-d));
            Ps[(i0 + 4 * fq + r) * 136 + 16 * n + fr] = f2bf(sa[r] * scale * dcy); }
    }
    LDS_WAIT(); asm volatile("" ::: "memory");
    f32x4 O[8];
#pragma unroll
    for (int n = 0; n < 8; ++n) O[n] = (f32x4){0.f, 0.f, 0.f, 0.f};
#pragma unroll
    for (int s = 0; s < 4; ++s) { const bf16x8 pa = *(const LAS bf16x8*)(Ps + (i0 + fr) * 136 + 32 * s + 8 * fq);
#pragma unroll
        for (int n = 0; n < 8; ++n) { const bf16x8 vb = *(const LAS bf16x8*)(VTs + (16 * n + fr) * 136 + 32 * s + 8 * fq); O[n] = mfma16(pa, vb, O[n]); } }
    __syncthreads();
#pragma unroll
    for (int dir = 0; dir < 2; ++dir)
#pragma unroll
        for (int j = 0; j < 4; ++j) { const int e = (tid + NTHR * j) * 8, dvr = e >> 7, dkc = e & 127; *(LAS v4u*)((dir ? Qs : Ks) + dvr * 136 + dkc) = streg[dir][j]; }
    __syncthreads();
#pragma unroll
    for (int dir = 0; dir < 2; ++dir) {
        const LAS bf16* st = dir ? Qs : Ks;
        f32x4 T[8];
#pragma unroll
        for (int n = 0; n < 8; ++n) T[n] = (f32x4){0.f, 0.f, 0.f, 0.f};
#pragma unroll
        for (int s = 0; s < 4; ++s)
#pragma unroll
            for (int n = 0; n < 8; ++n) { const bf16x8 sb = *(const LAS bf16x8*)(st + (16 * n + fr) * 136 + 32 * s + 8 * fq); T[n] = mfma16(qa[s], sb, T[n]); }
#pragma unroll
        for (int r = 0; r < 4; ++r) { const int il = i0 + 4 * fq + r; const float fac = scale * (dir == 0 ? fexp2(lf2 * (float)(il + 1)) : fexp2(lb2 * (float)(128 - il)));
#pragma unroll
            for (int n = 0; n < 8; ++n) O[n][r] += T[n][r] * fac; }
    }
    bf16* mix = (bf16*)(ws + WS_MIX);
    unsigned short gtv[4][8]; float gw8[8];
#pragma unroll
    for (int n = 0; n < 8; ++n) gw8[n] = gnw[h * 128 + 16 * n + fr];
#pragma unroll
    for (int r = 0; r < 4; ++r)
#pragma unroll
        for (int n = 0; n < 8; ++n) gtv[r][n] = prj[(size_t)(row0 + i0 + 4 * fq + r) * EV_IN + E_GR + h * 128 + 16 * n + fr];
#pragma unroll
    for (int r = 0; r < 4; ++r) {
        float s1 = 0.f;
#pragma unroll
        for (int n = 0; n < 8; ++n) s1 += O[n][r];
        s1 += __shfl_xor(s1, 1); s1 += __shfl_xor(s1, 2); s1 += __shfl_xor(s1, 4); s1 += __shfl_xor(s1, 8);
        const float mu = s1 * (1.f / 128.f);
        float s2 = 0.f;
#pragma unroll
        for (int n = 0; n < 8; ++n) { const float d = O[n][r] - mu; s2 += d * d; }
        s2 += __shfl_xor(s2, 1); s2 += __shfl_xor(s2, 2); s2 += __shfl_xor(s2, 4); s2 += __shfl_xor(s2, 8);
        const float rstd = 1.f / sqrtf(s2 * (1.f / 128.f) + EPS);
        const int row = row0 + i0 + 4 * fq + r;
#pragma unroll
        for (int n = 0; n < 8; ++n) { const int dv = 16 * n + fr; const float gt = bf2f(gtv[r][n]);
            const float y = (O[n][r] - mu) * rstd * gw8[n] * (gt / (1.f + __expf(-gt)));
            mix[(size_t)row * DM + h * 128 + dv] = f2bf(y); }
    }
    __syncthreads();
}

template <int DQK, bool WINDOW, bool SINK>
__device__ __forceinline__ void attn_unit(LAS unsigned char* lds, int tid, int wave, int lane,
        const bf16* Qp, int ldq, const bf16* Kc, const bf16* Kl, int ldk, const bf16* K2c, const bf16* K2l, int ldk2, const bf16* VT,
        int nctx, int tlo, int thi, int q0, float sc_log2, float sink_log2, bf16* Op, int ldo) {
    constexpr int KS = DQK * 2 + 16, KT_BYTES = 64 * KS, VS = 144, VT_BYTES = 128 * VS, BUF = KT_BYTES + VT_BYTES;
    constexpr int NS = DQK / 16, KPT = DQK / 64;
    const int c = lane & 31, h = lane >> 5;
    bf16x8 qf[NS];
    { const bf16* qr = Qp + (size_t)(wave * 32 + c) * ldq + 8 * h;
#pragma unroll
      for (int s = 0; s < NS; ++s) qf[s] = *(const bf16x8*)(qr + 16 * s); }
    f32x16 oT[4];
#pragma unroll
    for (int dt = 0; dt < 4; ++dt)
#pragma unroll
        for (int r = 0; r < 16; ++r) oT[dt][r] = 0.f;
    float m_run = SINK ? sink_log2 : -1e30f, l_run = (SINK && h == 0) ? 1.f : 0.f;
    const int ntile = nctx + (thi - tlo);
    v4u kregA[KPT], vregA[2], kregB[KPT], vregB[2];
    const unsigned koff0 = (unsigned)((tid >> 4) * ldk + (tid & 15) * 8), koff1 = koff0 + 32u * (unsigned)ldk, koff2 = (unsigned)((tid >> 3) * ldk2 + (tid & 7) * 8);
    const unsigned voff0 = (unsigned)((tid >> 3) * NKEY + (tid & 7) * 8), voff1 = voff0 + 64u * NKEY;
    const int klds0 = (tid >> 4) * KS + (tid & 15) * 16, klds2 = (tid >> 3) * KS + 256 + (tid & 7) * 16, vlds0 = (tid >> 3) * VS + (tid & 7) * 16;
#define ATT_LOAD(i_, kreg, vreg) do { int _i = (i_); if (_i > ntile - 1) _i = ntile - 1; const bool _cx = _i < nctx; const int _t = _cx ? _i : tlo + (_i - nctx); \
        const bf16* _k = (_cx ? Kc : Kl) + (size_t)(64 * _t) * ldk; const int _vc = _cx ? 64 * _t : TC + 64 * _t; \
        kreg[0] = *(const v4u*)(_k + koff0); kreg[1] = *(const v4u*)(_k + koff1); \
        if (DQK > 128) { const bf16* _k2 = (_cx ? K2c : K2l) + (size_t)(64 * _t) * ldk2; kreg[KPT - 1] = *(const v4u*)(_k2 + koff2); } \
        vreg[0] = *(const v4u*)(VT + voff0 + _vc); vreg[1] = *(const v4u*)(VT + voff1 + _vc); } while (0)
#define ATT_STORE(buf_, kreg, vreg) do { LAS unsigned char* _kb = lds + (buf_) * BUF; LAS unsigned char* _vb = _kb + KT_BYTES; \
        *(LAS v4u*)(_kb + klds0) = kreg[0]; *(LAS v4u*)(_kb + klds0 + 32 * KS) = kreg[1]; \
        if (DQK > 128) *(LAS v4u*)(_kb + klds2) = kreg[KPT - 1]; \
        *(LAS v4u*)(_vb + vlds0) = vreg[0]; *(LAS v4u*)(_vb + vlds0 + 64 * VS) = vreg[1]; } while (0)
#define ATT_THR 8.0f
#define ATT_COMPUTE(i) do { \
        if (WINDOW && (i) >= nctx) { const int _k0 = 64 * (tlo + ((i) - nctx)), _qw = q0 + wave * 32; if (_k0 > _qw + 159 || _k0 + 63 < _qw - 128) break; }     \
        const LAS unsigned char* kb = lds + (i & 1) * BUF; const LAS unsigned char* vb = kb + KT_BYTES; \
        f32x16 sT[2]; \
        _Pragma("unroll") \
        for (int kt = 0; kt < 2; ++kt) \
        _Pragma("unroll") \
            for (int r = 0; r < 16; ++r) sT[kt][r] = 0.f; \
        { \
            constexpr int PF = 4, NQ = 2 * NS; \
            bf16x8 kf[PF]; \
        _Pragma("unroll") \
            for (int n = 0; n < PF; ++n) kf[n] = *(const LAS bf16x8*)(kb + (32 * (n / NS) + c) * KS + (16 * (n % NS) + 8 * h) * 2); \
        _Pragma("unroll") \
            for (int n = 0; n < NQ; ++n) { const bf16x8 ka = kf[n % PF]; \
                if (n + PF < NQ) kf[n % PF] = *(const LAS bf16x8*)(kb + (32 * ((n + PF) / NS) + c) * KS + (16 * ((n + PF) % NS) + 8 * h) * 2); \
                sT[n / NS] = mfma32(ka, qf[n % NS], sT[n / NS]); } \
        } \
        const bool msk = WINDOW && (i >= nctx); \
        const int kpos0 = 64 * (tlo + (i - nctx)), qpos = q0 + wave * 32 + c; \
        float mx = -1e38f; \
        _Pragma("unroll") \
        for (int kt = 0; kt < 2; ++kt) \
        _Pragma("unroll") \
            for (int r = 0; r < 16; ++r) { \
                if (WINDOW) { const int kpos = kpos0 + 32 * kt + (r & 3) + 8 * (r >> 2) + 4 * h; const int dd = qpos - kpos; if (msk && (dd > 128 || dd < -128)) sT[kt][r] = -1e38f; } \
                mx = fmaxf(mx, sT[kt][r]); } \
        mx = fmaxf(mx, __shfl_xor(mx, 32)); \
        const float mxs = mx * sc_log2; \
        if (__builtin_amdgcn_ballot_w64(mxs > m_run + ATT_THR) != 0ull) {     \
            const float mn = fmaxf(m_run, mxs), alpha = fexp2(m_run - mn); \
            m_run = mn; l_run *= alpha; \
            _Pragma("unroll") \
            for (int dt = 0; dt < 4; ++dt) \
            _Pragma("unroll") \
                for (int r = 0; r < 16; ++r) oT[dt][r] *= alpha; \
        } \
        float ps = 0.f; \
        _Pragma("unroll") \
        for (int kt = 0; kt < 2; ++kt) \
        _Pragma("unroll") \
            for (int r = 0; r < 16; ++r) { const float pv = fexp2(fmaf(sT[kt][r], sc_log2, -m_run)); sT[kt][r] = pv; ps += pv; } \
        l_run += ps; \
        bf16x8 pf[4]; \
        _Pragma("unroll") \
        for (int s = 0; s < 4; ++s) { const int kt = s >> 1, s8 = (s & 1) * 8; v4u w; \
            w.x = pk2(sT[kt][s8 + 0], sT[kt][s8 + 1]); w.y = pk2(sT[kt][s8 + 2], sT[kt][s8 + 3]); w.z = pk2(sT[kt][s8 + 4], sT[kt][s8 + 5]); w.w = pk2(sT[kt][s8 + 6], sT[kt][s8 + 7]); \
            pf[s] = __builtin_bit_cast(bf16x8, w); } \
        { \
            constexpr int PF = 4; \
            v4u vf[PF]; \
        _Pragma("unroll") \
            for (int n = 0; n < PF; ++n) vf[n] = *(const LAS v4u*)(vb + (32 * (n >> 2) + c) * VS + (16 * (n & 3) + 8 * h) * 2); \
        _Pragma("unroll") \
            for (int n = 0; n < 16; ++n) { const v4u va = vf[n % PF]; \
                if (n + PF < 16) { const int n2 = n + PF; vf[n % PF] = *(const LAS v4u*)(vb + (32 * (n2 >> 2) + c) * VS + (16 * (n2 & 3) + 8 * h) * 2); } \
                oT[n >> 2] = mfma32(__builtin_bit_cast(bf16x8, va), pf[n & 3], oT[n >> 2]); } \
        } \
    } while (0)
    if (ntile > 0) { ATT_LOAD(0, kregA, vregA); ATT_STORE(0, kregA, vregA); ATT_LOAD(1, kregB, vregB); }
    __syncthreads();
    for (int i = 0; i < ntile; i += 2) {
        ATT_LOAD(i + 2, kregA, vregA);
        ATT_COMPUTE(i);
        ATT_STORE((i + 1) & 1, kregB, vregB);
        __syncthreads();
        if (i + 1 < ntile) {
            ATT_LOAD(i + 3, kregB, vregB);
            ATT_COMPUTE(i + 1);
            ATT_STORE(i & 1, kregA, vregA);
            __syncthreads();
        }
    }
#undef ATT_COMPUTE
#undef ATT_THR
#undef ATT_LOAD
#undef ATT_STORE
    const float lt = l_run + __shfl_xor(l_run, 32), inv = 1.f / lt;
    bf16* orow = Op + (size_t)(wave * 32 + c) * ldo + 4 * h;
#pragma unroll
    for (int dt = 0; dt < 4; ++dt)
#pragma unroll
        for (int rq = 0; rq < 4; ++rq) { v2u w; w.x = pk2(oT[dt][4 * rq] * inv, oT[dt][4 * rq + 1] * inv); w.y = pk2(oT[dt][4 * rq + 2] * inv, oT[dt][4 * rq + 3] * inv);
            *(v2u*)(orow + 32 * dt + 8 * rq) = w; }
}

__device__ __forceinline__ void ph_win(unsigned char* ws, const float* sink, LAS unsigned char* lds, int tid, int wave, int lane, int wg, int G) {
    const bf16* prj = (const bf16*)(ws + WS_PRJ); bf16* mix = (bf16*)(ws + WS_MIX); const bf16* vtw = (const bf16*)(ws + WS_VTW);
    const float scl = 0.088388347648318440f * LOG2E;
    for (int u = wg; u < 272; u += G) {
        const bool cx = u >= 256;
        const int pair = cx ? (u - 256) : ((u & 7) * 2 + (u >> 7)), qb = (u >> 3) & 15, b = pair >> 3, hq = pair & 7, kvh = hq >> 2;
        const int q0 = cx ? 0 : qb * 256; int tlo = (q0 - 128) / 64; if (tlo < 0) tlo = 0; int thi = (q0 + 383) / 64 + 1; if (thi > 64) thi = 64; if (cx) { tlo = 0; thi = 0; }
        const int qrow = cx ? b * TC : RC + b * TL + q0;
        attn_unit<128, true, true>(lds, tid, wave, lane, prj + (size_t)qrow * EV_IN + E_QW + hq * 128, EV_IN,
            prj + (size_t)(b * TC) * EV_IN + E_KW + kvh * 128, prj + (size_t)(RC + b * TL) * EV_IN + E_KW + kvh * 128, EV_IN, nullptr, nullptr, 0,
            vtw + (size_t)(b * 2 + kvh) * 128 * NKEY, 4, tlo, thi, q0, scl, sink[hq] * LOG2E, mix + (size_t)qrow * DM + 1024 + hq * 128, DM);
    }
}
__device__ __forceinline__ void ph_ret_out(unsigned char* ws, const float* dec, const float* gnw, LAS unsigned char* lds, int tid, int wave, int lane, int wg, int G) {
    for (int u = (wg + G - 32) % G; u < 16 * NCH; u += G) ret_out_unit(ws, dec, gnw, lds, tid, wave, lane, u);
}

__device__ __forceinline__ void ph_prep_odd(unsigned char* ws, LAS unsigned char* lds, const float* convw, const float* qnw, const float* kvnw, int jl, int tid, int wave, int lane, int wg, int G) {
    const bf16* prj = (const bf16*)(ws + WS_PRJ); bf16* mix = (bf16*)(ws + WS_MIX);
    {
        const bf16* a1 = (const bf16*)(ws + WS_A1); const bf16* wk = (const bf16*)(ws + WS_WKRT) + (size_t)jl * 64 * DM; bf16* kr = (bf16*)(ws + WS_KR);
        const int fr = lane & 15, fq = lane >> 4;
        LAS f32x4* red = (LAS f32x4*)lds;
        for (int t = wg; t < RALL / 32; t += G) {
            f32x4 acc[2][4];
#pragma unroll
            for (int m = 0; m < 2; ++m)
#pragma unroll
                for (int n = 0; n < 4; ++n) acc[m][n] = (f32x4){0.f, 0.f, 0.f, 0.f};
            const bf16* ap = a1 + (size_t)(32 * t + fr) * DM + 256 * wave + 8 * fq; const bf16* bp = wk + (size_t)fr * DM + 256 * wave + 8 * fq;
#pragma unroll
            for (int s = 0; s < 8; ++s) { bf16x8 af[2], bfr[4];
#pragma unroll
                for (int m = 0; m < 2; ++m) af[m] = *(const bf16x8*)(ap + (size_t)(16 * m) * DM + 32 * s);
#pragma unroll
                for (int n = 0; n < 4; ++n) bfr[n] = *(const bf16x8*)(bp + (size_t)(16 * n) * DM + 32 * s);
#pragma unroll
                for (int m = 0; m < 2; ++m)
#pragma unroll
                    for (int n = 0; n < 4; ++n) acc[m][n] = mfma16(af[m], bfr[n], acc[m][n]); }
#pragma unroll
            for (int m = 0; m < 2; ++m)
#pragma unroll
                for (int n = 0; n < 4; ++n) red[(wave * 8 + m * 4 + n) * 64 + lane] = acc[m][n];
            __syncthreads();
            { const int m = wave >> 2, n = wave & 3; f32x4 sacc = red[(0 * 8 + wave) * 64 + lane];
#pragma unroll
              for (int w = 1; w < 8; ++w) sacc += red[(w * 8 + wave) * 64 + lane];
#pragma unroll
              for (int r = 0; r < 4; ++r) kr[(size_t)(32 * t + 16 * m + 4 * fq + r) * 64 + 16 * n + fr] = f2bf(sacc[r]); }
            __syncthreads();
        }
    }
    const int gt = wg * NTHR + tid, NGT = G * NTHR;
    const bool wfix = (NGT & 127) == 0;
    float w0[8], w1[8], w2[8];
    if (wfix) { const int c0 = (gt & 127) * 8; ld8f(convw + c0, w0); ld8f(convw + 1024 + c0, w1); ld8f(convw + 2048 + c0, w2); }
    for (int idx0 = gt; idx0 < RALL * 128; idx0 += 3 * NGT) {
        v4u wb[3], wc[3][3], wx[3][3];
#pragma unroll
        for (int b = 0; b < 3; ++b) { const int idx = idx0 + b * NGT; if (idx < RALL * 128) {
            const int r = idx >> 7, c0 = (idx & 127) * 8;
            int t, T; if (r < RC) { t = r & (TC - 1); T = TC; } else { t = (r - RC) & (TL - 1); T = TL; }
            const bf16* pr = prj + (size_t)r * OD_INP;
            wb[b] = *(const v4u*)(pr + O_BG + c0); wc[b][1] = *(const v4u*)(pr + O_CG + c0); wx[b][1] = *(const v4u*)(pr + O_XV + c0);
            if (t > 0) { wc[b][0] = *(const v4u*)(pr - OD_INP + O_CG + c0); wx[b][0] = *(const v4u*)(pr - OD_INP + O_XV + c0); } else { wc[b][0] = (v4u){0u, 0u, 0u, 0u}; wx[b][0] = wc[b][0]; }
            if (t < T - 1) { wc[b][2] = *(const v4u*)(pr + OD_INP + O_CG + c0); wx[b][2] = *(const v4u*)(pr + OD_INP + O_XV + c0); } else { wc[b][2] = (v4u){0u, 0u, 0u, 0u}; wx[b][2] = wc[b][2]; } } }
#pragma unroll
        for (int b = 0; b < 3; ++b) { const int idx = idx0 + b * NGT; if (idx < RALL * 128) {
            const int r = idx >> 7, c0 = (idx & 127) * 8;
            float bg[8], u0[8], u1[8], u2[8], a[8], b2[8], y[8];
            unpack8(wb[b], bg);
            unpack8(wc[b][0], a); unpack8(wx[b][0], b2);
#pragma unroll
            for (int e = 0; e < 8; ++e) u0[e] = a[e] * b2[e];
            unpack8(wc[b][1], a); unpack8(wx[b][1], b2);
#pragma unroll
            for (int e = 0; e < 8; ++e) u1[e] = a[e] * b2[e];
            unpack8(wc[b][2], a); unpack8(wx[b][2], b2);
#pragma unroll
            for (int e = 0; e < 8; ++e) u2[e] = a[e] * b2[e];
            if (!wfix) { ld8f(convw + c0, w0); ld8f(convw + 1024 + c0, w1); ld8f(convw + 2048 + c0, w2); }
#pragma unroll
            for (int e = 0; e < 8; ++e) y[e] = bg[e] * (u0[e] * w0[e] + u1[e] * w1[e] + u2[e] * w2[e]);
            *(v4u*)(mix + (size_t)r * DM + c0) = pack8(y); } }
    }
    bf16* cqn = (bf16*)(ws + WS_CQN); bf16* ckvn = (bf16*)(ws + WS_CKVN);
    const int gw = wg * NWAVES + wave, NGW = G * NWAVES;
    float qw8[8]; ld8f(qnw + 8 * lane, qw8); const f32x4 kw4 = *(const f32x4*)(kvnw + 4 * lane);
    for (int r0 = gw; r0 < RALL; r0 += 5 * NGW) {
        v4u wq[5]; v2u wk[5];
#pragma unroll
        for (int b = 0; b < 5; ++b) { const int r = r0 + b * NGW; if (r < RALL) { const bf16* pr = prj + (size_t)r * OD_INP; wq[b] = *(const v4u*)(pr + O_CQ + 8 * lane); wk[b] = *(const v2u*)(pr + O_CKV + 4 * lane); } }
#pragma unroll
        for (int b = 0; b < 5; ++b) { const int r = r0 + b * NGW; if (r < RALL) {
            float q[8]; unpack8(wq[b], q);
            float ss = 0.f;
#pragma unroll
            for (int e = 0; e < 8; ++e) ss += q[e] * q[e];
            ss = wave_sum(ss);
            const float rs = 1.f / sqrtf(ss * (1.f / 512.f) + EPS);
#pragma unroll
            for (int e = 0; e < 8; ++e) q[e] = q[e] * rs * qw8[e];
            *(v4u*)(cqn + (size_t)r * 512 + 8 * lane) = pack8(q);
            const v2u kw = wk[b];
            const float k0 = bflo(kw.x), k1 = bfhi(kw.x), k2 = bflo(kw.y), k3 = bfhi(kw.y);
            float s2 = wave_sum(k0 * k0 + k1 * k1 + k2 * k2 + k3 * k3);
            const float rs2 = 1.f / sqrtf(s2 * (1.f / 256.f) + EPS);
            v2u o; o.x = pk2(k0 * rs2 * kw4.x, k1 * rs2 * kw4.y); o.y = pk2(k2 * rs2 * kw4.z, k3 * rs2 * kw4.w);
            *(v2u*)(ckvn + (size_t)r * 256 + 4 * lane) = o; } }
    }
}
__device__ __forceinline__ void rope64_item(bf16* blk, int t, int half, int p, const float* t3c, const float* t3s) {
    const int posv = half ? (t & 63) : (t >> 6); bf16* bp = blk + half * 32 + 8 * p; const int tb = posv * 16 + 8 * p;
    const v4u w1 = *(const v4u*)bp, w2 = *(const v4u*)(bp + 16);
    float x1[8], x2[8], cs[8], sn[8], o1[8], o2[8];
    unpack8(w1, x1); unpack8(w2, x2); ld8f(t3c + tb, cs); ld8f(t3s + tb, sn);
#pragma unroll
    for (int e = 0; e < 8; ++e) { o1[e] = x1[e] * cs[e] - x2[e] * sn[e]; o2[e] = x2[e] * cs[e] + x1[e] * sn[e]; }
    *(v4u*)bp = pack8(o1); *(v4u*)(bp + 16) = pack8(o2);
}
__device__ __forceinline__ void ph_rope_kr(unsigned char* ws, int tid, int wg, int G) {
    bf16* krb = (bf16*)(ws + WS_KR); const float* t3c = (const float*)(ws + WS_T2) + 2 * 64 * 32; const float* t3s = t3c + 64 * 16;
    for (int idx = wg * NTHR + tid; idx < NB * TL * 4; idx += G * NTHR) { const int p = idx & 1, half = (idx >> 1) & 1, rl = idx >> 2;
        rope64_item(krb + (size_t)(RC + rl) * 64, rl & (TL - 1), half, p, t3c, t3s); }
}
__device__ __forceinline__ void post_q_tile(unsigned char* ws, int pm, int pn, int tid) {
    if (pm < 2) return;
    bf16* qraw = (bf16*)(ws + WS_QRAW); const float* t3c = (const float*)(ws + WS_T2) + 2 * 64 * 32; const float* t3s = t3c + 64 * 16;
    for (int h = 0; h < 8; ++h) { const int c0 = 192 * h + 128; if (c0 < 256 * pn || c0 >= 256 * pn + 256) continue;
        for (int idx = tid; idx < 1024; idx += NTHR) { const int p = idx & 1, half = (idx >> 1) & 1, i = idx >> 2; const int r = pm * 256 + i;
            rope64_item(qraw + (size_t)r * 1536 + c0, (r - RC) & (TL - 1), half, p, t3c, t3s); } }
}
__device__ __forceinline__ void post_v_tile(unsigned char* ws, LAS unsigned char* lds, int b, int hh, int kt0, int wave, int lane) {
    const bf16* kvraw = (const bf16*)(ws + WS_KVRAW); bf16* vtm = (bf16*)(ws + WS_VTM); LAS unsigned char* scr = lds + wave * 16384;
    const int kt = kt0 + (wave >> 1), dvh = wave & 1, row0 = key_row(b, 64 * kt);
    vt_tile(kvraw + (size_t)row0 * 2048 + hh * 256 + 128 + dvh * 64, 2048, vtm + ((size_t)(b * 8 + hh) * 128 + dvh * 64) * NKEY + 64 * kt, scr, lane);
}
__device__ __forceinline__ void ph_mix_odd(unsigned char* ws, LAS unsigned char* lds, int nunits, int tid, int wave, int lane, int wg, int G) {
    const bf16* krb = (const bf16*)(ws + WS_KR); bf16* mix = (bf16*)(ws + WS_MIX); const bf16* vtm = (const bf16*)(ws + WS_VTM);
    const bf16* qraw = (const bf16*)(ws + WS_QRAW); const bf16* kvraw = (const bf16*)(ws + WS_KVRAW);
    const float scl = 0.072168783648703220f * LOG2E;
    for (int u = wg; u < nunits; u += G) {
        const bool cx = u >= 256;
        const int pair = cx ? (u - 256) : ((u & 7) * 2 + (u >> 7)), qb = (u >> 3) & 15, b = pair >> 3, hh = pair & 7;
        const int q0 = cx ? 0 : qb * 256, qrow = cx ? b * TC : RC + b * TL + q0;
        attn_unit<192, false, false>(lds, tid, wave, lane, qraw + (size_t)qrow * 1536 + hh * 192, 1536,
            kvraw + (size_t)(b * TC) * 2048 + hh * 256, kvraw + (size_t)(RC + b * TL) * 2048 + hh * 256, 2048,
            krb + (size_t)(b * TC) * 64, krb + (size_t)(RC + b * TL) * 64, 64,
            vtm + (size_t)(b * 8 + hh) * 128 * NKEY, 4, 0, cx ? 0 : 64, q0, scl, 0.f, mix + (size_t)qrow * DM + 1024 + hh * 128, DM);
    }
}

#define NOINL static __device__ __forceinline__
typedef const GAS float* gcf;
typedef GAS unsigned char* gws;
typedef const GAS unsigned short* gcb;
__device__ __forceinline__ int mk_lane() { int l; asm volatile("v_mbcnt_lo_u32_b32 %0, -1, 0\n\tv_mbcnt_hi_u32_b32 %0, -1, %0" : "=v"(l)); return l; }
#define PH_IDS int wv_ = wave_in; asm volatile("" : "+s"(wv_)); const int wave = wv_, lane = mk_lane(), tid = wave * 64 + lane, G = gridDim.x, wg = blockIdx.x; (void)lane; (void)wave; (void)G; (void)wg; (void)tid
#define PH_GW const int gw = wg * NWAVES + wave, NGW = G * NWAVES

__device__ __forceinline__ int uni(int v) { return __builtin_amdgcn_readfirstlane(v); }
template <class T> __device__ __forceinline__ GAS T* uni(GAS T* p) { const unsigned long long v = (unsigned long long)p; const unsigned lo = (unsigned)__builtin_amdgcn_readfirstlane((int)(unsigned)v), hi = (unsigned)__builtin_amdgcn_readfirstlane((int)(unsigned)(v >> 32));
    return (GAS T*)(((unsigned long long)hi << 32) | lo); }
template <class T> __device__ __forceinline__ LAS T* uni(LAS T* p) { return (LAS T*)(unsigned)__builtin_amdgcn_readfirstlane((int)(unsigned)(unsigned long long)p); }
#define U(x) x = uni(x)
#define OPQ(x) asm volatile("" : "+s"(x))

NOINL void f_prologue(int wave_in, gws ws, LAS unsigned char* lds, gcf x, gcf c, gcf ctx, gcf c_ctx, gcf w_mod, gcf b_mod, gcf mlp_w1, gcf mlp_w2, gcf ev_w_in, gcf ev_w_out, gcf od_w_in, gcf od_w_out, gcf od_w_uq, gcf od_w_ukv) {
    PH_IDS; U(ws); U(lds); U(x); U(c); U(ctx); U(c_ctx); U(w_mod); U(b_mod); U(mlp_w1); U(mlp_w2); U(ev_w_in); U(ev_w_out); U(od_w_in); U(od_w_out); U(od_w_uq); U(od_w_ukv);
    ProIn p{(const float*)x, (const float*)c, (const float*)ctx, (const float*)c_ctx, (const float*)w_mod, (const float*)b_mod, (const float*)mlp_w1, (const float*)mlp_w2, (const float*)ev_w_in, (const float*)ev_w_out,
            (const float*)od_w_in, (const float*)od_w_out, (const float*)od_w_uq, (const float*)od_w_ukv};
    ph_prologue(p, (unsigned char*)ws, lds, tid, wave, lane, wg, G);
}
NOINL void f_norm(int wave_in, gws ws, LAS unsigned char* lds, gcf nw, gcf ctx32, gcf x32, int layer, int ch_sh, int ch_sc, int mode) {
    PH_IDS; PH_GW; U(ws); U(lds); U(nw); U(ctx32); U(x32); U(layer); U(ch_sh); U(ch_sc); U(mode);
    const float* mod_l = (const float*)(ws + WS_MOD) + (size_t)layer * 3 * 12288;
    bf16* Hb = (bf16*)(ws + WS_H);
    if (mode == 1) ph_norm_ctx<S_MLP>(nullptr, Hb, (const float*)nw, mod_l, ch_sh, ch_sc, (bf16*)(ws + WS_A1), (const bf16*)(ws + WS_PARTM), mod_l - 3 * 12288 + (2 * 6 + 5) * DM, lds, tid, wave, lane, wg, G);
    if (mode == 2) ph_norm_ctx<S_OUT>(layer == 0 ? (const float*)ctx32 : nullptr, Hb, (const float*)nw, mod_l, ch_sh, ch_sc, (bf16*)(ws + WS_A1), (const bf16*)(ws + WS_PARTO), mod_l + (2 * 6 + 2) * DM, lds, tid, wave, lane, wg, G);
    __syncthreads();
    ph_norm(mode == 0, (const float*)ctx32, (const float*)x32, Hb, (const float*)nw, mod_l, ch_sh, ch_sc, (bf16*)(ws + WS_A1), mode == 0 ? 0 : RC, lds, tid, gw, NGW, lane);
}
NOINL void f_final(int wave_in, gws ws, gcf nw, GAS float* out) { PH_IDS; PH_GW; U(ws); U(nw); U(out); ph_final((const bf16*)(ws + WS_H), (const float*)nw, (float*)out, gw, NGW, lane); }
NOINL void f_post_win(int wave_in, gws ws, LAS unsigned char* lds) { PH_IDS; U(ws); U(lds); VM_WAIT(); __syncthreads();
    pg8::StaticOrder S; S.init(RALL, EV_IN, G, wg, DM); pg8::Unit u;
    for (int i = 0; S.next(i, u); ++i) { post_win_tile((unsigned char*)ws, lds, u.pm, u.pn, tid, wave, lane); } }
NOINL void f_ret_kv(int wave_in, gws ws, LAS unsigned char* lds, gcf dec) { PH_IDS; U(ws); U(lds); U(dec); for (int u = wg; u < 16 * NCH; u += G) ret_kv_unit((unsigned char*)ws, (const float*)dec, lds, tid, wave, lane, u); }
NOINL void f_ret_scan(int wave_in, gws ws, gcf dec) { PH_IDS; U(ws); U(dec); ph_ret_scan((unsigned char*)ws, (const float*)dec, tid, wg, G); }
NOINL void f_win(int wave_in, gws ws, LAS unsigned char* lds, gcf sink) { PH_IDS; U(ws); U(lds); U(sink); ph_win((unsigned char*)ws, (const float*)sink, lds, tid, wave, lane, wg, G); }
NOINL void f_ret_out(int wave_in, gws ws, LAS unsigned char* lds, gcf dec, gcf gnw) { PH_IDS; U(ws); U(lds); U(dec); U(gnw); ph_ret_out((unsigned char*)ws, (const float*)dec, (const float*)gnw, lds, tid, wave, lane, wg, G); }
NOINL void f_prep_odd(int wave_in, gws ws, LAS unsigned char* lds, gcf convw, gcf qnw, gcf kvnw, int jl) { PH_IDS; U(ws); U(lds); U(convw); U(qnw); U(kvnw); U(jl); ph_prep_odd((unsigned char*)ws, lds, (const float*)convw, (const float*)qnw, (const float*)kvnw, jl, tid, wave, lane, wg, G); }
NOINL void f_rope_kr(int wave_in, gws ws) { PH_IDS; U(ws); ph_rope_kr((unsigned char*)ws, tid, wg, G); }
NOINL void f_post_q(int wave_in, gws ws) { PH_IDS; U(ws); VM_WAIT(); __syncthreads();
    pg8::StaticOrder S; S.init(RALL, 1536, G, wg, 512); pg8::Unit u; for (int i = 0; S.next(i, u); ++i) post_q_tile((unsigned char*)ws, u.pm, u.pn, tid); }
NOINL void f_post_v(int wave_in, gws ws, LAS unsigned char* lds) { PH_IDS; U(ws); U(lds); VM_WAIT(); __syncthreads();
    pg8::Unit u;
    { pg8::StaticOrder S; S.init(RC, 2048, G, ((wg - 204) % G + G) % G, 256); for (int i = 0; S.next(i, u); ++i) post_v_tile((unsigned char*)ws, lds, u.pm, u.pn, 0, wave, lane); }
    { pg8::StaticOrder S; S.init(RALL - RC, 2048, G, wg, 256); for (int i = 0; S.next(i, u); ++i) post_v_tile((unsigned char*)ws, lds, u.pm >> 4, u.pn, 4 + (u.pm & 15) * 4, wave, lane); }
}
NOINL void f_mla(int wave_in, gws ws, LAS unsigned char* lds, int nunits) { PH_IDS; U(ws); U(lds); U(nunits); ph_mix_odd((unsigned char*)ws, lds, nunits, tid, wave, lane, wg, G); }
template <int ACT> NOINL void f_gemm_act(int wave_in, LAS unsigned char* lds, gcb A, gcb Bt, GAS unsigned short* O, int M, int N, int K, int ldc, int wg_shift = 0) {
    PH_IDS; U(lds); U(A); U(Bt); U(O); U(M); U(N); U(K); U(ldc); U(wg_shift); OPQ(M); OPQ(N); OPQ(K); OPQ(ldc);
    pg8::Gemm g{(const pg8::bf16_t*)A, (const pg8::bf16_t*)Bt, M, N, K}; pg8::StaticOrder S; S.init(M, N, G, ((wg - wg_shift) % G + G) % G, K);
    pg8::EpiAct<ACT> E{(pg8::bf16_t*)O, ldc};
    pg8::gemm_phase<pg8::EpiAct<ACT>, pg8::StaticOrder, PG8_ALIGN, PG8_SP2>((PG8_LAS unsigned char*)lds, g, S, E, wave);
}
NOINL void f_gemm_res(int wave_in, LAS unsigned char* lds, gcb A, gcb Bt, GAS unsigned short* Hp, gcf x32, gcf gate0, GAS unsigned short* part, int M, int N, int K, int S) {
    PH_IDS; U(lds); U(A); U(Bt); U(Hp); U(x32); U(gate0); U(part); U(M); U(N); U(K); U(S); OPQ(M); OPQ(N); OPQ(K); OPQ(S);
    pg8::Gemm g{(const pg8::bf16_t*)A, (const pg8::bf16_t*)Bt, M, N, K}; pg8::ResOrder S_; S_.init(M, N, K, S, G, wg);
    pg8::EpiResGate E{(pg8::bf16_t*)Hp, N, (const float*)gate0, 6 * DM, (pg8::bf16_t*)part, (const float*)x32};
    pg8::gemm_phase<pg8::EpiResGate, pg8::ResOrder, PG8_ALIGN, PG8_SP2>((PG8_LAS unsigned char*)lds, g, S_, E, wave);
}

constexpr int PH_END = 50;
#ifndef MK_PER_PHASE
#define MK_PER_PHASE 0
#endif
__global__ void __launch_bounds__(NTHR, 2) mk_fwd(Args a) {
    extern __shared__ __attribute__((aligned(16))) unsigned char lds_raw[];
    LAS unsigned char* lds = (LAS unsigned char*)lds_raw;
    const int tid = threadIdx.x;
    const int wv = __builtin_amdgcn_readfirstlane(tid >> 6);
    gws ws = (gws)a.ws;
    volatile LAS unsigned* MISC = (volatile LAS unsigned*)(lds + MISC_OFF);
    for (int u = tid; u < (LDS_BYTES - MISC_OFF) / 4; u += NTHR) ((LAS unsigned*)(lds + MISC_OFF))[u] = 0u;
    __syncthreads();
    const int lo = a.ph_lo, hi = a.ph_hi;
    XcdBarrier bar; bar.bar = (unsigned*)(a.ws + WS_CTL) + CW_BAR; bar.x = 0; bar.st = MISC + 8;
    if (hi - lo > 1) bar = xcd_barrier_post((unsigned*)(a.ws + WS_CTL) + CW_BAR, MISC + 8);
#define IN(k) (lo <= (k) && (k) < hi)
#define SEAM(k) do { if ((k) + 1 < hi) xcd_barrier(bar); } while (0)

    if (IN(0)) { f_prologue(wv, ws, lds, (gcf)a.x, (gcf)a.c, (gcf)a.ctx, (gcf)a.c_ctx, (gcf)a.w_mod, (gcf)a.b_mod, (gcf)a.mlp_w1, (gcf)a.mlp_w2, (gcf)a.ev_w_in, (gcf)a.ev_w_out, (gcf)a.od_w_in, (gcf)a.od_w_out, (gcf)a.od_w_uq, (gcf)a.od_w_ukv);


        SEAM(0); }

#pragma nounroll
    for (int l = 0; l < DEPTH; ++l) {
        const int j = l >> 1, pb = 1 + 12 * l;
        const int row_off = (l == DEPTH - 1) ? RC : 0, Mr = RALL - row_off;
        if (IN(pb + 0)) { f_norm(wv, ws, lds, (gcf)(a.norm1_w + l * DM), (gcf)a.ctx, (gcf)a.x, l, 0, 1, l == 0 ? 0 : 1); SEAM(pb + 0); }
        if (!(l & 1)) {
            if (IN(pb + 1)) { f_gemm_act<0>(wv, lds, (gcb)(ws + WS_A1), (gcb)(ws + WS_EWIN) + (size_t)j * EV_IN * DM, (GAS unsigned short*)(ws + WS_PRJ), RALL, EV_IN, DM, EV_IN);
                f_post_win(wv, ws, lds);
                SEAM(pb + 1); }
            if (IN(pb + 2)) { f_ret_kv(wv, ws, lds, (gcf)(a.ev_decay + j * 16)); SEAM(pb + 2); }
            if (IN(pb + 4)) { f_ret_scan(wv, ws, (gcf)(a.ev_decay + j * 16)); SEAM(pb + 4); }
            if (IN(pb + 5)) { f_win(wv, ws, lds, (gcf)(a.ev_sink + j * 8)); __syncthreads(); f_ret_out(wv, ws, lds, (gcf)(a.ev_decay + j * 16), (gcf)(a.ev_gn_w + j * 1024));


                SEAM(pb + 5); }
        } else {
            if (IN(pb + 1)) {
                f_gemm_act<0>(wv, lds, (gcb)(ws + WS_A1) + (size_t)row_off * DM, (gcb)(ws + WS_OWIN) + (size_t)j * OD_INP * DM, (GAS unsigned short*)(ws + WS_PRJ) + (size_t)row_off * OD_INP, Mr, OD_INP, DM, OD_INP);
                if (row_off) { __syncthreads();
                    f_gemm_act<0>(wv, lds, (gcb)(ws + WS_A1), (gcb)(ws + WS_OWIN) + (size_t)j * OD_INP * DM + (size_t)O_CKV * DM, (GAS unsigned short*)(ws + WS_PRJ) + O_CKV, RC, 256, DM, OD_INP, 224); }
                SEAM(pb + 1); }
            if (IN(pb + 2)) { f_prep_odd(wv, ws, lds, (gcf)(a.od_conv_w + j * 3 * 1024), (gcf)(a.od_qn_w + j * 512), (gcf)(a.od_kvn_w + j * 256), j); SEAM(pb + 2); }
            if (IN(pb + 3)) {
                f_rope_kr(wv, ws);
                f_gemm_act<0>(wv, lds, (gcb)(ws + WS_CQN), (gcb)(ws + WS_UQT) + (size_t)j * 1536 * 512, (GAS unsigned short*)(ws + WS_QRAW), RALL, 1536, 512, 1536);
                f_post_q(wv, ws);
                __syncthreads();
                f_gemm_act<0>(wv, lds, (gcb)(ws + WS_CKVN), (gcb)(ws + WS_UKVT) + (size_t)j * 2048 * 256, (GAS unsigned short*)(ws + WS_KVRAW), RC, 2048, 256, 2048, 204);
                __syncthreads();
                f_gemm_act<0>(wv, lds, (gcb)(ws + WS_CKVN) + (size_t)RC * 256, (gcb)(ws + WS_UKVT) + (size_t)j * 2048 * 256, (GAS unsigned short*)(ws + WS_KVRAW) + (size_t)RC * 2048, RALL - RC, 2048, 256, 2048);
                f_post_v(wv, ws, lds);
                SEAM(pb + 3); }
            if (IN(pb + 6)) { f_mla(wv, ws, lds, row_off ? 256 : 272); SEAM(pb + 6); }
        }
        if (IN(pb + 7)) { gcb wo = (l & 1) ? (gcb)(ws + WS_OWOUT) + (size_t)j * DM * DM : (gcb)(ws + WS_EWOUT) + (size_t)j * DM * DM;
            f_gemm_res(wv, lds, (gcb)(ws + WS_MIX), wo, (GAS unsigned short*)(ws + WS_H), l == 0 ? (gcf)a.x : (gcf)nullptr, (gcf)(ws + WS_MOD) + (size_t)l * 3 * 12288 + 2 * DM, (GAS unsigned short*)(ws + WS_PARTO), RALL, DM, DM, row_off ? 0 : S_OUT);
            SEAM(pb + 7); }
        if (IN(pb + 8)) { f_norm(wv, ws, lds, (gcf)(a.norm2_w + l * DM), (gcf)a.ctx, (gcf)a.x, l, 3, 4, row_off ? 3 : 2); SEAM(pb + 8); }
        if (IN(pb + 9)) { f_gemm_act<1>(wv, lds, (gcb)(ws + WS_A1) + (size_t)row_off * DM, (gcb)(ws + WS_W1T) + (size_t)l * DFF * DM, (GAS unsigned short*)(ws + WS_HID) + (size_t)row_off * DFF, Mr, DFF, DM, DFF);

            SEAM(pb + 9); }
        if (IN(pb + 10)) { f_gemm_res(wv, lds, (gcb)(ws + WS_HID), (gcb)(ws + WS_W2T) + (size_t)l * DM * DFF, (GAS unsigned short*)(ws + WS_H), (gcf)nullptr, (gcf)(ws + WS_MOD) + (size_t)l * 3 * 12288 + 5 * DM, (GAS unsigned short*)(ws + WS_PARTM), RALL, DM, DFF, row_off ? 0 : S_MLP);
            SEAM(pb + 10); }
    }
    if (IN(49)) f_final(wv, ws, (gcf)a.norm_f, (GAS float*)a.out);
#undef IN
#undef SEAM
}

extern "C" void kernel_launch(void* const* d_in, const int* in_sizes, int n_in, void* d_out, int out_size, void* d_ws, size_t ws_size, hipStream_t stream) {
    static int grid = 0;
    if (grid == 0) {
        if (n_in != 23 || out_size != NB * TL * DM || ws_size < WS_END) { fprintf(stderr, "kernel_launch: unexpected shapes (n_in %d, out %d, ws %zu); nothing launched\n", n_in, out_size, ws_size); grid = -1; return; }
        int dev = 0, cus = 0, per_cu = 0;
        if (hipGetDevice(&dev) != hipSuccess || hipDeviceGetAttribute(&cus, hipDeviceAttributeMultiprocessorCount, dev) != hipSuccess) { grid = -1; return; }
        if (hipFuncSetAttribute((const void*)mk_fwd, hipFuncAttributeMaxDynamicSharedMemorySize, LDS_BYTES) != hipSuccess) { fprintf(stderr, "kernel_launch: hipFuncSetAttribute failed\n"); grid = -1; return; }
        if (hipOccupancyMaxActiveBlocksPerMultiprocessor(&per_cu, (const void*)mk_fwd, NTHR, LDS_BYTES) != hipSuccess || per_cu < 1) { fprintf(stderr, "kernel_launch: occupancy query reports %d blocks per CU; nothing launched\n", per_cu); grid = -1; (void)hipGetLastError(); return; }
        grid = cus;
    }
    if (grid < 0) return;
    if (hipMemsetAsync((char*)d_ws + WS_CTL, 0, CTL_ZERO_BYTES, stream) != hipSuccess) return;
    Args a{};
    const float** ap = (const float**)&a;
    for (int i = 0; i < 23; ++i) ap[i] = (const float*)d_in[i];
    a.out = (float*)d_out; a.ws = (unsigned char*)d_ws;
#if MK_PER_PHASE
    for (int p = 0; p < PH_END; ++p) { a.ph_lo = p; a.ph_hi = p + 1; hipLaunchKernelGGL(mk_fwd, dim3(grid), dim3(NTHR), LDS_BYTES, stream, a); }
#else
    a.ph_lo = 0; a.ph_hi = PH_END;
    hipLaunchKernelGGL(mk_fwd, dim3(grid), dim3(NTHR), LDS_BYTES, stream, a);
#endif
    const hipError_t le = hipPeekAtLastError();
    if (le != hipSuccess) fprintf(stderr, "kernel_launch: launch failed: %s\n", hipGetErrorName(le));
}
```

```cpp
#include <hip/hip_runtime.h>
#include <cstdio>
#include <cstdint>
#define MK_PER_PHASE 0
namespace pg8 {
#define PG8_LAS __attribute__((address_space(3)))
typedef unsigned short bf16_t;
typedef short bf16x8 __attribute__((ext_vector_type(8)));
typedef float f32x4 __attribute__((ext_vector_type(4)));
typedef unsigned u32x4 __attribute__((ext_vector_type(4)));
constexpr int BM = 256, BK = 64, HALF = 128, HTB = HALF * BK * 2  , STAGE_BYTES = 8 * HTB, NXCD = 8, WGM = 4;

__host__ __device__ __forceinline__ int lds_byte(int r, int c) { const int st = (r >> 4) * 2 + (c >> 5), rr = r & 15, cc = c & 31, ob = rr * 64 + cc * 2; return st * 1024 + (ob ^ (((ob >> 9) & 1) << 5)); }
__host__ __device__ __forceinline__ void stage_rc(int b, int& R, int& C) { const int st = b / 1024, sb = b % 1024, swz = sb ^ (((sb >> 9) & 1) << 5); R = (st >> 1) * 16 + swz / 64; C = (st & 1) * 32 + (swz % 64) / 2; }
__host__ __device__ __forceinline__ int perm32(int rho) { const int n = rho >> 4, i = rho & 15; return 8 * (i >> 2) + 4 * n + (i & 3); }

struct Unit { int pm, pn, ks, nt, koff; };
struct Gemm { const bf16_t* A; const bf16_t* Bt; int M, N, K; };

struct StaticOrder {
    int nM, nN, nwg, G, c, ntK;
    __host__ __device__ void init(int M, int N, int G_, int c_, int K_) { nM = M / BM; nN = N / BM; nwg = nM * nN; G = G_; c = c_; ntK = K_ / BK; }
    __host__ __device__ bool next(int i, Unit& u) const {
        const long L = (long)i * G + c; if (L >= nwg) return false;
        int wgid = (int)L; { const int q = nwg / NXCD, r = nwg % NXCD, xcd = wgid % NXCD, off = wgid / NXCD; wgid = (xcd < r ? xcd * (q + 1) : r * (q + 1) + (xcd - r) * q) + off; }
        const int nig = WGM * nN, gid = wgid / nig, fm = gid * WGM, gsz = (nM - fm) < WGM ? (nM - fm) : WGM;
        u.pm = fm + ((wgid % nig) % gsz); u.pn = (wgid % nig) / gsz; u.ks = -1; u.nt = ntK; u.koff = 0; return true;
    }
    __device__ __forceinline__ void a_ready(const Unit&) const {}
    __device__ __forceinline__ void done(const Unit&) const {}
};

__device__ __forceinline__ unsigned cvt_pk_bf16(float lo, float hi) { unsigned r; asm volatile("v_cvt_pk_bf16_f32 %0, %1, %2" : "=v"(r) : "v"(lo), "v"(hi)); return r; }
typedef float f32x2 __attribute__((ext_vector_type(2)));
__device__ __forceinline__ f32x2 gelu_pk(f32x2 v) {
    const f32x2 av = __builtin_elementwise_abs(v), d = av * 0.2316418882f + 1.0f;
    f32x2 t; t.x = __builtin_amdgcn_rcpf(d.x); t.y = __builtin_amdgcn_rcpf(d.y);
    f32x2 q = t * 0.5307027145f + (-0.7265760135f); q = q * t + 0.7107068705f; q = q * t + (-0.142248368f); q = q * t + 0.127414796f; q = q * t;
    const f32x2 s = (v * v) * (-0.72134752044f);
    f32x2 e; e.x = __builtin_amdgcn_exp2f(s.x); e.y = __builtin_amdgcn_exp2f(s.y);
    const f32x2 m = v * (q * e), r = v - m;
    f32x2 o; o.x = v.x < 0.f ? m.x : r.x; o.y = v.y < 0.f ? m.y : r.y; return o;
}


template <int ACT> struct EpiAct {
    static constexpr bool PERM = true, AFTER_DRAIN = false;
    bf16_t* O; int ldc;
    __device__ __forceinline__ void operator()(const f32x4 (&acc)[2][2][4][2], const Unit& u, int wr, int wc, int fr, int fq) const {
        const int row0 = u.pm * BM + wr * 64 + fr, col0 = u.pn * BM + wc * 32 + 8 * fq;
#pragma unroll
        for (int ai = 0; ai < 2; ++ai)
#pragma unroll
            for (int m = 0; m < 4; ++m) { bf16_t* rowp = O + (size_t)(row0 + ai * HALF + m * 16) * ldc + col0;
#pragma unroll
                for (int bj = 0; bj < 2; ++bj) { f32x4 v0 = acc[ai][bj][m][0], v1 = acc[ai][bj][m][1];
                    if (ACT == 1) {
#pragma unroll
                        for (int e = 0; e < 4; ++e) { const float a = fmaxf(v0[e], 0.f), b = fmaxf(v1[e], 0.f); v0[e] = a * a; v1[e] = b * b; } }
                    u32x4 w; w.x = cvt_pk_bf16(v0[0], v0[1]); w.y = cvt_pk_bf16(v0[2], v0[3]); w.z = cvt_pk_bf16(v1[0], v1[1]); w.w = cvt_pk_bf16(v1[2], v1[3]);
                    *(u32x4*)(rowp + bj * HALF) = w; } }
    }
};
struct EpiResGate {
    static constexpr bool PERM = true, AFTER_DRAIN = false;
    bf16_t* H; int ldc; const float* gate0; int set_stride; bf16_t* part; const float* Hx32;
    __device__ __forceinline__ void operator()(const f32x4 (&acc)[2][2][4][2], const Unit& u, int wr, int wc, int fr, int fq) const {
        const int row0 = u.pm * BM + wr * 64 + fr, col0 = u.pn * BM + wc * 32 + 8 * fq;
        if (u.ks >= 0) {
            bf16_t* P = part + (size_t)u.ks * 512 * ldc;
#pragma unroll
            for (int ai = 0; ai < 2; ++ai)
#pragma unroll
                for (int m = 0; m < 4; ++m) { bf16_t* rowp = P + (size_t)(row0 + ai * HALF + m * 16) * ldc + col0;
#pragma unroll
                    for (int bj = 0; bj < 2; ++bj) { const f32x4 v0 = acc[ai][bj][m][0], v1 = acc[ai][bj][m][1];
                        u32x4 o; o.x = cvt_pk_bf16(v0[0], v0[1]); o.y = cvt_pk_bf16(v0[2], v0[3]); o.z = cvt_pk_bf16(v1[0], v1[1]); o.w = cvt_pk_bf16(v1[2], v1[3]);
                        *(u32x4*)(rowp + bj * HALF) = o; } }
            return; }
        const int grow = u.pm * BM; const int set = grow < 512 ? 2 : ((grow - 512) >> 12);
        const float* g = gate0 + (size_t)set * set_stride + col0;
        f32x4 gv[2][2];
#pragma unroll
        for (int bj = 0; bj < 2; ++bj) { gv[bj][0] = *(const f32x4*)(g + bj * HALF); gv[bj][1] = *(const f32x4*)(g + bj * HALF + 4); }
        if (Hx32) {
#pragma unroll
            for (int ai = 0; ai < 2; ++ai) { f32x4 hx[4][2][2];
#pragma unroll
                for (int m = 0; m < 4; ++m)
#pragma unroll
                    for (int bj = 0; bj < 2; ++bj) { const float* ps = Hx32 + (size_t)(row0 + ai * HALF + m * 16) * ldc + col0 - (size_t)512 * ldc + bj * HALF; hx[m][bj][0] = *(const f32x4*)ps; hx[m][bj][1] = *(const f32x4*)(ps + 4); }
#pragma unroll
                for (int m = 0; m < 4; ++m)
#pragma unroll
                    for (int bj = 0; bj < 2; ++bj) { const f32x4 v0 = hx[m][bj][0] + gv[bj][0] * acc[ai][bj][m][0], v1 = hx[m][bj][1] + gv[bj][1] * acc[ai][bj][m][1];
                        u32x4 o; o.x = cvt_pk_bf16(v0[0], v0[1]); o.y = cvt_pk_bf16(v0[2], v0[3]); o.z = cvt_pk_bf16(v1[0], v1[1]); o.w = cvt_pk_bf16(v1[2], v1[3]);
                        *(u32x4*)(H + (size_t)(row0 + ai * HALF + m * 16) * ldc + col0 + bj * HALF) = o; } }
        } else {
#pragma unroll
            for (int ai = 0; ai < 2; ++ai) { u32x4 hw[4][2];
#pragma unroll
                for (int m = 0; m < 4; ++m)
#pragma unroll
                    for (int bj = 0; bj < 2; ++bj) hw[m][bj] = *(const u32x4*)(H + (size_t)(row0 + ai * HALF + m * 16) * ldc + col0 + bj * HALF);
#pragma unroll
                for (int m = 0; m < 4; ++m)
#pragma unroll
                    for (int bj = 0; bj < 2; ++bj) { const u32x4 w = hw[m][bj];
                        const f32x4 h0 = {__uint_as_float(w.x << 16), __uint_as_float(w.x & 0xffff0000u), __uint_as_float(w.y << 16), __uint_as_float(w.y & 0xffff0000u)};
                        const f32x4 h1 = {__uint_as_float(w.z << 16), __uint_as_float(w.z & 0xffff0000u), __uint_as_float(w.w << 16), __uint_as_float(w.w & 0xffff0000u)};
                        const f32x4 v0 = h0 + gv[bj][0] * acc[ai][bj][m][0], v1 = h1 + gv[bj][1] * acc[ai][bj][m][1];
                        u32x4 o; o.x = cvt_pk_bf16(v0[0], v0[1]); o.y = cvt_pk_bf16(v0[2], v0[3]); o.z = cvt_pk_bf16(v1[0], v1[1]); o.w = cvt_pk_bf16(v1[2], v1[3]);
                        *(u32x4*)(H + (size_t)(row0 + ai * HALF + m * 16) * ldc + col0 + bj * HALF) = o; } }
        }
    }
};

struct ResOrder {
    StaticOrder so; int nmain, nsplit, S, nN, ntc, G, c;
    __host__ __device__ void init(int M, int N, int K, int S_, int G_, int c_) { so.init(M - 512, N, G_, c_, K); nmain = so.nwg; S = S_; nN = N / BM; nsplit = 2 * nN * S_; ntc = S_ ? K / S_ / BK : 0; G = G_; c = c_; }
    __host__ __device__ bool next(int i, Unit& u) const {
        const long L = (long)i * G + c;
        if (L < nmain) { so.next(i, u); u.pm += 2; return true; }
        const int s = (int)(L - nmain); if (s >= nsplit) return false;
        u.ks = s % S; const int rest = s / S; u.pn = rest % nN; u.pm = rest / nN; u.nt = ntc; u.koff = u.ks * ntc * BK; return true;
    }
    __device__ __forceinline__ void a_ready(const Unit&) const {}
    __device__ __forceinline__ void done(const Unit&) const {}
};
template <class Epi, class Sched, bool ALIGN_EPI = false, bool SP2 = false>
__device__ __forceinline__ void gemm_phase(PG8_LAS unsigned char* lds, const Gemm g, const Sched& S, const Epi& E, int wave_in) {
    int lane_; asm volatile("v_mbcnt_lo_u32_b32 %0, -1, 0\n\tv_mbcnt_hi_u32_b32 %0, -1, %0" : "=v"(lane_));
    const int wid = wave_in, tid = wid * 64 + lane_, lane = tid & 63, wr = wid >> 2, wc = wid & 3, fr = lane & 15, fq = lane >> 4;
    const int K = g.K;
    unsigned voffA[2], voffB[2];
#pragma unroll
    for (int i = 0; i < 2; ++i) { int R, C; stage_rc(tid * 16 + i * 8192, R, C); const int Rb = Epi::PERM ? ((R & ~31) + perm32(R & 31)) : R;
        voffA[i] = (unsigned)(R * K + C) * 2u; voffB[i] = (unsigned)(Rb * K + C) * 2u; }
    const size_t kstep = (size_t)(BK * 2);
    const size_t hstep = (size_t)HALF * K * 2;
    const size_t tstep = 2 * hstep;
    const unsigned ldsw = (unsigned)wid * 1024u;
    const int aoff = lds_byte(wr * 64 + fr, fq * 8), boff = lds_byte(wc * 32 + fr, fq * 8);
#define PG8_SA(b, h) (((b) * 2 + (h)) * HTB)
#define PG8_SB(b, h) ((4 + (b) * 2 + (h)) * HTB)
#define PG8_STAGE(bufoff, gbase, voff) do { _Pragma("unroll") for (int _i = 0; _i < 2; ++_i) \
        __builtin_amdgcn_global_load_lds((const unsigned*)((const char*)(gbase) + (voff)[_i]), (PG8_LAS unsigned*)(lds + (bufoff) + ldsw + _i * 8192), 16, 0, 0); } while (0)
#define PG8_LDA(dst, b, h) do { _Pragma("unroll") for (int m = 0; m < 4; ++m) _Pragma("unroll") for (int k = 0; k < 2; ++k) dst[m][k] = *(const PG8_LAS bf16x8*)(lds + PG8_SA(b, h) + aoff + m * 2048 + k * 1024); } while (0)
#define PG8_LDB(dst, b, h) do { _Pragma("unroll") for (int n = 0; n < 2; ++n) _Pragma("unroll") for (int k = 0; k < 2; ++k) dst[n][k] = *(const PG8_LAS bf16x8*)(lds + PG8_SB(b, h) + boff + n * 2048 + k * 1024); } while (0)
#define PG8_MMA(ai, bj, At, Bt) do { __builtin_amdgcn_s_setprio(1); _Pragma("unroll") for (int m = 0; m < 4; ++m) _Pragma("unroll") for (int n = 0; n < 2; ++n) _Pragma("unroll") for (int k = 0; k < 2; ++k) \
        acc[ai][bj][m][n] = __builtin_amdgcn_mfma_f32_16x16x32_bf16(Bt[n][k], At[m][k], acc[ai][bj][m][n], 0, 0, 0); __builtin_amdgcn_s_setprio(0); } while (0)
#define PG8_WAIT_V(n) asm volatile("s_waitcnt vmcnt(" #n ")" ::: "memory")
#define PG8_WAIT_L(n) asm volatile("s_waitcnt lgkmcnt(" #n ")" ::: "memory")
#define PG8_BAR __builtin_amdgcn_s_barrier()
#define PG8_SCHED __builtin_amdgcn_sched_barrier(0)
    Unit cur, nxt; int ui = 0;
    if (!S.next(0, cur)) return;
    f32x4 acc[2][2][4][2];
#pragma unroll
    for (int a = 0; a < 2; ++a)
#pragma unroll
        for (int b = 0; b < 2; ++b)
#pragma unroll
            for (int m = 0; m < 4; ++m)
#pragma unroll
                for (int n = 0; n < 2; ++n) acc[a][b][m][n] = (f32x4){0.f, 0.f, 0.f, 0.f};
    bf16x8 At[4][2], B0[2][2], B1[2][2];
    const char* cA = (const char*)g.A + (size_t)cur.pm * tstep + (size_t)cur.koff * 2; const char* cB = (const char*)g.Bt + (size_t)cur.pn * tstep + (size_t)cur.koff * 2;
    int nt = cur.nt;
    S.a_ready(cur);
    if constexpr (SP2) {
        PG8_STAGE(PG8_SB(0, 0), cB, voffB); PG8_STAGE(PG8_SB(0, 1), cB + hstep, voffB); PG8_STAGE(PG8_SA(0, 0), cA, voffA); PG8_STAGE(PG8_SA(0, 1), cA + hstep, voffA);
        if (wr == 1) PG8_BAR;
        PG8_WAIT_V(2); PG8_BAR;
        PG8_STAGE(PG8_SB(1, 0), cB + kstep, voffB); PG8_STAGE(PG8_SA(1, 0), cA + kstep, voffA); PG8_STAGE(PG8_SB(1, 1), cB + hstep + kstep, voffB);
        PG8_WAIT_V(6); PG8_BAR;
    } else {
        PG8_STAGE(PG8_SB(0, 0), cB, voffB); PG8_STAGE(PG8_SA(0, 0), cA, voffA); PG8_STAGE(PG8_SB(0, 1), cB + hstep, voffB); PG8_STAGE(PG8_SA(0, 1), cA + hstep, voffA);
        if (wr == 1) PG8_BAR;
        PG8_WAIT_V(4); PG8_BAR;
        PG8_STAGE(PG8_SB(1, 0), cB + kstep, voffB); PG8_STAGE(PG8_SA(1, 0), cA + kstep, voffA); PG8_STAGE(PG8_SB(1, 1), cB + hstep + kstep, voffB);
        PG8_WAIT_V(6); PG8_BAR;
    }
    for (;;) {
        const bool has_next = S.next(ui + 1, nxt);
        const char* nA = has_next ? (const char*)g.A + (size_t)nxt.pm * tstep + (size_t)nxt.koff * 2 : cA; const char* nB = has_next ? (const char*)g.Bt + (size_t)nxt.pn * tstep + (size_t)nxt.koff * 2 : cB;
        asm volatile(".p2align 8" ::: "memory");
        for (int t = 0; t < nt; t += 2) {
            const bool last = (t == nt - 2);
            const char* a1 = cA + (size_t)(t + 1) * kstep;
            const char* a2 = last ? nA : cA + (size_t)(t + 2) * kstep; const char* b2 = last ? nB : cB + (size_t)(t + 2) * kstep;
            const char* a3 = a2 + kstep; const char* b3 = b2 + kstep;
            if (last && has_next) S.a_ready(nxt);
            if constexpr (SP2) {
            PG8_LDB(B0, 0, 0); PG8_LDB(B1, 0, 1); PG8_SCHED; PG8_LDA(At, 0, 0); PG8_STAGE(PG8_SA(1, 1), a1 + hstep, voffA);
            PG8_WAIT_V(8); PG8_WAIT_L(0); PG8_BAR; PG8_MMA(0, 0, At, B0); PG8_MMA(0, 1, At, B1); PG8_BAR; PG8_SCHED;
            PG8_LDA(At, 0, 1); PG8_STAGE(PG8_SB(0, 0), b2, voffB); PG8_STAGE(PG8_SB(0, 1), b2 + hstep, voffB); PG8_STAGE(PG8_SA(0, 0), a2, voffA);
            PG8_WAIT_V(8); PG8_WAIT_L(0); PG8_BAR; PG8_MMA(1, 0, At, B0); PG8_MMA(1, 1, At, B1); PG8_BAR; PG8_SCHED;
            PG8_LDB(B0, 1, 0); PG8_LDB(B1, 1, 1); PG8_SCHED; PG8_LDA(At, 1, 0); PG8_STAGE(PG8_SA(0, 1), a2 + hstep, voffA);
            PG8_WAIT_V(8); PG8_WAIT_L(0); PG8_BAR; PG8_MMA(0, 0, At, B0); PG8_MMA(0, 1, At, B1); PG8_BAR; PG8_SCHED;
            PG8_LDA(At, 1, 1); PG8_STAGE(PG8_SB(1, 0), b3, voffB); PG8_STAGE(PG8_SB(1, 1), b3 + hstep, voffB); PG8_STAGE(PG8_SA(1, 0), a3, voffA);
            PG8_WAIT_V(8); PG8_WAIT_L(0); PG8_BAR; PG8_MMA(1, 0, At, B0); PG8_MMA(1, 1, At, B1); PG8_BAR; PG8_SCHED;
            } else {
            PG8_LDB(B0, 0, 0); PG8_SCHED; PG8_LDA(At, 0, 0); PG8_STAGE(PG8_SA(1, 1), a1 + hstep, voffA);
            PG8_WAIT_L(8); PG8_BAR; PG8_WAIT_L(0); PG8_MMA(0, 0, At, B0); PG8_BAR; PG8_SCHED;
            PG8_LDB(B1, 0, 1); PG8_STAGE(PG8_SB(0, 0), b2, voffB);
            PG8_BAR; PG8_WAIT_L(0); PG8_MMA(0, 1, At, B1); PG8_BAR;
            PG8_LDA(At, 0, 1); PG8_STAGE(PG8_SA(0, 0), a2, voffA);
            PG8_BAR; PG8_WAIT_L(0); PG8_MMA(1, 0, At, B0); PG8_BAR; PG8_SCHED;
            PG8_STAGE(PG8_SB(0, 1), b2 + hstep, voffB);
            PG8_WAIT_V(6); PG8_BAR; PG8_MMA(1, 1, At, B1); PG8_BAR;
            PG8_LDB(B0, 1, 0); PG8_SCHED; PG8_LDA(At, 1, 0); PG8_STAGE(PG8_SA(0, 1), a2 + hstep, voffA);
            PG8_WAIT_L(8); PG8_BAR; PG8_WAIT_L(0); PG8_MMA(0, 0, At, B0); PG8_BAR; PG8_SCHED;
            PG8_LDB(B1, 1, 1); PG8_STAGE(PG8_SB(1, 0), b3, voffB);
            PG8_BAR; PG8_WAIT_L(0); PG8_MMA(0, 1, At, B1); PG8_BAR;
            PG8_LDA(At, 1, 1); PG8_STAGE(PG8_SA(1, 0), a3, voffA);
            PG8_BAR; PG8_WAIT_L(0); PG8_MMA(1, 0, At, B0); PG8_BAR; PG8_SCHED;
            PG8_STAGE(PG8_SB(1, 1), b3 + hstep, voffB);
            PG8_WAIT_V(6); PG8_BAR; PG8_MMA(1, 1, At, B1); PG8_BAR;
            }
        }
        if constexpr (ALIGN_EPI) { if (wr == 0) PG8_BAR; }
        if constexpr (!Epi::AFTER_DRAIN) { E(acc, cur, wr, wc, fr, fq); S.done(cur); }
        if (!has_next) break;
#pragma unroll
        for (int a = 0; a < 2; ++a)
#pragma unroll
            for (int b = 0; b < 2; ++b)
#pragma unroll
                for (int m = 0; m < 4; ++m)
#pragma unroll
                    for (int n = 0; n < 2; ++n) acc[a][b][m][n] = (f32x4){0.f, 0.f, 0.f, 0.f};
        cur = nxt; cA = nA; cB = nB; ++ui; nt = cur.nt;
        if constexpr (ALIGN_EPI) { if (wr == 1) PG8_BAR; }
    }
    PG8_WAIT_V(0);
    if constexpr (!ALIGN_EPI) { if (wr == 0) PG8_BAR; }
    PG8_BAR;
    if constexpr (Epi::AFTER_DRAIN) { E.fused(acc, cur, wr, wc, fr, fq, lds, wid, lane); S.done(cur); }
#undef PG8_SA
#undef PG8_SB
#undef PG8_STAGE
#undef PG8_LDA
#undef PG8_LDB
#undef PG8_MMA
#undef PG8_WAIT_V
#undef PG8_WAIT_L
#undef PG8_BAR
#undef PG8_SCHED
}
}

#ifndef PG8_SP2
#define PG8_SP2 true
#endif
#ifndef PG8_ALIGN
#define PG8_ALIGN true
#endif

constexpr int DM = 2048, NB = 2, TL = 4096, TC = 256, DEPTH = 4, DFF = 8192;
constexpr int RC = NB * TC;
constexpr int RALL = RC + NB * TL;
constexpr int NKEY = TC + TL;
constexpr int EV_IN = 5632, OD_IN = 3904, OD_INP = 3840;
constexpr int E_QR = 0, E_KR = 1024, E_VR = 2048, E_GR = 3072, E_QW = 4096, E_KW = 5120, E_VW = 5376;
constexpr int O_BG = 0, O_CG = 1024, O_XV = 2048, O_CQ = 3072, O_CKV = 3584, O_KR = 3840;
constexpr int NCH = 34;
constexpr float EPS = 1e-6f;
constexpr float LOG2E = 1.4426950408889634f;

constexpr size_t MiB = 1u << 20;
constexpr size_t WS_CTL = 0, CTL_ZERO_BYTES = 1 * MiB;
constexpr size_t WS_MOD = 1 * MiB;
constexpr size_t WS_T1C = 2 * MiB, WS_T1S = 3 * MiB;
constexpr size_t WS_T2 = 4 * MiB;
constexpr size_t WS_W1T = 8 * MiB, WS_W2T = 136 * MiB, WS_EWIN = 264 * MiB, WS_EWOUT = 308 * MiB, WS_OWIN = 324 * MiB, WS_OWOUT = 356 * MiB, WS_UQT = 372 * MiB, WS_UKVT = 375 * MiB;
constexpr size_t WS_H = 384 * MiB, WS_A1 = 452 * MiB, WS_PRJ = 486 * MiB, WS_MIX = 580 * MiB, WS_HID = 614 * MiB, WS_KVST = 750 * MiB, WS_ST = 818 * MiB;
constexpr size_t WS_VTW = 852 * MiB, WS_VTM = 857 * MiB, WS_CQN = 874 * MiB, WS_CKVN = 883 * MiB, WS_QRAW = 888 * MiB, WS_KVRAW = 914 * MiB, WS_PARTO = 948 * MiB, WS_PARTM = 980 * MiB, WS_WKRT = 1044 * MiB, WS_KR = 1045 * MiB, WS_END = 1047 * MiB;
constexpr int S_OUT = 4, S_MLP = 8;
constexpr int CW_BAR = 4096;

constexpr int LDS_BYTES = 147456;
constexpr int MISC_OFF = 143360;
constexpr int NWAVES = 8, NTHR = 512;

#define GAS __attribute__((address_space(1)))
#define LAS __attribute__((address_space(3)))
typedef unsigned short bf16;
typedef unsigned v4u __attribute__((ext_vector_type(4)));
typedef unsigned v2u __attribute__((ext_vector_type(2)));
typedef float f32x4 __attribute__((ext_vector_type(4)));
typedef float f32x16 __attribute__((ext_vector_type(16)));
typedef short bf16x8 __attribute__((ext_vector_type(8)));
#define LDS_WAIT() asm volatile("s_waitcnt lgkmcnt(0)" ::: "memory")
#define VM_WAIT() asm volatile("s_waitcnt vmcnt(0)" ::: "memory")

__device__ __forceinline__ unsigned pk2(float lo, float hi) { unsigned r; asm volatile("v_cvt_pk_bf16_f32 %0, %1, %2" : "=v"(r) : "v"(lo), "v"(hi)); return r; }
__device__ __forceinline__ float bflo(unsigned w) { return __uint_as_float(w << 16); }
__device__ __forceinline__ float bfhi(unsigned w) { return __uint_as_float(w & 0xffff0000u); }
__device__ __forceinline__ float bf2f(unsigned short b) { return __uint_as_float(((unsigned)b) << 16); }
__device__ __forceinline__ unsigned short f2bf(float f) { return (unsigned short)(pk2(f, 0.f) & 0xffffu); }
__device__ __forceinline__ float wave_sum(float v) {
#pragma unroll
    for (int o = 1; o < 64; o <<= 1) v += __shfl_xor(v, o);
    return v;
}
__device__ __forceinline__ float fexp2(float x) { return __builtin_amdgcn_exp2f(x); }
__device__ __forceinline__ int row_set(int r) { return r < RC ? 2 : ((r - RC) >> 12); }

#define XB_TMO      128
#define XB_XCNT(j)  (256  + 64 * (j))
#define XB_XSUB(j)  (1280 + 64 * (j))
#define XB_XGEN(j)  (2304 + 64 * (j))
#define XB_TOP      3328
#define XB_TOPGEN   3392
#define XCD_BAR_WORDS 3456
#define XB_SPIN_CAP (1u << 18)

__device__ __forceinline__ unsigned xb_ld(unsigned* p)              { return __hip_atomic_load(p, __ATOMIC_RELAXED, __HIP_MEMORY_SCOPE_AGENT); }
__device__ __forceinline__ unsigned xb_add(unsigned* p, unsigned v) { return __hip_atomic_fetch_add(p, v, __ATOMIC_RELAXED, __HIP_MEMORY_SCOPE_AGENT); }
__device__ __forceinline__ unsigned xb_xcc_id() { return (unsigned)__builtin_amdgcn_s_getreg((3 << 11) | 20) & 0xFu; }
#define XB_SPIN(cond, bar) do { unsigned _sp = 0; while (cond) { __builtin_amdgcn_s_sleep(1); \
    if ((++_sp & 255u) == 0u) { if (xb_ld(&(bar)[XB_TMO])) break; if (_sp > XB_SPIN_CAP) { atomicAdd(&(bar)[XB_TMO], 1u); break; } } } } while (0)

struct XcdBarrier {
    unsigned* bar; unsigned x;
    volatile LAS unsigned* st;
};

__device__ __forceinline__ XcdBarrier xcd_barrier_post(unsigned* bar, volatile LAS unsigned* st) {
    XcdBarrier b; b.bar = bar; b.x = xb_xcc_id(); b.st = st;
    if (threadIdx.x == 0) (void)xb_add(&bar[XB_XCNT(b.x)], 1u);
    return b;
}
__device__ __forceinline__ void xcd_barrier_complete(unsigned* bar, unsigned x, unsigned& nloc, unsigned& nx) {
    const unsigned G = gridDim.x * gridDim.y * gridDim.z;
    unsigned sum, cnt, mine, sp = 0u;
    for (;;) {
        sum = 0u; cnt = 0u; mine = 0u;
#pragma unroll
        for (unsigned j = 0; j < 16; ++j) { const unsigned c = xb_ld(&bar[XB_XCNT(j)]); sum += c; cnt += (c > 0u) ? 1u : 0u; mine = (j == x) ? c : mine; }
        if (sum == G) break;
        __builtin_amdgcn_s_sleep(1);
        if ((++sp & 255u) == 0u) { if (xb_ld(&bar[XB_TMO])) break; if (sp > XB_SPIN_CAP) { atomicAdd(&bar[XB_TMO], 1u); break; } }
    }
    nloc = mine > 0u ? mine : 1u; nx = cnt > 0u ? cnt : 1u;
}

__device__ __forceinline__ void xcd_barrier(const XcdBarrier& b) {
    asm volatile("s_waitcnt vmcnt(0)" ::: "memory");
    __syncthreads();
    if (threadIdx.x == 0) {
        unsigned* bar = b.bar;
        __builtin_amdgcn_s_waitcnt(0);
        unsigned nloc = b.st[0], nx = b.st[1];
        if (nloc == 0u) { xcd_barrier_complete(bar, b.x, nloc, nx); b.st[0] = nloc; b.st[1] = nx; }
        const unsigned old = xb_add(&bar[XB_XSUB(b.x)], 1u);
        const unsigned gen = old / nloc;
        if (old + 1u == (gen + 1u) * nloc) {
            __builtin_amdgcn_fence(__ATOMIC_RELEASE, "agent");
            asm volatile("s_waitcnt vmcnt(0)" ::: "memory");
            const unsigned og = xb_add(&bar[XB_TOP], 1u);
            const unsigned tg = og / nx;
            if (og + 1u == (tg + 1u) * nx) xb_add(&bar[XB_TOPGEN], 1u);
            else XB_SPIN(xb_ld(&bar[XB_TOPGEN]) == tg, bar);
            __builtin_amdgcn_fence(__ATOMIC_ACQUIRE, "agent");
            xb_add(&bar[XB_XGEN(b.x)], 1u);
            asm volatile("s_waitcnt vmcnt(0)" ::: "memory");
        } else {
            XB_SPIN(xb_ld(&bar[XB_XGEN(b.x)]) == gen, bar);
            __builtin_amdgcn_fence(__ATOMIC_ACQUIRE, "agent");
            asm volatile("s_waitcnt vmcnt(0)" ::: "memory");
        }
    }
    __syncthreads();
}

struct Args {
    const float *x, *c, *ctx, *c_ctx, *w_mod, *b_mod, *norm1_w, *norm2_w, *mlp_w1, *mlp_w2, *ev_w_in, *ev_decay, *ev_gn_w, *ev_sink, *ev_w_out,
                *od_w_in, *od_conv_w, *od_qn_w, *od_kvn_w, *od_w_uq, *od_w_ukv, *od_w_out, *norm_f;
    float* out; unsigned char* ws; int ph_lo, ph_hi;
};

__device__ __forceinline__ void unpack8(const v4u w, float (&f)[8]) {
#pragma unroll
    for (int i = 0; i < 4; ++i) { f[2 * i] = bflo(w[i]); f[2 * i + 1] = bfhi(w[i]); }
}
__device__ __forceinline__ v4u pack8(const float (&f)[8]) { v4u w; w.x = pk2(f[0], f[1]); w.y = pk2(f[2], f[3]); w.z = pk2(f[4], f[5]); w.w = pk2(f[6], f[7]); return w; }
__device__ __forceinline__ void ld8f(const float* p, float (&f)[8]) { const f32x4 a = *(const f32x4*)p, b = *(const f32x4*)(p + 4);
    f[0] = a.x; f[1] = a.y; f[2] = a.z; f[3] = a.w; f[4] = b.x; f[5] = b.y; f[6] = b.z; f[7] = b.w; }
__device__ __forceinline__ float lam_of(float log2_decay) { const float x = -fexp2(log2_decay);
    float s = -1.f / 8.f; s = s * x + 1.f / 7.f; s = s * x - 1.f / 6.f; s = s * x + 1.f / 5.f; s = s * x - 1.f / 4.f; s = s * x + 1.f / 3.f; s = s * x - 0.5f; s = s * x + 1.f; return s * x; }
__device__ __forceinline__ f32x4 mfma16(bf16x8 a, bf16x8 b, f32x4 c) { return __builtin_amdgcn_mfma_f32_16x16x32_bf16(a, b, c, 0, 0, 0); }
__device__ __forceinline__ f32x16 mfma32(bf16x8 a, bf16x8 b, f32x16 c) { return __builtin_amdgcn_mfma_f32_32x32x16_bf16(a, b, c, 0, 0, 0); }

struct P0Item { const float* W; bf16* WT; int K, N, item; };
__device__ __forceinline__ void p0_item_load(const P0Item& d, int lane, float (&ld)[32]) {
    const int nblk = d.N / 32, kb = d.item / nblk, nb = d.item % nblk; const float* src = d.W + (size_t)(64 * kb + (lane >> 5)) * d.N + 32 * nb + (lane & 31);
#pragma unroll
    for (int i = 0; i < 32; ++i) ld[i] = __builtin_nontemporal_load(src + (size_t)(2 * i) * d.N);
}
__device__ __forceinline__ void p0_item_finish(const P0Item& d, int lane, const float (&ld)[32], LAS float* scr) {
    const int nblk = d.N / 32, kb = d.item / nblk, nb = d.item % nblk, k0 = 64 * kb, n0 = 32 * nb;
#pragma unroll
    for (int i = 0; i < 32; ++i) scr[(2 * i + (lane >> 5)) * 33 + (lane & 31)] = ld[i];
    LDS_WAIT(); asm volatile("" ::: "memory");
    const int c = lane & 7;
#pragma unroll
    for (int j = 0; j < 4; ++j) { const int n = (lane >> 3) + 8 * j; const LAS float* s = scr + (8 * c) * 33 + n;
        v4u o; o.x = pk2(s[0 * 33], s[1 * 33]); o.y = pk2(s[2 * 33], s[3 * 33]); o.z = pk2(s[4 * 33], s[5 * 33]); o.w = pk2(s[6 * 33], s[7 * 33]);
        __builtin_nontemporal_store(o, (GAS v4u*)(d.WT + (size_t)(n0 + n) * d.K + k0 + 8 * c)); }
    LDS_WAIT(); asm volatile("" ::: "memory");
}
struct ProIn { const float *x, *c, *ctx, *c_ctx, *w_mod, *b_mod, *mlp_w1, *mlp_w2, *ev_w_in, *ev_w_out, *od_w_in, *od_w_out, *od_w_uq, *od_w_ukv; };
__device__ __forceinline__ void ph_prologue(const ProIn a, unsigned char* ws, LAS unsigned char* lds, int tid, int wave, int lane, int wg, int G) {
    float* mod = (float*)(ws + WS_MOD);
    for (int u = wg; u < 192; u += G) {
        LAS float* sl = (LAS float*)lds;
        LAS float* red = (LAS float*)(lds + 24576);
        for (int i = tid; i < 3 * DM; i += NTHR) { const int s = i >> 11, k = i & 2047; const float cv = (s < 2) ? a.c[s * DM + k] : a.c_ctx[k]; sl[i] = cv / (1.f + __expf(-cv)); }
        __syncthreads();
        const int l = u / 48, j0 = (u % 48) * 256;
        const float* wp = a.w_mod + ((size_t)l * DM + wave * 256) * 12288 + j0 + 4 * lane;
        f32x4 a0 = {0.f, 0.f, 0.f, 0.f}, a1 = a0, a2 = a0;
#pragma unroll 8
        for (int k = 0; k < 256; ++k) { const f32x4 w = *(const f32x4*)(wp + (size_t)k * 12288); const int kk = wave * 256 + k;
            a0 += sl[kk] * w; a1 += sl[DM + kk] * w; a2 += sl[2 * DM + kk] * w; }
        *(LAS f32x4*)(red + (wave * 3 + 0) * 256 + 4 * lane) = a0; *(LAS f32x4*)(red + (wave * 3 + 1) * 256 + 4 * lane) = a1; *(LAS f32x4*)(red + (wave * 3 + 2) * 256 + 4 * lane) = a2;
        __syncthreads();
        for (int i = tid; i < 768; i += NTHR) { const int s = i >> 8, col = i & 255; float v = a.b_mod[l * 12288 + j0 + col];
#pragma unroll
            for (int w = 0; w < 8; ++w) v += red[(w * 3 + s) * 256 + col];
            mod[(size_t)(l * 3 + s) * 12288 + j0 + col] = v; }
        __syncthreads();
    }
    {
        LAS float* scr = (LAS float*)(lds + wave * 16384);
        const int gw = wg * NWAVES + wave, NGW = G * NWAVES;
        constexpr int I_W1 = 32 * 256, I_W2 = 128 * 64, I_EI = 32 * 176, I_EO = 32 * 64, I_OI = 32 * 122, I_OO = 32 * 64, I_UQ = 8 * 48, I_UKV = 4 * 64;
        constexpr int NIT = 4 * I_W1 + 4 * I_W2 + 2 * (I_EI + I_EO + I_OI + I_OO + I_UQ + I_UKV);
#define P0_DECODE(it_, d) do { int r = (it_); \
            if (r < 4 * I_W1) { const int l = r / I_W1; d = P0Item{a.mlp_w1 + (size_t)l * DM * DFF, (bf16*)(ws + WS_W1T) + (size_t)l * DFF * DM, DM, DFF, r % I_W1}; break; } r -= 4 * I_W1; \
            if (r < 4 * I_W2) { const int l = r / I_W2; d = P0Item{a.mlp_w2 + (size_t)l * DFF * DM, (bf16*)(ws + WS_W2T) + (size_t)l * DM * DFF, DFF, DM, r % I_W2}; break; } r -= 4 * I_W2; \
            if (r < 2 * I_EI) { const int l = r / I_EI; d = P0Item{a.ev_w_in + (size_t)l * DM * EV_IN, (bf16*)(ws + WS_EWIN) + (size_t)l * EV_IN * DM, DM, EV_IN, r % I_EI}; break; } r -= 2 * I_EI; \
            if (r < 2 * I_EO) { const int l = r / I_EO; d = P0Item{a.ev_w_out + (size_t)l * DM * DM, (bf16*)(ws + WS_EWOUT) + (size_t)l * DM * DM, DM, DM, r % I_EO}; break; } r -= 2 * I_EO; \
            if (r < 2 * I_OI) { const int l = r / I_OI, it2 = r % I_OI, nb = it2 % 122;     \
                bf16* dst = nb < 120 ? (bf16*)(ws + WS_OWIN) + (size_t)l * OD_INP * DM : (bf16*)(ws + WS_WKRT) + (size_t)l * 64 * DM - (size_t)OD_INP * DM; \
                d = P0Item{a.od_w_in + (size_t)l * DM * OD_IN, dst, DM, OD_IN, it2}; break; } r -= 2 * I_OI; \
            if (r < 2 * I_OO) { const int l = r / I_OO; d = P0Item{a.od_w_out + (size_t)l * DM * DM, (bf16*)(ws + WS_OWOUT) + (size_t)l * DM * DM, DM, DM, r % I_OO}; break; } r -= 2 * I_OO; \
            if (r < 2 * I_UQ) { const int l = r / I_UQ; d = P0Item{a.od_w_uq + (size_t)l * 512 * 1536, (bf16*)(ws + WS_UQT) + (size_t)l * 1536 * 512, 512, 1536, r % I_UQ}; break; } r -= 2 * I_UQ; \
            { const int l = r / I_UKV; d = P0Item{a.od_w_ukv + (size_t)l * 256 * 2048, (bf16*)(ws + WS_UKVT) + (size_t)l * 2048 * 256, 256, 2048, r % I_UKV}; } } while (0)
        P0Item dA, dB; float ldA[32], ldB[32];
        int it = gw;
        if (it < NIT) { P0_DECODE(it, dA); p0_item_load(dA, lane, ldA); }
        while (it < NIT) {
            if (it + NGW < NIT) { P0_DECODE(it + NGW, dB); p0_item_load(dB, lane, ldB); }
            p0_item_finish(dA, lane, ldA, scr);
            it += NGW;
            if (it >= NIT) break;
            if (it + NGW < NIT) { P0_DECODE(it + NGW, dA); p0_item_load(dA, lane, ldA); }
            p0_item_finish(dB, lane, ldB, scr);
            it += NGW;
        }
#undef P0_DECODE
    }
    const int gt = wg * NTHR + tid, NGT = G * NTHR;
    {
        const double INV2PI = 0.15915494309189533576888;
        const float L2B = 13.287712379549449f;
        float* t1c = (float*)(ws + WS_T1C); float* t1s = (float*)(ws + WS_T1S);
        for (int i = gt; i < TL * 64; i += NGT) { const int pos = i >> 6, f = i & 63; const float inv = fexp2(-(float)(2 * f) / 128.f * L2B); const float ang = (float)pos * inv;
            double rev = (double)ang * INV2PI; rev -= __builtin_rint(rev); const float fr = (float)rev; t1c[i] = __builtin_amdgcn_cosf(fr); t1s[i] = __builtin_amdgcn_sinf(fr); }
        float* t2c = (float*)(ws + WS_T2); float* t2s = t2c + 64 * 32; float* t3c = t2s + 64 * 32; float* t3s = t3c + 64 * 16;
        for (int i = gt; i < 64 * 32; i += NGT) { const int pos = i >> 5, f = i & 31; const float inv = fexp2(-(float)(2 * f) / 64.f * L2B); const float ang = (float)pos * inv;
            double rev = (double)ang * INV2PI; rev -= __builtin_rint(rev); const float fr = (float)rev; t2c[i] = __builtin_amdgcn_cosf(fr); t2s[i] = __builtin_amdgcn_sinf(fr); }
        for (int i = gt; i < 64 * 16; i += NGT) { const int pos = i >> 4, f = i & 15; const float inv = fexp2(-(float)(2 * f) / 32.f * L2B); const float ang = (float)pos * inv;
            double rev = (double)ang * INV2PI; rev -= __builtin_rint(rev); const float fr = (float)rev; t3c[i] = __builtin_amdgcn_cosf(fr); t3s[i] = __builtin_amdgcn_sinf(fr); }
    }
}

__device__ __forceinline__ void ph_norm(bool src32, const float* Hc, const float* Hx, const bf16* Hb, const float* nw, const float* mod_l, int ch_sh, int ch_sc, bf16* A, int row_lo, LAS unsigned char* lds, int tid, int gw, int NGW, int lane) {
    LAS float* comb = (LAS float*)(lds + 1024);
    for (int i = tid; i < 3 * DM; i += NTHR) { const int set = i >> 11, col = i & 2047; comb[(set * 2 + 0) * DM + col] = nw[col] * (1.f + mod_l[(size_t)(set * 6 + ch_sc) * DM + col]); comb[(set * 2 + 1) * DM + col] = mod_l[(size_t)(set * 6 + ch_sh) * DM + col]; }
    __syncthreads();
#define NORM_ROW_OUT(vv, r_) do { float ss = 0.f; \
        _Pragma("unroll") for (int j = 0; j < 8; ++j) ss += (vv[j].x * vv[j].x + vv[j].y * vv[j].y) + (vv[j].z * vv[j].z + vv[j].w * vv[j].w); \
        ss = wave_sum(ss); \
        const float rs = 1.f / sqrtf(ss * (1.f / DM) + EPS); \
        const LAS float* ca = comb + (row_set(r_) * 2) * DM; const LAS float* cb = ca + DM; \
        v2u* o = (v2u*)(A + (size_t)(r_) * DM) + lane; \
        _Pragma("unroll") for (int j = 0; j < 8; ++j) { const int col = 256 * j + 4 * lane; const f32x4 w = *(const LAS f32x4*)(ca + col), t = *(const LAS f32x4*)(cb + col); \
            const f32x4 y = (vv[j] * rs) * w + t; v2u q; q.x = pk2(y.x, y.y); q.y = pk2(y.z, y.w); o[64 * j] = q; } } while (0)
    if (src32) {
        for (int r0 = row_lo + gw; r0 < RALL; r0 += 2 * NGW) {
            f32x4 va[8], vb[8]; const int r1 = r0 + NGW; const bool h1 = r1 < RALL;
            { const f32x4* xr = (const f32x4*)(r0 < RC ? Hc + (size_t)r0 * DM : Hx + (size_t)(r0 - RC) * DM) + lane;
#pragma unroll
              for (int j = 0; j < 8; ++j) va[j] = xr[64 * j]; }
            if (h1) { const f32x4* xr = (const f32x4*)(r1 < RC ? Hc + (size_t)r1 * DM : Hx + (size_t)(r1 - RC) * DM) + lane;
#pragma unroll
              for (int j = 0; j < 8; ++j) vb[j] = xr[64 * j]; }
            NORM_ROW_OUT(va, r0);
            if (h1) NORM_ROW_OUT(vb, r1);
        }
    } else {
        for (int r0 = row_lo + gw; r0 < RALL; r0 += 5 * NGW) {
            v2u pk[5][8];
#pragma unroll
            for (int b = 0; b < 5; ++b) { const int r = r0 + b * NGW; if (r < RALL) { const v2u* xr = (const v2u*)(Hb + (size_t)r * DM) + lane;
#pragma unroll
                for (int j = 0; j < 8; ++j) pk[b][j] = xr[64 * j]; } }
#pragma unroll
            for (int b = 0; b < 5; ++b) { const int r = r0 + b * NGW; if (r < RALL) { f32x4 v[8];
#pragma unroll
                for (int j = 0; j < 8; ++j) v[j] = (f32x4){bflo(pk[b][j].x), bfhi(pk[b][j].x), bflo(pk[b][j].y), bfhi(pk[b][j].y)};
                NORM_ROW_OUT(v, r); } }
        }
    }
#undef NORM_ROW_OUT
    __syncthreads();
}
template <int NPART> __device__ __forceinline__ void ph_norm_ctx(const float* Hin32, bf16* H, const float* nw, const float* mod_l, int ch_sh, int ch_sc, bf16* A, const bf16* part, const float* pgate, LAS unsigned char* lds, int tid, int wave, int lane, int wg, int G) {
    LAS float* red = (LAS float*)lds;
    const float* sh = mod_l + (size_t)(2 * 6 + ch_sh) * DM; const float* sc = mod_l + (size_t)(2 * 6 + ch_sc) * DM;
    const int col = 256 * wave + 4 * lane;
    for (int r = wg; r < RC; r += G) {
        f32x4 h;
        if (Hin32) h = *(const f32x4*)(Hin32 + (size_t)r * DM + col);
        else { const v2u w = *(const v2u*)(H + (size_t)r * DM + col); h = (f32x4){bflo(w.x), bfhi(w.x), bflo(w.y), bfhi(w.y)}; }
        f32x4 acc = {0.f, 0.f, 0.f, 0.f};
        v2u pw[NPART];
#pragma unroll
        for (int s = 0; s < NPART; ++s) pw[s] = *(const v2u*)(part + ((size_t)s * RC + r) * DM + col);
#pragma unroll
        for (int s = 0; s < NPART; ++s) acc += (f32x4){bflo(pw[s].x), bfhi(pw[s].x), bflo(pw[s].y), bfhi(pw[s].y)};
        h += *(const f32x4*)(pgate + col) * acc;
        { v2u w; w.x = pk2(h.x, h.y); w.y = pk2(h.z, h.w); *(v2u*)(H + (size_t)r * DM + col) = w;
          h = (f32x4){bflo(w.x), bfhi(w.x), bflo(w.y), bfhi(w.y)}; }
        float ss = wave_sum((h.x * h.x + h.y * h.y) + (h.z * h.z + h.w * h.w));
        if (lane == 0) red[wave] = ss;
        __syncthreads();
        float tot = 0.f;
#pragma unroll
        for (int w = 0; w < 8; ++w) tot += red[w];
        __syncthreads();
        const float rs = 1.f / sqrtf(tot * (1.f / DM) + EPS);
        const f32x4 w4 = *(const f32x4*)(nw + col), s4 = *(const f32x4*)(sc + col), t4 = *(const f32x4*)(sh + col);
        const f32x4 y = (h * rs) * w4 * (s4 + 1.f) + t4; v2u q; q.x = pk2(y.x, y.y); q.y = pk2(y.z, y.w);
        *(v2u*)(A + (size_t)r * DM + col) = q;
    }
}
__device__ __forceinline__ void ph_final(const bf16* H, const float* nw, float* out, int gw, int NGW, int lane) {
    f32x4 wv[8];
#pragma unroll
    for (int j = 0; j < 8; ++j) wv[j] = *(const f32x4*)(nw + 256 * j + 4 * lane);
    for (int r0 = gw; r0 < NB * TL; r0 += 4 * NGW) {
        v2u pk[4][8];
#pragma unroll
        for (int b = 0; b < 4; ++b) { const int r = r0 + b * NGW; if (r < NB * TL) { const v2u* xr = (const v2u*)(H + (size_t)(RC + r) * DM) + lane;
#pragma unroll
            for (int j = 0; j < 8; ++j) pk[b][j] = xr[64 * j]; } }
#pragma unroll
        for (int b = 0; b < 4; ++b) { const int r = r0 + b * NGW; if (r < NB * TL) { f32x4 v[8]; float ss = 0.f;
#pragma unroll
            for (int j = 0; j < 8; ++j) { v[j] = (f32x4){bflo(pk[b][j].x), bfhi(pk[b][j].x), bflo(pk[b][j].y), bfhi(pk[b][j].y)}; ss += (v[j].x * v[j].x + v[j].y * v[j].y) + (v[j].z * v[j].z + v[j].w * v[j].w); }
            ss = wave_sum(ss);
            const float rs = 1.f / sqrtf(ss * (1.f / DM) + EPS);
            f32x4* o = (f32x4*)(out + (size_t)r * DM) + lane;
#pragma unroll
            for (int j = 0; j < 8; ++j) o[64 * j] = (v[j] * rs) * wv[j]; } }
    }
}

__device__ __forceinline__ void vt_tile(const bf16* src, int ld_src, bf16* dst, LAS unsigned char* scr, int lane) {
#pragma unroll
    for (int it = 0; it < 8; ++it) { const int key = it * 8 + (lane >> 3), pc = lane & 7;
        const v4u w = *(const v4u*)(src + (size_t)key * ld_src + pc * 8); *(LAS v4u*)(scr + key * 144 + pc * 16) = w; }
    LDS_WAIT(); asm volatile("" ::: "memory");
#pragma unroll
    for (int q = 0; q < 8; ++q) { unsigned e[8];
#pragma unroll
        for (int i = 0; i < 8; ++i) e[i] = *(const LAS unsigned short*)(scr + (16 * (q >> 1) + 4 * (q & 1) + 8 * (i >> 2) + (i & 3)) * 144 + lane * 2);
        v4u w; w.x = e[0] | (e[1] << 16); w.y = e[2] | (e[3] << 16); w.z = e[4] | (e[5] << 16); w.w = e[6] | (e[7] << 16);
        *(v4u*)(dst + (size_t)lane * NKEY + 8 * q) = w; }
    LDS_WAIT(); asm volatile("" ::: "memory");
}
__device__ __forceinline__ int key_row(int b, int kk) { return kk < TC ? b * TC + kk : RC + b * TL + (kk - TC); }

__device__ __forceinline__ void post_win_tile(unsigned char* ws, LAS unsigned char* lds, int pm, int pn, int tid, int wave, int lane) {
    bf16* prj = (bf16*)(ws + WS_PRJ);
    if (pn >= 16 && pn <= 20) {
        if (pm < 2) return;
        const float* t2c = (const float*)(ws + WS_T2); const float* t2s = t2c + 64 * 32;
        for (int idx0 = tid; idx0 < 256 * 16; idx0 += 4 * NTHR) {
            v4u w1[4], w2[4]; bf16* bp[4]; int tb[4];
#pragma unroll
            for (int q = 0; q < 4; ++q) { const int idx = idx0 + q * NTHR; const int p = idx & 3, half = (idx >> 2) & 1, hh = (idx >> 3) & 1, i = idx >> 4;
                const int r = pm * 256 + i, t = (r - RC) & (TL - 1), posv = half ? (t & 63) : (t >> 6);
                bp[q] = prj + (size_t)r * EV_IN + 256 * pn + hh * 128 + half * 64 + 8 * p; tb[q] = posv * 32 + 8 * p;
                w1[q] = *(const v4u*)bp[q]; w2[q] = *(const v4u*)(bp[q] + 32); }
#pragma unroll
            for (int q = 0; q < 4; ++q) { float x1[8], x2[8], cs[8], sn[8], o1[8], o2[8];
                unpack8(w1[q], x1); unpack8(w2[q], x2); ld8f(t2c + tb[q], cs); ld8f(t2s + tb[q], sn);
#pragma unroll
                for (int e = 0; e < 8; ++e) { o1[e] = x1[e] * cs[e] - x2[e] * sn[e]; o2[e] = x2[e] * cs[e] + x1[e] * sn[e]; }
                *(v4u*)bp[q] = pack8(o1); *(v4u*)(bp[q] + 32) = pack8(o2); }
        }
    } else if (pn == 21) {
        bf16* vtw = (bf16*)(ws + WS_VTW); LAS unsigned char* scr = lds + wave * 16384;
        const int b = pm < 2 ? pm : ((pm - 2) >> 4), kt0 = pm < 2 ? 0 : 4 + ((pm - 2) & 15) * 4;
        for (int q = 0; q < 2; ++q) { const int it = wave * 2 + q, dvh = it & 1, kvh = (it >> 1) & 1, kt = kt0 + (it >> 2);
            const int row0 = key_row(b, 64 * kt);
            vt_tile(prj + (size_t)row0 * EV_IN + E_VW + kvh * 128 + dvh * 64, EV_IN, vtw + ((size_t)(b * 2 + kvh) * 128 + dvh * 64) * NKEY + 64 * kt, scr, lane); }
    }
}

__device__ __forceinline__ void ret_kv_unit(unsigned char* ws, const float* dec, LAS unsigned char* lds, int tid, int wave, int lane, int u) {
    const int bh = u / NCH, c = u % NCH, b = bh >> 3, h = bh & 7;
    const bool isctx = c < 2;
    const int row0 = isctx ? b * TC + c * 128 : RC + b * TL + (c - 2) * 128, pos0 = isctx ? 0 : (c - 2) * 128;
    const bf16* prj = (const bf16*)(ws + WS_PRJ);
    const float* t1c = (const float*)(ws + WS_T1C); const float* t1s = (const float*)(ws + WS_T1S);
    const float lf2 = lam_of(dec[h]) * LOG2E, lb2 = lam_of(dec[8 + h]) * LOG2E;
    LAS bf16* KTf = (LAS bf16*)lds; LAS bf16* KTb = KTf + 128 * 136; LAS bf16* VTs = KTb + 128 * 136;
    for (int it = tid; it < 1024; it += NTHR) { const int t = it & 127, p = it >> 7;
        const bf16* kr = prj + (size_t)(row0 + t) * EV_IN + E_KR + h * 128 + 8 * p;
        float x1[8], x2[8]; unpack8(*(const v4u*)kr, x1); unpack8(*(const v4u*)(kr + 64), x2);
        if (!isctx) { float cs[8], sn[8]; ld8f(t1c + (size_t)(pos0 + t) * 64 + 8 * p, cs); ld8f(t1s + (size_t)(pos0 + t) * 64 + 8 * p, sn);
#pragma unroll
            for (int e = 0; e < 8; ++e) { const float a1 = x1[e] * cs[e] - x2[e] * sn[e], a2 = x2[e] * cs[e] + x1[e] * sn[e]; x1[e] = a1; x2[e] = a2; } }
        const float ft = fexp2(lf2 * (float)(127 - t)), bt = fexp2(lb2 * (float)t);
#pragma unroll
        for (int e = 0; e < 8; ++e) { KTf[(8 * p + e) * 136 + t] = f2bf(x1[e] * ft); KTf[(64 + 8 * p + e) * 136 + t] = f2bf(x2[e] * ft);
            KTb[(8 * p + e) * 136 + t] = f2bf(x1[e] * bt); KTb[(64 + 8 * p + e) * 136 + t] = f2bf(x2[e] * bt); }
    }
    for (int it = tid; it < 2048; it += NTHR) { const int t = it & 127, p = it >> 7;
        const v4u w = *(const v4u*)(prj + (size_t)(row0 + t) * EV_IN + E_VR + h * 128 + 8 * p);
#pragma unroll
        for (int i = 0; i < 4; ++i) { VTs[(8 * p + 2 * i) * 136 + t] = (bf16)(w[i] & 0xffffu); VTs[(8 * p + 2 * i + 1) * 136 + t] = (bf16)(w[i] >> 16); }
    }
    __syncthreads();
    const int dir = wave >> 2, dvb = (wave & 3) * 32, fr = lane & 15, fq = lane >> 4;
    const LAS bf16* KT = dir ? KTb : KTf;
    f32x4 acc[2][8];
#pragma unroll
    for (int m = 0; m < 2; ++m)
#pragma unroll
        for (int n = 0; n < 8; ++n) acc[m][n] = (f32x4){0.f, 0.f, 0.f, 0.f};
#pragma unroll
    for (int s = 0; s < 4; ++s) {
        bf16x8 af[2];
#pragma unroll
        for (int m = 0; m < 2; ++m) af[m] = *(const LAS bf16x8*)(VTs + (dvb + 16 * m + fr) * 136 + 32 * s + 8 * fq);
#pragma unroll
        for (int n = 0; n < 8; ++n) { const bf16x8 bfr = *(const LAS bf16x8*)(KT + (16 * n + fr) * 136 + 32 * s + 8 * fq);
#pragma unroll
            for (int m = 0; m < 2; ++m) acc[m][n] = mfma16(af[m], bfr, acc[m][n]); }
    }
    float* o = (float*)(ws + WS_KVST) + ((size_t)(dir * 16 + bh) * NCH + c) * 16384;
#pragma unroll
    for (int m = 0; m < 2; ++m)
#pragma unroll
        for (int n = 0; n < 8; ++n)
#pragma unroll
            for (int r = 0; r < 4; ++r) o[(dvb + 16 * m + 4 * fq + r) * 128 + 16 * n + fr] = acc[m][n][r];
    __syncthreads();
}
__device__ __forceinline__ void ph_ret_scan(unsigned char* ws, const float* dec, int tid, int wg, int G) {
    for (int w = wg; w < 256; w += G) {
        const int s = w >> 3, slice = w & 7, dir = s >> 4, bh = s & 15, h = bh & 7;
        const float g = fexp2(lam_of(dec[dir * 8 + h]) * LOG2E * 128.f);
        const size_t e0 = (size_t)slice * 2048 + tid * 4;
        const float* kv = (const float*)(ws + WS_KVST) + (size_t)(dir * 16 + bh) * NCH * 16384 + e0;
        bf16* st = (bf16*)(ws + WS_ST) + (size_t)(dir * 16 + bh) * NCH * 16384 + e0;
        f32x4 S = {0.f, 0.f, 0.f, 0.f};
#pragma unroll
        for (int half = 0; half < 2; ++half) {
            f32x4 buf[17];
#pragma unroll
            for (int i = 0; i < 17; ++i) { const int k = half * 17 + i; const int c = dir ? (k == 0 ? 1 : (k == 1 ? 0 : 35 - k)) : k; buf[i] = *(const f32x4*)(kv + (size_t)c * 16384); }
#pragma unroll
            for (int i = 0; i < 17; ++i) { const int k = half * 17 + i; const int c = dir ? (k == 0 ? 1 : (k == 1 ? 0 : 35 - k)) : k;
                v2u q; q.x = pk2(S.x, S.y); q.y = pk2(S.z, S.w); *(v2u*)(st + (size_t)c * 16384) = q; S = S * g + buf[i]; }
        }
    }
}
__device__ __forceinline__ void ret_out_unit(unsigned char* ws, const float* dec, const float* gnw, LAS unsigned char* lds, int tid, int wave, int lane, int u) {
    const int bh = u / NCH, c = u % NCH, b = bh >> 3, h = bh & 7;
    const bool isctx = c < 2;
    const int row0 = isctx ? b * TC + c * 128 : RC + b * TL + (c - 2) * 128, pos0 = isctx ? 0 : (c - 2) * 128;
    const bf16* prj = (const bf16*)(ws + WS_PRJ);
    const float* t1c = (const float*)(ws + WS_T1C); const float* t1s = (const float*)(ws + WS_T1S);
    const float lf2 = lam_of(dec[h]) * LOG2E, lb2 = lam_of(dec[8 + h]) * LOG2E;
    const float scale = 0.088388347648318440f;
    LAS bf16* Qs = (LAS bf16*)lds; LAS bf16* Ks = Qs + 128 * 136; LAS bf16* VTs = Ks + 128 * 136; LAS bf16* Ps = VTs + 128 * 136;
    for (int it = tid; it < 1024; it += NTHR) { const int t = it >> 3, p = it & 7;
        const bf16* qr = prj + (size_t)(row0 + t) * EV_IN + E_QR + h * 128 + 8 * p; const bf16* kr = qr + (E_KR - E_QR);
        float q1[8], q2[8], k1[8], k2[8]; unpack8(*(const v4u*)qr, q1); unpack8(*(const v4u*)(qr + 64), q2); unpack8(*(const v4u*)kr, k1); unpack8(*(const v4u*)(kr + 64), k2);
        if (!isctx) { float cs[8], sn[8]; ld8f(t1c + (size_t)(pos0 + t) * 64 + 8 * p, cs); ld8f(t1s + (size_t)(pos0 + t) * 64 + 8 * p, sn);
#pragma unroll
            for (int e = 0; e < 8; ++e) { const float a1 = q1[e] * cs[e] - q2[e] * sn[e], a2 = q2[e] * cs[e] + q1[e] * sn[e]; q1[e] = a1; q2[e] = a2;
                const float b1 = k1[e] * cs[e] - k2[e] * sn[e], b2 = k2[e] * cs[e] + k1[e] * sn[e]; k1[e] = b1; k2[e] = b2; } }
        *(LAS v4u*)(Qs + t * 136 + 8 * p) = pack8(q1); *(LAS v4u*)(Qs + t * 136 + 64 + 8 * p) = pack8(q2);
        *(LAS v4u*)(Ks + t * 136 + 8 * p) = pack8(k1); *(LAS v4u*)(Ks + t * 136 + 64 + 8 * p) = pack8(k2);
    }
    for (int it = tid; it < 2048; it += NTHR) { const int t = it & 127, p = it >> 7;
        const v4u w = *(const v4u*)(prj + (size_t)(row0 + t) * EV_IN + E_VR + h * 128 + 8 * p);
#pragma unroll
        for (int i = 0; i < 4; ++i) { VTs[(8 * p + 2 * i) * 136 + t] = (bf16)(w[i] & 0xffffu); VTs[(8 * p + 2 * i + 1) * 136 + t] = (bf16)(w[i] >> 16); }
    }
    __syncthreads();
    v4u streg[2][4];
    { const bf16* st0 = (const bf16*)(ws + WS_ST) + ((size_t)bh * NCH + c) * 16384;
#pragma unroll
      for (int dir = 0; dir < 2; ++dir)
#pragma unroll
          for (int j = 0; j < 4; ++j) streg[dir][j] = *(const v4u*)(st0 + (size_t)dir * 16 * NCH * 16384 + (size_t)(tid + NTHR * j) * 8); }
    const int i0 = 16 * wave, fr = lane & 15, fq = lane >> 4;
    bf16x8 qa[4];
#pragma unroll
    for (int s = 0; s < 4; ++s) qa[s] = *(const LAS bf16x8*)(Qs + (i0 + fr) * 136 + 32 * s + 8 * fq);
#pragma unroll
    for (int n = 0; n < 8; ++n) { f32x4 sa = {0.f, 0.f, 0.f, 0.f};
#pragma unroll
        for (int s = 0; s < 4; ++s) { const bf16x8 kb = *(const LAS bf16x8*)(Ks + (16 * n + fr) * 136 + 32 * s + 8 * fq); sa = mfma16(qa[s], kb, sa); }
#pragma unroll
        for (int r = 0; r < 4; ++r) { const int d = (i0 + 4 * fq + r) - (16 * n + fr);
            const float dcy = d >= 0 ? fexp2(lf2 * (float)d) : fexp2(lb2 * (float)(-d));
            Ps[(i0 + 4 * fq + r) * 136 + 16 * n + fr] = f2bf(sa[r] * scale * dcy); }
    }
    LDS_WAIT(); asm volatile("" ::: "memory");
    f32x4 O[8];
#pragma unroll
    for (int n = 0; n < 8; ++n) O[n] = (f32x4){0.f, 0.f, 0.f, 0.f};
#pragma unroll
    for (int s = 0; s < 4; ++s) { const bf16x8 pa = *(const LAS bf16x8*)(Ps + (i0 + fr) * 136 + 32 * s + 8 * fq);
#pragma unroll
        for (int n = 0; n < 8; ++n) { const bf16x8 vb = *(const LAS bf16x8*)(VTs + (16 * n + fr) * 136 + 32 * s + 8 * fq); O[n] = mfma16(pa, vb, O[n]); } }
    __syncthreads();
#pragma unroll
    for (int dir = 0; dir < 2; ++dir)
#pragma unroll
        for (int j = 0; j < 4; ++j) { const int e = (tid + NTHR * j) * 8, dvr = e >> 7, dkc = e & 127; *(LAS v4u*)((dir ? Qs : Ks) + dvr * 136 + dkc) = streg[dir][j]; }
    __syncthreads();
#pragma unroll
    for (int dir = 0; dir < 2; ++dir) {
        const LAS bf16* st = dir ? Qs : Ks;
        f32x4 T[8];
#pragma unroll
        for (int n = 0; n < 8; ++n) T[n] = (f32x4){0.f, 0.f, 0.f, 0.f};
#pragma unroll
        for (int s = 0; s < 4; ++s)
#pragma unroll
            for (int n = 0; n < 8; ++n) { const bf16x8 sb = *(const LAS bf16x8*)(st + (16 * n + fr) * 136 + 32 * s + 8 * fq); T[n] = mfma16(qa[s], sb, T[n]); }
#pragma unroll
        for (int r = 0; r < 4; ++r) { const int il = i0 + 4 * fq + r; const float fac = scale * (dir == 0 ? fexp2(lf2 * (float)(il + 1)) : fexp2(lb2 * (float)(128 - il)));
#pragma unroll
            for (int n = 0; n < 8; ++n) O[n][r] += T[n][r] * fac; }
    }
    bf16* mix = (bf16*)(ws + WS_MIX);
    unsigned short gtv[4][8]; float gw8[8];
#pragma unroll
    for (int n = 0; n < 8; ++n) gw8[n] = gnw[h * 128 + 16 * n + fr];
#pragma unroll
    for (int r = 0; r < 4; ++r)
#pragma unroll
        for (int n = 0; n < 8; ++n) gtv[r][n] = prj[(size_t)(row0 + i0 + 4 * fq + r) * EV_IN + E_GR + h * 128 + 16 * n + fr];
#pragma unroll
    for (int r = 0; r < 4; ++r) {
        float s1 = 0.f;
#pragma unroll
        for (int n = 0; n < 8; ++n) s1 += O[n][r];
        s1 += __shfl_xor(s1, 1); s1 += __shfl_xor(s1, 2); s1 += __shfl_xor(s1, 4); s1 += __shfl_xor(s1, 8);
        const float mu = s1 * (1.f / 128.f);
        float s2 = 0.f;
#pragma unroll
        for (int n = 0; n < 8; ++n) { const float d = O[n][r] - mu; s2 += d * d; }
        s2 += __shfl_xor(s2, 1); s2 += __shfl_xor(s2, 2); s2 += __shfl_xor(s2, 4); s2 += __shfl_xor(s2, 8);
        const float rstd = 1.f / sqrtf(s2 * (1.f / 128.f) + EPS);
        const int row = row0 + i0 + 4 * fq + r;
#pragma unroll
        for (int n = 0; n < 8; ++n) { const int dv = 16 * n + fr; const float gt = bf2f(gtv[r][n]);
            const float y = (O[n][r] - mu) * rstd * gw8[n] * (gt / (1.f + __expf(-gt)));
            mix[(size_t)row * DM + h * 128 + dv] = f2bf(y); }
    }
    __syncthreads();
}

template <int DQK, bool WINDOW, bool SINK>
__device__ __forceinline__ void attn_unit(LAS unsigned char* lds, int tid, int wave, int lane,
        const bf16* Qp, int ldq, const bf16* Kc, const bf16* Kl, int ldk, const bf16* K2c, const bf16* K2l, int ldk2, const bf16* VT,
        int nctx, int tlo, int thi, int q0, float sc_log2, float sink_log2, bf16* Op, int ldo) {
    constexpr int KS = DQK * 2 + 16, KT_BYTES = 64 * KS, VS = 144, VT_BYTES = 128 * VS, BUF = KT_BYTES + VT_BYTES;
    constexpr int NS = DQK / 16, KPT = DQK / 64;
    const int c = lane & 31, h = lane >> 5;
    bf16x8 qf[NS];
    { const bf16* qr = Qp + (size_t)(wave * 32 + c) * ldq + 8 * h;
#pragma unroll
      for (int s = 0; s < NS; ++s) qf[s] = *(const bf16x8*)(qr + 16 * s); }
    f32x16 oT[4];
#pragma unroll
    for (int dt = 0; dt < 4; ++dt)
#pragma unroll
        for (int r = 0; r < 16; ++r) oT[dt][r] = 0.f;
    float m_run = SINK ? sink_log2 : -1e30f, l_run = (SINK && h == 0) ? 1.f : 0.f;
    const int ntile = nctx + (thi - tlo);
    v4u kregA[KPT], vregA[2], kregB[KPT], vregB[2];
    const unsigned koff0 = (unsigned)((tid >> 4) * ldk + (tid & 15) * 8), koff1 = koff0 + 32u * (unsigned)ldk, koff2 = (unsigned)((tid >> 3) * ldk2 + (tid & 7) * 8);
    const unsigned voff0 = (unsigned)((tid >> 3) * NKEY + (tid & 7) * 8), voff1 = voff0 + 64u * NKEY;
    const int klds0 = (tid >> 4) * KS + (tid & 15) * 16, klds2 = (tid >> 3) * KS + 256 + (tid & 7) * 16, vlds0 = (tid >> 3) * VS + (tid & 7) * 16;
#define ATT_LOAD(i_, kreg, vreg) do { int _i = (i_); if (_i > ntile - 1) _i = ntile - 1; const bool _cx = _i < nctx; const int _t = _cx ? _i : tlo + (_i - nctx); \
        const bf16* _k = (_cx ? Kc : Kl) + (size_t)(64 * _t) * ldk; const int _vc = _cx ? 64 * _t : TC + 64 * _t; \
        kreg[0] = *(const v4u*)(_k + koff0); kreg[1] = *(const v4u*)(_k + koff1); \
        if (DQK > 128) { const bf16* _k2 = (_cx ? K2c : K2l) + (size_t)(64 * _t) * ldk2; kreg[KPT - 1] = *(const v4u*)(_k2 + koff2); } \
        vreg[0] = *(const v4u*)(VT + voff0 + _vc); vreg[1] = *(const v4u*)(VT + voff1 + _vc); } while (0)
#define ATT_STORE(buf_, kreg, vreg) do { LAS unsigned char* _kb = lds + (buf_) * BUF; LAS unsigned char* _vb = _kb + KT_BYTES; \
        *(LAS v4u*)(_kb + klds0) = kreg[0]; *(LAS v4u*)(_kb + klds0 + 32 * KS) = kreg[1]; \
        if (DQK > 128) *(LAS v4u*)(_kb + klds2) = kreg[KPT - 1]; \
        *(LAS v4u*)(_vb + vlds0) = vreg[0]; *(LAS v4u*)(_vb + vlds0 + 64 * VS) = vreg[1]; } while (0)
#define ATT_THR 8.0f
#define ATT_COMPUTE(i) do { \
        if (WINDOW && (i) >= nctx) { const int _k0 = 64 * (tlo + ((i) - nctx)), _qw = q0 + wave * 32; if (_k0 > _qw + 159 || _k0 + 63 < _qw - 128) break; }     \
        const LAS unsigned char* kb = lds + (i & 1) * BUF; const LAS unsigned char* vb = kb + KT_BYTES; \
        f32x16 sT[2]; \
        _Pragma("unroll") \
        for (int kt = 0; kt < 2; ++kt) \
        _Pragma("unroll") \
            for (int r = 0; r < 16; ++r) sT[kt][r] = 0.f; \
        { \
            constexpr int PF = 4, NQ = 2 * NS; \
            bf16x8 kf[PF]; \
        _Pragma("unroll") \
            for (int n = 0; n < PF; ++n) kf[n] = *(const LAS bf16x8*)(kb + (32 * (n / NS) + c) * KS + (16 * (n % NS) + 8 * h) * 2); \
        _Pragma("unroll") \
            for (int n = 0; n < NQ; ++n) { const bf16x8 ka = kf[n % PF]; \
                if (n + PF < NQ) kf[n % PF] = *(const LAS bf16x8*)(kb + (32 * ((n + PF) / NS) + c) * KS + (16 * ((n + PF) % NS) + 8 * h) * 2); \
                sT[n / NS] = mfma32(ka, qf[n % NS], sT[n / NS]); } \
        } \
        const bool msk = WINDOW && (i >= nctx); \
        const int kpos0 = 64 * (tlo + (i - nctx)), qpos = q0 + wave * 32 + c; \
        float mx = -1e38f; \
        _Pragma("unroll") \
        for (int kt = 0; kt < 2; ++kt) \
        _Pragma("unroll") \
            for (int r = 0; r < 16; ++r) { \
                if (WINDOW) { const int kpos = kpos0 + 32 * kt + (r & 3) + 8 * (r >> 2) + 4 * h; const int dd = qpos - kpos; if (msk && (dd > 128 || dd < -128)) sT[kt][r] = -1e38f; } \
                mx = fmaxf(mx, sT[kt][r]); } \
        mx = fmaxf(mx, __shfl_xor(mx, 32)); \
        const float mxs = mx * sc_log2; \
        if (__builtin_amdgcn_ballot_w64(mxs > m_run + ATT_THR) != 0ull) {     \
            const float mn = fmaxf(m_run, mxs), alpha = fexp2(m_run - mn); \
            m_run = mn; l_run *= alpha; \
            _Pragma("unroll") \
            for (int dt = 0; dt < 4; ++dt) \
            _Pragma("unroll") \
                for (int r = 0; r < 16; ++r) oT[dt][r] *= alpha; \
        } \
        float ps = 0.f; \
        _Pragma("unroll") \
        for (int kt = 0; kt < 2; ++kt) \
        _Pragma("unroll") \
            for (int r = 0; r < 16; ++r) { const float pv = fexp2(fmaf(sT[kt][r], sc_log2, -m_run)); sT[kt][r] = pv; ps += pv; } \
        l_run += ps; \
        bf16x8 pf[4]; \
        _Pragma("unroll") \
        for (int s = 0; s < 4; ++s) { const int kt = s >> 1, s8 = (s & 1) * 8; v4u w; \
            w.x = pk2(sT[kt][s8 + 0], sT[kt][s8 + 1]); w.y = pk2(sT[kt][s8 + 2], sT[kt][s8 + 3]); w.z = pk2(sT[kt][s8 + 4], sT[kt][s8 + 5]); w.w = pk2(sT[kt][s8 + 6], sT[kt][s8 + 7]); \
            pf[s] = __builtin_bit_cast(bf16x8, w); } \
        { \
            constexpr int PF = 4; \
            v4u vf[PF]; \
        _Pragma("unroll") \
            for (int n = 0; n < PF; ++n) vf[n] = *(const LAS v4u*)(vb + (32 * (n >> 2) + c) * VS + (16 * (n & 3) + 8 * h) * 2); \
        _Pragma("unroll") \
            for (int n = 0; n < 16; ++n) { const v4u va = vf[n % PF]; \
                if (n + PF < 16) { const int n2 = n + PF; vf[n % PF] = *(const LAS v4u*)(vb + (32 * (n2 >> 2) + c) * VS + (16 * (n2 & 3) + 8 * h) * 2); } \
                oT[n >> 2] = mfma32(__builtin_bit_cast(bf16x8, va), pf[n & 3], oT[n >> 2]); } \
        } \
    } while (0)
    if (ntile > 0) { ATT_LOAD(0, kregA, vregA); ATT_STORE(0, kregA, vregA); ATT_LOAD(1, kregB, vregB); }
    __syncthreads();
    for (int i = 0; i < ntile; i += 2) {
        ATT_LOAD(i + 2, kregA, vregA);
        ATT_COMPUTE(i);
        ATT_STORE((i + 1) & 1, kregB, vregB);
        __syncthreads();
        if (i + 1 < ntile) {
            ATT_LOAD(i + 3, kregB, vregB);
            ATT_COMPUTE(i + 1);
            ATT_STORE(i & 1, kregA, vregA);
            __syncthreads();
        }
    }
#undef ATT_COMPUTE
#undef ATT_THR
#undef ATT_LOAD
#undef ATT_STORE
    const float lt = l_run + __shfl_xor(l_run, 32), inv = 1.f / lt;
    bf16* orow = Op + (size_t)(wave * 32 + c) * ldo + 4 * h;
#pragma unroll
    for (int dt = 0; dt < 4; ++dt)
#pragma unroll
        for (int rq = 0; rq < 4; ++rq) { v2u w; w.x = pk2(oT[dt][4 * rq] * inv, oT[dt][4 * rq + 1] * inv); w.y = pk2(oT[dt][4 * rq + 2] * inv, oT[dt][4 * rq + 3] * inv);
            *(v2u*)(orow + 32 * dt + 8 * rq) = w; }
}

__device__ __forceinline__ void ph_win(unsigned char* ws, const float* sink, LAS unsigned char* lds, int tid, int wave, int lane, int wg, int G) {
    const bf16* prj = (const bf16*)(ws + WS_PRJ); bf16* mix = (bf16*)(ws + WS_MIX); const bf16* vtw = (const bf16*)(ws + WS_VTW);
    const float scl = 0.088388347648318440f * LOG2E;
    for (int u = wg; u < 272; u += G) {
        const bool cx = u >= 256;
        const int pair = cx ? (u - 256) : ((u & 7) * 2 + (u >> 7)), qb = (u >> 3) & 15, b = pair >> 3, hq = pair & 7, kvh = hq >> 2;
        const int q0 = cx ? 0 : qb * 256; int tlo = (q0 - 128) / 64; if (tlo < 0) tlo = 0; int thi = (q0 + 383) / 64 + 1; if (thi > 64) thi = 64; if (cx) { tlo = 0; thi = 0; }
        const int qrow = cx ? b * TC : RC + b * TL + q0;
        attn_unit<128, true, true>(lds, tid, wave, lane, prj + (size_t)qrow * EV_IN + E_QW + hq * 128, EV_IN,
            prj + (size_t)(b * TC) * EV_IN + E_KW + kvh * 128, prj + (size_t)(RC + b * TL) * EV_IN + E_KW + kvh * 128, EV_IN, nullptr, nullptr, 0,
            vtw + (size_t)(b * 2 + kvh) * 128 * NKEY, 4, tlo, thi, q0, scl, sink[hq] * LOG2E, mix + (size_t)qrow * DM + 1024 + hq * 128, DM);
    }
}
__device__ __forceinline__ void ph_ret_out(unsigned char* ws, const float* dec, const float* gnw, LAS unsigned char* lds, int tid, int wave, int lane, int wg, int G) {
    for (int u = (wg + G - 32) % G; u < 16 * NCH; u += G) ret_out_unit(ws, dec, gnw, lds, tid, wave, lane, u);
}

__device__ __forceinline__ void ph_prep_odd(unsigned char* ws, LAS unsigned char* lds, const float* convw, const float* qnw, const float* kvnw, int jl, int tid, int wave, int lane, int wg, int G) {
    const bf16* prj = (const bf16*)(ws + WS_PRJ); bf16* mix = (bf16*)(ws + WS_MIX);
    {
        const bf16* a1 = (const bf16*)(ws + WS_A1); const bf16* wk = (const bf16*)(ws + WS_WKRT) + (size_t)jl * 64 * DM; bf16* kr = (bf16*)(ws + WS_KR);
        const int fr = lane & 15, fq = lane >> 4;
        LAS f32x4* red = (LAS f32x4*)lds;
        for (int t = wg; t < RALL / 32; t += G) {
            f32x4 acc[2][4];
#pragma unroll
            for (int m = 0; m < 2; ++m)
#pragma unroll
                for (int n = 0; n < 4; ++n) acc[m][n] = (f32x4){0.f, 0.f, 0.f, 0.f};
            const bf16* ap = a1 + (size_t)(32 * t + fr) * DM + 256 * wave + 8 * fq; const bf16* bp = wk + (size_t)fr * DM + 256 * wave + 8 * fq;
#pragma unroll
            for (int s = 0; s < 8; ++s) { bf16x8 af[2], bfr[4];
#pragma unroll
                for (int m = 0; m < 2; ++m) af[m] = *(const bf16x8*)(ap + (size_t)(16 * m) * DM + 32 * s);
#pragma unroll
                for (int n = 0; n < 4; ++n) bfr[n] = *(const bf16x8*)(bp + (size_t)(16 * n) * DM + 32 * s);
#pragma unroll
                for (int m = 0; m < 2; ++m)
#pragma unroll
                    for (int n = 0; n < 4; ++n) acc[m][n] = mfma16(af[m], bfr[n], acc[m][n]); }
#pragma unroll
            for (int m = 0; m < 2; ++m)
#pragma unroll
                for (int n = 0; n < 4; ++n) red[(wave * 8 + m * 4 + n) * 64 + lane] = acc[m][n];
            __syncthreads();
            if (wave < 4) {
                const int m = wave >> 1, np = wave & 1, ta = m * 4 + 2 * np, tb2 = ta + 1;
                f32x4 x1 = red[(0 * 8 + ta) * 64 + lane], x2 = red[(0 * 8 + tb2) * 64 + lane];
#pragma unroll
                for (int w = 1; w < 8; ++w) { x1 += red[(w * 8 + ta) * 64 + lane]; x2 += red[(w * 8 + tb2) * 64 + lane]; }
                const float* t3c = (const float*)(ws + WS_T2) + 2 * 64 * 32; const float* t3s = t3c + 64 * 16;
#pragma unroll
                for (int r = 0; r < 4; ++r) { const int row = 32 * t + 16 * m + 4 * fq + r; float a = x1[r], b = x2[r];
                    if (row >= RC) { const int tt = (row - RC) & (TL - 1), posv = np ? (tt & 63) : (tt >> 6); const float cs = t3c[posv * 16 + fr], sn = t3s[posv * 16 + fr];
                        const float o1 = a * cs - b * sn, o2 = b * cs + a * sn; a = o1; b = o2; }
                    kr[(size_t)row * 64 + 32 * np + fr] = f2bf(a); kr[(size_t)row * 64 + 32 * np + 16 + fr] = f2bf(b); } }
            __syncthreads();
        }
    }
    const int gt = wg * NTHR + tid, NGT = G * NTHR;
    const bool wfix = (NGT & 127) == 0;
    float w0[8], w1[8], w2[8];
    if (wfix) { const int c0 = (gt & 127) * 8; ld8f(convw + c0, w0); ld8f(convw + 1024 + c0, w1); ld8f(convw + 2048 + c0, w2); }
    for (int idx0 = gt; idx0 < RALL * 128; idx0 += 3 * NGT) {
        v4u wb[3], wc[3][3], wx[3][3];
#pragma unroll
        for (int b = 0; b < 3; ++b) { const int idx = idx0 + b * NGT; if (idx < RALL * 128) {
            const int r = idx >> 7, c0 = (idx & 127) * 8;
            int t, T; if (r < RC) { t = r & (TC - 1); T = TC; } else { t = (r - RC) & (TL - 1); T = TL; }
            const bf16* pr = prj + (size_t)r * OD_INP;
            wb[b] = *(const v4u*)(pr + O_BG + c0); wc[b][1] = *(const v4u*)(pr + O_CG + c0); wx[b][1] = *(const v4u*)(pr + O_XV + c0);
            if (t > 0) { wc[b][0] = *(const v4u*)(pr - OD_INP + O_CG + c0); wx[b][0] = *(const v4u*)(pr - OD_INP + O_XV + c0); } else { wc[b][0] = (v4u){0u, 0u, 0u, 0u}; wx[b][0] = wc[b][0]; }
            if (t < T - 1) { wc[b][2] = *(const v4u*)(pr + OD_INP + O_CG + c0); wx[b][2] = *(const v4u*)(pr + OD_INP + O_XV + c0); } else { wc[b][2] = (v4u){0u, 0u, 0u, 0u}; wx[b][2] = wc[b][2]; } } }
#pragma unroll
        for (int b = 0; b < 3; ++b) { const int idx = idx0 + b * NGT; if (idx < RALL * 128) {
            const int r = idx >> 7, c0 = (idx & 127) * 8;
            float bg[8], u0[8], u1[8], u2[8], a[8], b2[8], y[8];
            unpack8(wb[b], bg);
            unpack8(wc[b][0], a); unpack8(wx[b][0], b2);
#pragma unroll
            for (int e = 0; e < 8; ++e) u0[e] = a[e] * b2[e];
            unpack8(wc[b][1], a); unpack8(wx[b][1], b2);
#pragma unroll
            for (int e = 0; e < 8; ++e) u1[e] = a[e] * b2[e];
            unpack8(wc[b][2], a); unpack8(wx[b][2], b2);
#pragma unroll
            for (int e = 0; e < 8; ++e) u2[e] = a[e] * b2[e];
            if (!wfix) { ld8f(convw + c0, w0); ld8f(convw + 1024 + c0, w1); ld8f(convw + 2048 + c0, w2); }
#pragma unroll
            for (int e = 0; e < 8; ++e) y[e] = bg[e] * (u0[e] * w0[e] + u1[e] * w1[e] + u2[e] * w2[e]);
            *(v4u*)(mix + (size_t)r * DM + c0) = pack8(y); } }
    }
    bf16* cqn = (bf16*)(ws + WS_CQN); bf16* ckvn = (bf16*)(ws + WS_CKVN);
    const int gw = wg * NWAVES + wave, NGW = G * NWAVES;
    float qw8[8]; ld8f(qnw + 8 * lane, qw8); const f32x4 kw4 = *(const f32x4*)(kvnw + 4 * lane);
    for (int r0 = gw; r0 < RALL; r0 += 5 * NGW) {
        v4u wq[5]; v2u wk[5];
#pragma unroll
        for (int b = 0; b < 5; ++b) { const int r = r0 + b * NGW; if (r < RALL) { const bf16* pr = prj + (size_t)r * OD_INP; wq[b] = *(const v4u*)(pr + O_CQ + 8 * lane); wk[b] = *(const v2u*)(pr + O_CKV + 4 * lane); } }
#pragma unroll
        for (int b = 0; b < 5; ++b) { const int r = r0 + b * NGW; if (r < RALL) {
            float q[8]; unpack8(wq[b], q);
            float ss = 0.f;
#pragma unroll
            for (int e = 0; e < 8; ++e) ss += q[e] * q[e];
            ss = wave_sum(ss);
            const float rs = 1.f / sqrtf(ss * (1.f / 512.f) + EPS);
#pragma unroll
            for (int e = 0; e < 8; ++e) q[e] = q[e] * rs * qw8[e];
            *(v4u*)(cqn + (size_t)r * 512 + 8 * lane) = pack8(q);
            const v2u kw = wk[b];
            const float k0 = bflo(kw.x), k1 = bfhi(kw.x), k2 = bflo(kw.y), k3 = bfhi(kw.y);
            float s2 = wave_sum(k0 * k0 + k1 * k1 + k2 * k2 + k3 * k3);
            const float rs2 = 1.f / sqrtf(s2 * (1.f / 256.f) + EPS);
            v2u o; o.x = pk2(k0 * rs2 * kw4.x, k1 * rs2 * kw4.y); o.y = pk2(k2 * rs2 * kw4.z, k3 * rs2 * kw4.w);
            *(v2u*)(ckvn + (size_t)r * 256 + 4 * lane) = o; } }
    }
}
__device__ __forceinline__ void rope64_item(bf16* blk, int t, int half, int p, const float* t3c, const float* t3s) {
    const int posv = half ? (t & 63) : (t >> 6); bf16* bp = blk + half * 32 + 8 * p; const int tb = posv * 16 + 8 * p;
    const v4u w1 = *(const v4u*)bp, w2 = *(const v4u*)(bp + 16);
    float x1[8], x2[8], cs[8], sn[8], o1[8], o2[8];
    unpack8(w1, x1); unpack8(w2, x2); ld8f(t3c + tb, cs); ld8f(t3s + tb, sn);
#pragma unroll
    for (int e = 0; e < 8; ++e) { o1[e] = x1[e] * cs[e] - x2[e] * sn[e]; o2[e] = x2[e] * cs[e] + x1[e] * sn[e]; }
    *(v4u*)bp = pack8(o1); *(v4u*)(bp + 16) = pack8(o2);
}
__device__ __forceinline__ void ph_rope_kr(unsigned char* ws, int tid, int wg, int G) {
    bf16* krb = (bf16*)(ws + WS_KR); const float* t3c = (const float*)(ws + WS_T2) + 2 * 64 * 32; const float* t3s = t3c + 64 * 16;
    for (int idx = wg * NTHR + tid; idx < NB * TL * 4; idx += G * NTHR) { const int p = idx & 1, half = (idx >> 1) & 1, rl = idx >> 2;
        rope64_item(krb + (size_t)(RC + rl) * 64, rl & (TL - 1), half, p, t3c, t3s); }
}
__device__ __forceinline__ void post_q_tile(unsigned char* ws, int pm, int pn, int tid) {
    if (pm < 2) return;
    bf16* qraw = (bf16*)(ws + WS_QRAW); const float* t3c = (const float*)(ws + WS_T2) + 2 * 64 * 32; const float* t3s = t3c + 64 * 16;
    for (int h = 0; h < 8; ++h) { const int c0 = 192 * h + 128; if (c0 < 256 * pn || c0 >= 256 * pn + 256) continue;
        for (int idx = tid; idx < 1024; idx += NTHR) { const int p = idx & 1, half = (idx >> 1) & 1, i = idx >> 2; const int r = pm * 256 + i;
            rope64_item(qraw + (size_t)r * 1536 + c0, (r - RC) & (TL - 1), half, p, t3c, t3s); } }
}
__device__ __forceinline__ void post_v_tile(unsigned char* ws, LAS unsigned char* lds, int b, int hh, int kt0, int wave, int lane) {
    const bf16* kvraw = (const bf16*)(ws + WS_KVRAW); bf16* vtm = (bf16*)(ws + WS_VTM); LAS unsigned char* scr = lds + wave * 16384;
    const int kt = kt0 + (wave >> 1), dvh = wave & 1, row0 = key_row(b, 64 * kt);
    vt_tile(kvraw + (size_t)row0 * 2048 + hh * 256 + 128 + dvh * 64, 2048, vtm + ((size_t)(b * 8 + hh) * 128 + dvh * 64) * NKEY + 64 * kt, scr, lane);
}
__device__ __forceinline__ void ph_mix_odd(unsigned char* ws, LAS unsigned char* lds, int nunits, int tid, int wave, int lane, int wg, int G) {
    const bf16* krb = (const bf16*)(ws + WS_KR); bf16* mix = (bf16*)(ws + WS_MIX); const bf16* vtm = (const bf16*)(ws + WS_VTM);
    const bf16* qraw = (const bf16*)(ws + WS_QRAW); const bf16* kvraw = (const bf16*)(ws + WS_KVRAW);
    const float scl = 0.072168783648703220f * LOG2E;
    for (int u = wg; u < nunits; u += G) {
        const bool cx = u >= 256;
        const int pair = cx ? (u - 256) : ((u & 7) * 2 + (u >> 7)), qb = (u >> 3) & 15, b = pair >> 3, hh = pair & 7;
        const int q0 = cx ? 0 : qb * 256, qrow = cx ? b * TC : RC + b * TL + q0;
        attn_unit<192, false, false>(lds, tid, wave, lane, qraw + (size_t)qrow * 1536 + hh * 192, 1536,
            kvraw + (size_t)(b * TC) * 2048 + hh * 256, kvraw + (size_t)(RC + b * TL) * 2048 + hh * 256, 2048,
            krb + (size_t)(b * TC) * 64, krb + (size_t)(RC + b * TL) * 64, 64,
            vtm + (size_t)(b * 8 + hh) * 128 * NKEY, 4, 0, cx ? 0 : 64, q0, scl, 0.f, mix + (size_t)qrow * DM + 1024 + hh * 128, DM);
    }
}

#define NOINL static __device__ __forceinline__
typedef const GAS float* gcf;
typedef GAS unsigned char* gws;
typedef const GAS unsigned short* gcb;
__device__ __forceinline__ int mk_lane() { int l; asm volatile("v_mbcnt_lo_u32_b32 %0, -1, 0\n\tv_mbcnt_hi_u32_b32 %0, -1, %0" : "=v"(l)); return l; }
#define PH_IDS int wv_ = wave_in; asm volatile("" : "+s"(wv_)); const int wave = wv_, lane = mk_lane(), tid = wave * 64 + lane, G = gridDim.x, wg = blockIdx.x; (void)lane; (void)wave; (void)G; (void)wg; (void)tid
#define PH_GW const int gw = wg * NWAVES + wave, NGW = G * NWAVES

__device__ __forceinline__ int uni(int v) { return __builtin_amdgcn_readfirstlane(v); }
template <class T> __device__ __forceinline__ GAS T* uni(GAS T* p) { const unsigned long long v = (unsigned long long)p; const unsigned lo = (unsigned)__builtin_amdgcn_readfirstlane((int)(unsigned)v), hi = (unsigned)__builtin_amdgcn_readfirstlane((int)(unsigned)(v >> 32));
    return (GAS T*)(((unsigned long long)hi << 32) | lo); }
template <class T> __device__ __forceinline__ LAS T* uni(LAS T* p) { return (LAS T*)(unsigned)__builtin_amdgcn_readfirstlane((int)(unsigned)(unsigned long long)p); }
#define U(x) x = uni(x)
#define OPQ(x) asm volatile("" : "+s"(x))

NOINL void f_prologue(int wave_in, gws ws, LAS unsigned char* lds, gcf x, gcf c, gcf ctx, gcf c_ctx, gcf w_mod, gcf b_mod, gcf mlp_w1, gcf mlp_w2, gcf ev_w_in, gcf ev_w_out, gcf od_w_in, gcf od_w_out, gcf od_w_uq, gcf od_w_ukv) {
    PH_IDS; U(ws); U(lds); U(x); U(c); U(ctx); U(c_ctx); U(w_mod); U(b_mod); U(mlp_w1); U(mlp_w2); U(ev_w_in); U(ev_w_out); U(od_w_in); U(od_w_out); U(od_w_uq); U(od_w_ukv);
    ProIn p{(const float*)x, (const float*)c, (const float*)ctx, (const float*)c_ctx, (const float*)w_mod, (const float*)b_mod, (const float*)mlp_w1, (const float*)mlp_w2, (const float*)ev_w_in, (const float*)ev_w_out,
            (const float*)od_w_in, (const float*)od_w_out, (const float*)od_w_uq, (const float*)od_w_ukv};
    ph_prologue(p, (unsigned char*)ws, lds, tid, wave, lane, wg, G);
}
NOINL void f_norm(int wave_in, gws ws, LAS unsigned char* lds, gcf nw, gcf ctx32, gcf x32, int layer, int ch_sh, int ch_sc, int mode) {
    PH_IDS; PH_GW; U(ws); U(lds); U(nw); U(ctx32); U(x32); U(layer); U(ch_sh); U(ch_sc); U(mode);
    const float* mod_l = (const float*)(ws + WS_MOD) + (size_t)layer * 3 * 12288;
    bf16* Hb = (bf16*)(ws + WS_H);
    if (mode == 1) ph_norm_ctx<S_MLP>(nullptr, Hb, (const float*)nw, mod_l, ch_sh, ch_sc, (bf16*)(ws + WS_A1), (const bf16*)(ws + WS_PARTM), mod_l - 3 * 12288 + (2 * 6 + 5) * DM, lds, tid, wave, lane, wg, G);
    if (mode == 2) ph_norm_ctx<S_OUT>(layer == 0 ? (const float*)ctx32 : nullptr, Hb, (const float*)nw, mod_l, ch_sh, ch_sc, (bf16*)(ws + WS_A1), (const bf16*)(ws + WS_PARTO), mod_l + (2 * 6 + 2) * DM, lds, tid, wave, lane, wg, G);
    __syncthreads();
    ph_norm(mode == 0, (const float*)ctx32, (const float*)x32, Hb, (const float*)nw, mod_l, ch_sh, ch_sc, (bf16*)(ws + WS_A1), mode == 0 ? 0 : RC, lds, tid, gw, NGW, lane);
}
NOINL void f_final(int wave_in, gws ws, gcf nw, GAS float* out) { PH_IDS; PH_GW; U(ws); U(nw); U(out); ph_final((const bf16*)(ws + WS_H), (const float*)nw, (float*)out, gw, NGW, lane); }
NOINL void f_post_win(int wave_in, gws ws, LAS unsigned char* lds) { PH_IDS; U(ws); U(lds); VM_WAIT(); __syncthreads();
    pg8::StaticOrder S; S.init(RALL, EV_IN, G, wg, DM); pg8::Unit u;
    for (int i = 0; S.next(i, u); ++i) { post_win_tile((unsigned char*)ws, lds, u.pm, u.pn, tid, wave, lane); } }
NOINL void f_ret_kv(int wave_in, gws ws, LAS unsigned char* lds, gcf dec) { PH_IDS; U(ws); U(lds); U(dec); for (int u = wg; u < 16 * NCH; u += G) ret_kv_unit((unsigned char*)ws, (const float*)dec, lds, tid, wave, lane, u); }
NOINL void f_ret_scan(int wave_in, gws ws, gcf dec) { PH_IDS; U(ws); U(dec); ph_ret_scan((unsigned char*)ws, (const float*)dec, tid, wg, G); }
NOINL void f_win(int wave_in, gws ws, LAS unsigned char* lds, gcf sink) { PH_IDS; U(ws); U(lds); U(sink); ph_win((unsigned char*)ws, (const float*)sink, lds, tid, wave, lane, wg, G); }
NOINL void f_ret_out(int wave_in, gws ws, LAS unsigned char* lds, gcf dec, gcf gnw) { PH_IDS; U(ws); U(lds); U(dec); U(gnw); ph_ret_out((unsigned char*)ws, (const float*)dec, (const float*)gnw, lds, tid, wave, lane, wg, G); }
NOINL void f_prep_odd(int wave_in, gws ws, LAS unsigned char* lds, gcf convw, gcf qnw, gcf kvnw, int jl) { PH_IDS; U(ws); U(lds); U(convw); U(qnw); U(kvnw); U(jl); ph_prep_odd((unsigned char*)ws, lds, (const float*)convw, (const float*)qnw, (const float*)kvnw, jl, tid, wave, lane, wg, G); }
NOINL void f_rope_kr(int wave_in, gws ws) { PH_IDS; U(ws); ph_rope_kr((unsigned char*)ws, tid, wg, G); }
NOINL void f_post_q(int wave_in, gws ws) { PH_IDS; U(ws); VM_WAIT(); __syncthreads();
    pg8::StaticOrder S; S.init(RALL, 1536, G, wg, 512); pg8::Unit u; for (int i = 0; S.next(i, u); ++i) post_q_tile((unsigned char*)ws, u.pm, u.pn, tid); }
NOINL void f_post_v(int wave_in, gws ws, LAS unsigned char* lds) { PH_IDS; U(ws); U(lds); VM_WAIT(); __syncthreads();
    pg8::Unit u;
    { pg8::StaticOrder S; S.init(RC, 2048, G, ((wg - 204) % G + G) % G, 256); for (int i = 0; S.next(i, u); ++i) post_v_tile((unsigned char*)ws, lds, u.pm, u.pn, 0, wave, lane); }
    { pg8::StaticOrder S; S.init(RALL - RC, 2048, G, wg, 256); for (int i = 0; S.next(i, u); ++i) post_v_tile((unsigned char*)ws, lds, u.pm >> 4, u.pn, 4 + (u.pm & 15) * 4, wave, lane); }
}
NOINL void f_mla(int wave_in, gws ws, LAS unsigned char* lds, int nunits) { PH_IDS; U(ws); U(lds); U(nunits); ph_mix_odd((unsigned char*)ws, lds, nunits, tid, wave, lane, wg, G); }
template <int ACT> NOINL void f_gemm_act(int wave_in, LAS unsigned char* lds, gcb A, gcb Bt, GAS unsigned short* O, int M, int N, int K, int ldc, int wg_shift = 0) {
    PH_IDS; U(lds); U(A); U(Bt); U(O); U(M); U(N); U(K); U(ldc); U(wg_shift); OPQ(M); OPQ(N); OPQ(K); OPQ(ldc);
    pg8::Gemm g{(const pg8::bf16_t*)A, (const pg8::bf16_t*)Bt, M, N, K}; pg8::StaticOrder S; S.init(M, N, G, ((wg - wg_shift) % G + G) % G, K);
    pg8::EpiAct<ACT> E{(pg8::bf16_t*)O, ldc};
    pg8::gemm_phase<pg8::EpiAct<ACT>, pg8::StaticOrder, PG8_ALIGN, PG8_SP2>((PG8_LAS unsigned char*)lds, g, S, E, wave);
}
NOINL void f_gemm_res(int wave_in, LAS unsigned char* lds, gcb A, gcb Bt, GAS unsigned short* Hp, gcf x32, gcf gate0, GAS unsigned short* part, int M, int N, int K, int S) {
    PH_IDS; U(lds); U(A); U(Bt); U(Hp); U(x32); U(gate0); U(part); U(M); U(N); U(K); U(S); OPQ(M); OPQ(N); OPQ(K); OPQ(S);
    pg8::Gemm g{(const pg8::bf16_t*)A, (const pg8::bf16_t*)Bt, M, N, K}; pg8::ResOrder S_; S_.init(M, N, K, S, G, wg);
    pg8::EpiResGate E{(pg8::bf16_t*)Hp, N, (const float*)gate0, 6 * DM, (pg8::bf16_t*)part, (const float*)x32};
    pg8::gemm_phase<pg8::EpiResGate, pg8::ResOrder, PG8_ALIGN, PG8_SP2>((PG8_LAS unsigned char*)lds, g, S_, E, wave);
}

constexpr int PH_END = 50;
#ifndef MK_PER_PHASE
#define MK_PER_PHASE 0
#endif
__global__ void __launch_bounds__(NTHR, 2) mk_fwd(Args a) {
    extern __shared__ __attribute__((aligned(16))) unsigned char lds_raw[];
    LAS unsigned char* lds = (LAS unsigned char*)lds_raw;
    const int tid = threadIdx.x;
    const int wv = __builtin_amdgcn_readfirstlane(tid >> 6);
    gws ws = (gws)a.ws;
    volatile LAS unsigned* MISC = (volatile LAS unsigned*)(lds + MISC_OFF);
    for (int u = tid; u < (LDS_BYTES - MISC_OFF) / 4; u += NTHR) ((LAS unsigned*)(lds + MISC_OFF))[u] = 0u;
    __syncthreads();
    const int lo = a.ph_lo, hi = a.ph_hi;
    XcdBarrier bar; bar.bar = (unsigned*)(a.ws + WS_CTL) + CW_BAR; bar.x = 0; bar.st = MISC + 8;
    if (hi - lo > 1) bar = xcd_barrier_post((unsigned*)(a.ws + WS_CTL) + CW_BAR, MISC + 8);
#define IN(k) (lo <= (k) && (k) < hi)
#define SEAM(k) do { if ((k) + 1 < hi) xcd_barrier(bar); } while (0)

    if (IN(0)) { f_prologue(wv, ws, lds, (gcf)a.x, (gcf)a.c, (gcf)a.ctx, (gcf)a.c_ctx, (gcf)a.w_mod, (gcf)a.b_mod, (gcf)a.mlp_w1, (gcf)a.mlp_w2, (gcf)a.ev_w_in, (gcf)a.ev_w_out, (gcf)a.od_w_in, (gcf)a.od_w_out, (gcf)a.od_w_uq, (gcf)a.od_w_ukv);


        SEAM(0); }

#pragma nounroll
    for (int l = 0; l < DEPTH; ++l) {
        const int j = l >> 1, pb = 1 + 12 * l;
        const int row_off = (l == DEPTH - 1) ? RC : 0, Mr = RALL - row_off;
        if (IN(pb + 0)) { f_norm(wv, ws, lds, (gcf)(a.norm1_w + l * DM), (gcf)a.ctx, (gcf)a.x, l, 0, 1, l == 0 ? 0 : 1); SEAM(pb + 0); }
        if (!(l & 1)) {
            if (IN(pb + 1)) { f_gemm_act<0>(wv, lds, (gcb)(ws + WS_A1), (gcb)(ws + WS_EWIN) + (size_t)j * EV_IN * DM, (GAS unsigned short*)(ws + WS_PRJ), RALL, EV_IN, DM, EV_IN);
                f_post_win(wv, ws, lds);
                SEAM(pb + 1); }
            if (IN(pb + 2)) { f_ret_kv(wv, ws, lds, (gcf)(a.ev_decay + j * 16)); SEAM(pb + 2); }
            if (IN(pb + 4)) { f_ret_scan(wv, ws, (gcf)(a.ev_decay + j * 16)); SEAM(pb + 4); }
            if (IN(pb + 5)) { f_win(wv, ws, lds, (gcf)(a.ev_sink + j * 8)); __syncthreads(); f_ret_out(wv, ws, lds, (gcf)(a.ev_decay + j * 16), (gcf)(a.ev_gn_w + j * 1024));


                SEAM(pb + 5); }
        } else {
            if (IN(pb + 1)) { f_gemm_act<0>(wv, lds, (gcb)(ws + WS_A1), (gcb)(ws + WS_OWIN) + (size_t)j * OD_INP * DM, (GAS unsigned short*)(ws + WS_PRJ), RALL, OD_INP, DM, OD_INP);
                SEAM(pb + 1); }
            if (IN(pb + 2)) { f_prep_odd(wv, ws, lds, (gcf)(a.od_conv_w + j * 3 * 1024), (gcf)(a.od_qn_w + j * 512), (gcf)(a.od_kvn_w + j * 256), j); SEAM(pb + 2); }
            if (IN(pb + 3)) {
                f_gemm_act<0>(wv, lds, (gcb)(ws + WS_CQN), (gcb)(ws + WS_UQT) + (size_t)j * 1536 * 512, (GAS unsigned short*)(ws + WS_QRAW), RALL, 1536, 512, 1536);
                f_post_q(wv, ws);
                __syncthreads();
                f_gemm_act<0>(wv, lds, (gcb)(ws + WS_CKVN), (gcb)(ws + WS_UKVT) + (size_t)j * 2048 * 256, (GAS unsigned short*)(ws + WS_KVRAW), RC, 2048, 256, 2048, 204);
                __syncthreads();
                f_gemm_act<0>(wv, lds, (gcb)(ws + WS_CKVN) + (size_t)RC * 256, (gcb)(ws + WS_UKVT) + (size_t)j * 2048 * 256, (GAS unsigned short*)(ws + WS_KVRAW) + (size_t)RC * 2048, RALL - RC, 2048, 256, 2048);
                f_post_v(wv, ws, lds);
                SEAM(pb + 3); }
            if (IN(pb + 6)) { f_mla(wv, ws, lds, row_off ? 256 : 272); SEAM(pb + 6); }
        }
        if (IN(pb + 7)) { gcb wo = (l & 1) ? (gcb)(ws + WS_OWOUT) + (size_t)j * DM * DM : (gcb)(ws + WS_EWOUT) + (size_t)j * DM * DM;
            f_gemm_res(wv, lds, (gcb)(ws + WS_MIX), wo, (GAS unsigned short*)(ws + WS_H), l == 0 ? (gcf)a.x : (gcf)nullptr, (gcf)(ws + WS_MOD) + (size_t)l * 3 * 12288 + 2 * DM, (GAS unsigned short*)(ws + WS_PARTO), RALL, DM, DM, row_off ? 0 : S_OUT);
            SEAM(pb + 7); }
        if (IN(pb + 8)) { f_norm(wv, ws, lds, (gcf)(a.norm2_w + l * DM), (gcf)a.ctx, (gcf)a.x, l, 3, 4, row_off ? 3 : 2); SEAM(pb + 8); }
        if (IN(pb + 9)) { f_gemm_act<1>(wv, lds, (gcb)(ws + WS_A1) + (size_t)row_off * DM, (gcb)(ws + WS_W1T) + (size_t)l * DFF * DM, (GAS unsigned short*)(ws + WS_HID) + (size_t)row_off * DFF, Mr, DFF, DM, DFF);

            SEAM(pb + 9); }
        if (IN(pb + 10)) { f_gemm_res(wv, lds, (gcb)(ws + WS_HID), (gcb)(ws + WS_W2T) + (size_t)l * DM * DFF, (GAS unsigned short*)(ws + WS_H), (gcf)nullptr, (gcf)(ws + WS_MOD) + (size_t)l * 3 * 12288 + 5 * DM, (GAS unsigned short*)(ws + WS_PARTM), RALL, DM, DFF, row_off ? 0 : S_MLP);
            SEAM(pb + 10); }
    }
    if (IN(49)) f_final(wv, ws, (gcf)a.norm_f, (GAS float*)a.out);
#undef IN
#undef SEAM
}

extern "C" void kernel_launch(void* const* d_in, const int* in_sizes, int n_in, void* d_out, int out_size, void* d_ws, size_t ws_size, hipStream_t stream) {
    static int grid = 0;
    if (grid == 0) {
        if (n_in != 23 || out_size != NB * TL * DM || ws_size < WS_END) { fprintf(stderr, "kernel_launch: unexpected shapes (n_in %d, out %d, ws %zu); nothing launched\n", n_in, out_size, ws_size); grid = -1; return; }
        int dev = 0, cus = 0, per_cu = 0;
        if (hipGetDevice(&dev) != hipSuccess || hipDeviceGetAttribute(&cus, hipDeviceAttributeMultiprocessorCount, dev) != hipSuccess) { grid = -1; return; }
        if (hipFuncSetAttribute((const void*)mk_fwd, hipFuncAttributeMaxDynamicSharedMemorySize, LDS_BYTES) != hipSuccess) { fprintf(stderr, "kernel_launch: hipFuncSetAttribute failed\n"); grid = -1; return; }
        if (hipOccupancyMaxActiveBlocksPerMultiprocessor(&per_cu, (const void*)mk_fwd, NTHR, LDS_BYTES) != hipSuccess || per_cu < 1) { fprintf(stderr, "kernel_launch: occupancy query reports %d blocks per CU; nothing launched\n", per_cu); grid = -1; (void)hipGetLastError(); return; }
        grid = cus;
    }
    if (grid < 0) return;
    if (hipMemsetAsync((char*)d_ws + WS_CTL, 0, CTL_ZERO_BYTES, stream) != hipSuccess) return;
    Args a{};
    const float** ap = (const float**)&a;
    for (int i = 0; i < 23; ++i) ap[i] = (const float*)d_in[i];
    a.out = (float*)d_out; a.ws = (unsigned char*)d_ws;
#if MK_PER_PHASE
    for (int p = 0; p < PH_END; ++p) { a.ph_lo = p; a.ph_hi = p + 1; hipLaunchKernelGGL(mk_fwd, dim3(grid), dim3(NTHR), LDS_BYTES, stream, a); }
#else
    a.ph_lo = 0; a.ph_hi = PH_END;
    hipLaunchKernelGGL(mk_fwd, dim3(grid), dim3(NTHR), LDS_BYTES, stream, a);
#endif
    const hipError_t le = hipPeekAtLastError();
    if (le != hipSuccess) fprintf(stderr, "kernel_launch: launch failed: %s\n", hipGetErrorName(le));
}
```

```cpp
#include <hip/hip_runtime.h>
#include <cstdio>
#include <cstdint>
#define MK_PER_PHASE 0
namespace pg8 {
#define PG8_LAS __attribute__((address_space(3)))
typedef unsigned short bf16_t;
typedef short bf16x8 __attribute__((ext_vector_type(8)));
typedef float f32x4 __attribute__((ext_vector_type(4)));
typedef unsigned u32x4 __attribute__((ext_vector_type(4)));
constexpr int BM = 256, BK = 64, HALF = 128, HTB = HALF * BK * 2  , STAGE_BYTES = 8 * HTB, NXCD = 8, WGM = 4;

__host__ __device__ __forceinline__ int lds_byte(int r, int c) { const int st = (r >> 4) * 2 + (c >> 5), rr = r & 15, cc = c & 31, ob = rr * 64 + cc * 2; return st * 1024 + (ob ^ (((ob >> 9) & 1) << 5)); }
__host__ __device__ __forceinline__ void stage_rc(int b, int& R, int& C) { const int st = b / 1024, sb = b % 1024, swz = sb ^ (((sb >> 9) & 1) << 5); R = (st >> 1) * 16 + swz / 64; C = (st & 1) * 32 + (swz % 64) / 2; }
__host__ __device__ __forceinline__ int perm32(int rho) { const int n = rho >> 4, i = rho & 15; return 8 * (i >> 2) + 4 * n + (i & 3); }

struct Unit { int pm, pn, ks, nt, koff; };
struct Gemm { const bf16_t* A; const bf16_t* Bt; int M, N, K; };

struct StaticOrder {
    int nM, nN, nwg, G, c, ntK;
    __host__ __device__ void init(int M, int N, int G_, int c_, int K_) { nM = M / BM; nN = N / BM; nwg = nM * nN; G = G_; c = c_; ntK = K_ / BK; }
    __host__ __device__ bool next(int i, Unit& u) const {
        const long L = (long)i * G + c; if (L >= nwg) return false;
        int wgid = (int)L; { const int q = nwg / NXCD, r = nwg % NXCD, xcd = wgid % NXCD, off = wgid / NXCD; wgid = (xcd < r ? xcd * (q + 1) : r * (q + 1) + (xcd - r) * q) + off; }
        const int nig = WGM * nN, gid = wgid / nig, fm = gid * WGM, gsz = (nM - fm) < WGM ? (nM - fm) : WGM;
        u.pm = fm + ((wgid % nig) % gsz); u.pn = (wgid % nig) / gsz; u.ks = -1; u.nt = ntK; u.koff = 0; return true;
    }
    __device__ __forceinline__ void a_ready(const Unit&) const {}
    __device__ __forceinline__ void done(const Unit&) const {}
};

__device__ __forceinline__ unsigned cvt_pk_bf16(float lo, float hi) { unsigned r; asm volatile("v_cvt_pk_bf16_f32 %0, %1, %2" : "=v"(r) : "v"(lo), "v"(hi)); return r; }
typedef float f32x2 __attribute__((ext_vector_type(2)));
__device__ __forceinline__ f32x2 gelu_pk(f32x2 v) {
    const f32x2 av = __builtin_elementwise_abs(v), d = av * 0.2316418882f + 1.0f;
    f32x2 t; t.x = __builtin_amdgcn_rcpf(d.x); t.y = __builtin_amdgcn_rcpf(d.y);
    f32x2 q = t * 0.5307027145f + (-0.7265760135f); q = q * t + 0.7107068705f; q = q * t + (-0.142248368f); q = q * t + 0.127414796f; q = q * t;
    const f32x2 s = (v * v) * (-0.72134752044f);
    f32x2 e; e.x = __builtin_amdgcn_exp2f(s.x); e.y = __builtin_amdgcn_exp2f(s.y);
    const f32x2 m = v * (q * e), r = v - m;
    f32x2 o; o.x = v.x < 0.f ? m.x : r.x; o.y = v.y < 0.f ? m.y : r.y; return o;
}


template <int ACT> struct EpiAct {
    static constexpr bool PERM = true, AFTER_DRAIN = false;
    bf16_t* O; int ldc;
    __device__ __forceinline__ void operator()(const f32x4 (&acc)[2][2][4][2], const Unit& u, int wr, int wc, int fr, int fq) const {
        const int row0 = u.pm * BM + wr * 64 + fr, col0 = u.pn * BM + wc * 32 + 8 * fq;
#pragma unroll
        for (int ai = 0; ai < 2; ++ai)
#pragma unroll
            for (int m = 0; m < 4; ++m) { bf16_t* rowp = O + (size_t)(row0 + ai * HALF + m * 16) * ldc + col0;
#pragma unroll
                for (int bj = 0; bj < 2; ++bj) { f32x4 v0 = acc[ai][bj][m][0], v1 = acc[ai][bj][m][1];
                    if (ACT == 1) {
#pragma unroll
                        for (int e = 0; e < 4; ++e) { const float a = fmaxf(v0[e], 0.f), b = fmaxf(v1[e], 0.f); v0[e] = a * a; v1[e] = b * b; } }
                    u32x4 w; w.x = cvt_pk_bf16(v0[0], v0[1]); w.y = cvt_pk_bf16(v0[2], v0[3]); w.z = cvt_pk_bf16(v1[0], v1[1]); w.w = cvt_pk_bf16(v1[2], v1[3]);
                    *(u32x4*)(rowp + bj * HALF) = w; } }
    }
};
struct EpiResGate {
    static constexpr bool PERM = true, AFTER_DRAIN = false;
    bf16_t* H; int ldc; const float* gate0; int set_stride; bf16_t* part; const float* Hx32;
    __device__ __forceinline__ void operator()(const f32x4 (&acc)[2][2][4][2], const Unit& u, int wr, int wc, int fr, int fq) const {
        const int row0 = u.pm * BM + wr * 64 + fr, col0 = u.pn * BM + wc * 32 + 8 * fq;
        if (u.ks >= 0) {
            bf16_t* P = part + (size_t)u.ks * 512 * ldc;
#pragma unroll
            for (int ai = 0; ai < 2; ++ai)
#pragma unroll
                for (int m = 0; m < 4; ++m) { bf16_t* rowp = P + (size_t)(row0 + ai * HALF + m * 16) * ldc + col0;
#pragma unroll
                    for (int bj = 0; bj < 2; ++bj) { const f32x4 v0 = acc[ai][bj][m][0], v1 = acc[ai][bj][m][1];
                        u32x4 o; o.x = cvt_pk_bf16(v0[0], v0[1]); o.y = cvt_pk_bf16(v0[2], v0[3]); o.z = cvt_pk_bf16(v1[0], v1[1]); o.w = cvt_pk_bf16(v1[2], v1[3]);
                        *(u32x4*)(rowp + bj * HALF) = o; } }
            return; }
        const int grow = u.pm * BM; const int set = grow < 512 ? 2 : ((grow - 512) >> 12);
        const float* g = gate0 + (size_t)set * set_stride + col0;
        f32x4 gv[2][2];
#pragma unroll
        for (int bj = 0; bj < 2; ++bj) { gv[bj][0] = *(const f32x4*)(g + bj * HALF); gv[bj][1] = *(const f32x4*)(g + bj * HALF + 4); }
        if (Hx32) {
#pragma unroll
            for (int ai = 0; ai < 2; ++ai) { f32x4 hx[4][2][2];
#pragma unroll
                for (int m = 0; m < 4; ++m)
#pragma unroll
                    for (int bj = 0; bj < 2; ++bj) { const float* ps = Hx32 + (size_t)(row0 + ai * HALF + m * 16) * ldc + col0 - (size_t)512 * ldc + bj * HALF; hx[m][bj][0] = *(const f32x4*)ps; hx[m][bj][1] = *(const f32x4*)(ps + 4); }
#pragma unroll
                for (int m = 0; m < 4; ++m)
#pragma unroll
                    for (int bj = 0; bj < 2; ++bj) { const f32x4 v0 = hx[m][bj][0] + gv[bj][0] * acc[ai][bj][m][0], v1 = hx[m][bj][1] + gv[bj][1] * acc[ai][bj][m][1];
                        u32x4 o; o.x = cvt_pk_bf16(v0[0], v0[1]); o.y = cvt_pk_bf16(v0[2], v0[3]); o.z = cvt_pk_bf16(v1[0], v1[1]); o.w = cvt_pk_bf16(v1[2], v1[3]);
                        *(u32x4*)(H + (size_t)(row0 + ai * HALF + m * 16) * ldc + col0 + bj * HALF) = o; } }
        } else {
#pragma unroll
            for (int ai = 0; ai < 2; ++ai) { u32x4 hw[4][2];
#pragma unroll
                for (int m = 0; m < 4; ++m)
#pragma unroll
                    for (int bj = 0; bj < 2; ++bj) hw[m][bj] = *(const u32x4*)(H + (size_t)(row0 + ai * HALF + m * 16) * ldc + col0 + bj * HALF);
#pragma unroll
                for (int m = 0; m < 4; ++m)
#pragma unroll
                    for (int bj = 0; bj < 2; ++bj) { const u32x4 w = hw[m][bj];
                        const f32x4 h0 = {__uint_as_float(w.x << 16), __uint_as_float(w.x & 0xffff0000u), __uint_as_float(w.y << 16), __uint_as_float(w.y & 0xffff0000u)};
                        const f32x4 h1 = {__uint_as_float(w.z << 16), __uint_as_float(w.z & 0xffff0000u), __uint_as_float(w.w << 16), __uint_as_float(w.w & 0xffff0000u)};
                        const f32x4 v0 = h0 + gv[bj][0] * acc[ai][bj][m][0], v1 = h1 + gv[bj][1] * acc[ai][bj][m][1];
                        u32x4 o; o.x = cvt_pk_bf16(v0[0], v0[1]); o.y = cvt_pk_bf16(v0[2], v0[3]); o.z = cvt_pk_bf16(v1[0], v1[1]); o.w = cvt_pk_bf16(v1[2], v1[3]);
                        *(u32x4*)(H + (size_t)(row0 + ai * HALF + m * 16) * ldc + col0 + bj * HALF) = o; } }
        }
    }
};

struct ResOrder {
    StaticOrder so; int nmain, nsplit, S, nN, ntc, G, c;
    __host__ __device__ void init(int M, int N, int K, int S_, int G_, int c_) { so.init(M - 512, N, G_, c_, K); nmain = so.nwg; S = S_; nN = N / BM; nsplit = 2 * nN * S_; ntc = S_ ? K / S_ / BK : 0; G = G_; c = c_; }
    __host__ __device__ bool next(int i, Unit& u) const {
        const long L = (long)i * G + c;
        if (L < nmain) { so.next(i, u); u.pm += 2; return true; }
        const int s = (int)(L - nmain); if (s >= nsplit) return false;
        u.ks = s % S; const int rest = s / S; u.pn = rest % nN; u.pm = rest / nN; u.nt = ntc; u.koff = u.ks * ntc * BK; return true;
    }
    __device__ __forceinline__ void a_ready(const Unit&) const {}
    __device__ __forceinline__ void done(const Unit&) const {}
};
template <class Epi, class Sched, bool ALIGN_EPI = false, bool SP2 = false>
__device__ __forceinline__ void gemm_phase(PG8_LAS unsigned char* lds, const Gemm g, const Sched& S, const Epi& E, int wave_in) {
    int lane_; asm volatile("v_mbcnt_lo_u32_b32 %0, -1, 0\n\tv_mbcnt_hi_u32_b32 %0, -1, %0" : "=v"(lane_));
    const int wid = wave_in, tid = wid * 64 + lane_, lane = tid & 63, wr = wid >> 2, wc = wid & 3, fr = lane & 15, fq = lane >> 4;
    const int K = g.K;
    unsigned voffA[2], voffB[2];
#pragma unroll
    for (int i = 0; i < 2; ++i) { int R, C; stage_rc(tid * 16 + i * 8192, R, C); const int Rb = Epi::PERM ? ((R & ~31) + perm32(R & 31)) : R;
        voffA[i] = (unsigned)(R * K + C) * 2u; voffB[i] = (unsigned)(Rb * K + C) * 2u; }
    const size_t kstep = (size_t)(BK * 2);
    const size_t hstep = (size_t)HALF * K * 2;
    const size_t tstep = 2 * hstep;
    const unsigned ldsw = (unsigned)wid * 1024u;
    const int aoff = lds_byte(wr * 64 + fr, fq * 8), boff = lds_byte(wc * 32 + fr, fq * 8);
#define PG8_SA(b, h) (((b) * 2 + (h)) * HTB)
#define PG8_SB(b, h) ((4 + (b) * 2 + (h)) * HTB)
#define PG8_STAGE(bufoff, gbase, voff) do { _Pragma("unroll") for (int _i = 0; _i < 2; ++_i) \
        __builtin_amdgcn_global_load_lds((const unsigned*)((const char*)(gbase) + (voff)[_i]), (PG8_LAS unsigned*)(lds + (bufoff) + ldsw + _i * 8192), 16, 0, 0); } while (0)
#define PG8_LDA(dst, b, h) do { _Pragma("unroll") for (int m = 0; m < 4; ++m) _Pragma("unroll") for (int k = 0; k < 2; ++k) dst[m][k] = *(const PG8_LAS bf16x8*)(lds + PG8_SA(b, h) + aoff + m * 2048 + k * 1024); } while (0)
#define PG8_LDB(dst, b, h) do { _Pragma("unroll") for (int n = 0; n < 2; ++n) _Pragma("unroll") for (int k = 0; k < 2; ++k) dst[n][k] = *(const PG8_LAS bf16x8*)(lds + PG8_SB(b, h) + boff + n * 2048 + k * 1024); } while (0)
#define PG8_MMA(ai, bj, At, Bt) do { __builtin_amdgcn_s_setprio(1); _Pragma("unroll") for (int m = 0; m < 4; ++m) _Pragma("unroll") for (int n = 0; n < 2; ++n) _Pragma("unroll") for (int k = 0; k < 2; ++k) \
        acc[ai][bj][m][n] = __builtin_amdgcn_mfma_f32_16x16x32_bf16(Bt[n][k], At[m][k], acc[ai][bj][m][n], 0, 0, 0); __builtin_amdgcn_s_setprio(0); } while (0)
#define PG8_WAIT_V(n) asm volatile("s_waitcnt vmcnt(" #n ")" ::: "memory")
#define PG8_WAIT_L(n) asm volatile("s_waitcnt lgkmcnt(" #n ")" ::: "memory")
#define PG8_BAR __builtin_amdgcn_s_barrier()
#define PG8_SCHED __builtin_amdgcn_sched_barrier(0)
    Unit cur, nxt; int ui = 0;
    if (!S.next(0, cur)) return;
    f32x4 acc[2][2][4][2];
#pragma unroll
    for (int a = 0; a < 2; ++a)
#pragma unroll
        for (int b = 0; b < 2; ++b)
#pragma unroll
            for (int m = 0; m < 4; ++m)
#pragma unroll
                for (int n = 0; n < 2; ++n) acc[a][b][m][n] = (f32x4){0.f, 0.f, 0.f, 0.f};
    bf16x8 At[4][2], B0[2][2], B1[2][2];
    const char* cA = (const char*)g.A + (size_t)cur.pm * tstep + (size_t)cur.koff * 2; const char* cB = (const char*)g.Bt + (size_t)cur.pn * tstep + (size_t)cur.koff * 2;
    int nt = cur.nt;
    S.a_ready(cur);
    if constexpr (SP2) {
        PG8_STAGE(PG8_SB(0, 0), cB, voffB); PG8_STAGE(PG8_SB(0, 1), cB + hstep, voffB); PG8_STAGE(PG8_SA(0, 0), cA, voffA); PG8_STAGE(PG8_SA(0, 1), cA + hstep, voffA);
        if (wr == 1) PG8_BAR;
        PG8_WAIT_V(2); PG8_BAR;
        PG8_STAGE(PG8_SB(1, 0), cB + kstep, voffB); PG8_STAGE(PG8_SA(1, 0), cA + kstep, voffA); PG8_STAGE(PG8_SB(1, 1), cB + hstep + kstep, voffB);
        PG8_WAIT_V(6); PG8_BAR;
    } else {
        PG8_STAGE(PG8_SB(0, 0), cB, voffB); PG8_STAGE(PG8_SA(0, 0), cA, voffA); PG8_STAGE(PG8_SB(0, 1), cB + hstep, voffB); PG8_STAGE(PG8_SA(0, 1), cA + hstep, voffA);
        if (wr == 1) PG8_BAR;
        PG8_WAIT_V(4); PG8_BAR;
        PG8_STAGE(PG8_SB(1, 0), cB + kstep, voffB); PG8_STAGE(PG8_SA(1, 0), cA + kstep, voffA); PG8_STAGE(PG8_SB(1, 1), cB + hstep + kstep, voffB);
        PG8_WAIT_V(6); PG8_BAR;
    }
    for (;;) {
        const bool has_next = S.next(ui + 1, nxt);
        const char* nA = has_next ? (const char*)g.A + (size_t)nxt.pm * tstep + (size_t)nxt.koff * 2 : cA; const char* nB = has_next ? (const char*)g.Bt + (size_t)nxt.pn * tstep + (size_t)nxt.koff * 2 : cB;
        asm volatile(".p2align 8" ::: "memory");
        for (int t = 0; t < nt; t += 2) {
            const bool last = (t == nt - 2);
            const char* a1 = cA + (size_t)(t + 1) * kstep;
            const char* a2 = last ? nA : cA + (size_t)(t + 2) * kstep; const char* b2 = last ? nB : cB + (size_t)(t + 2) * kstep;
            const char* a3 = a2 + kstep; const char* b3 = b2 + kstep;
            if (last && has_next) S.a_ready(nxt);
            if constexpr (SP2) {
            PG8_LDB(B0, 0, 0); PG8_LDB(B1, 0, 1); PG8_SCHED; PG8_LDA(At, 0, 0); PG8_STAGE(PG8_SA(1, 1), a1 + hstep, voffA);
            PG8_WAIT_V(8); PG8_WAIT_L(0); PG8_BAR; PG8_MMA(0, 0, At, B0); PG8_MMA(0, 1, At, B1); PG8_BAR; PG8_SCHED;
            PG8_LDA(At, 0, 1); PG8_STAGE(PG8_SB(0, 0), b2, voffB); PG8_STAGE(PG8_SB(0, 1), b2 + hstep, voffB); PG8_STAGE(PG8_SA(0, 0), a2, voffA);
            PG8_WAIT_V(8); PG8_WAIT_L(0); PG8_BAR; PG8_MMA(1, 0, At, B0); PG8_MMA(1, 1, At, B1); PG8_BAR; PG8_SCHED;
            PG8_LDB(B0, 1, 0); PG8_LDB(B1, 1, 1); PG8_SCHED; PG8_LDA(At, 1, 0); PG8_STAGE(PG8_SA(0, 1), a2 + hstep, voffA);
            PG8_WAIT_V(8); PG8_WAIT_L(0); PG8_BAR; PG8_MMA(0, 0, At, B0); PG8_MMA(0, 1, At, B1); PG8_BAR; PG8_SCHED;
            PG8_LDA(At, 1, 1); PG8_STAGE(PG8_SB(1, 0), b3, voffB); PG8_STAGE(PG8_SB(1, 1), b3 + hstep, voffB); PG8_STAGE(PG8_SA(1, 0), a3, voffA);
            PG8_WAIT_V(8); PG8_WAIT_L(0); PG8_BAR; PG8_MMA(1, 0, At, B0); PG8_MMA(1, 1, At, B1); PG8_BAR; PG8_SCHED;
            } else {
            PG8_LDB(B0, 0, 0); PG8_SCHED; PG8_LDA(At, 0, 0); PG8_STAGE(PG8_SA(1, 1), a1 + hstep, voffA);
            PG8_WAIT_L(8); PG8_BAR; PG8_WAIT_L(0); PG8_MMA(0, 0, At, B0); PG8_BAR; PG8_SCHED;
            PG8_LDB(B1, 0, 1); PG8_STAGE(PG8_SB(0, 0), b2, voffB);
            PG8_BAR; PG8_WAIT_L(0); PG8_MMA(0, 1, At, B1); PG8_BAR;
            PG8_LDA(At, 0, 1); PG8_STAGE(PG8_SA(0, 0), a2, voffA);
            PG8_BAR; PG8_WAIT_L(0); PG8_MMA(1, 0, At, B0); PG8_BAR; PG8_SCHED;
            PG8_STAGE(PG8_SB(0, 1), b2 + hstep, voffB);
            PG8_WAIT_V(6); PG8_BAR; PG8_MMA(1, 1, At, B1); PG8_BAR;
            PG8_LDB(B0, 1, 0); PG8_SCHED; PG8_LDA(At, 1, 0); PG8_STAGE(PG8_SA(0, 1), a2 + hstep, voffA);
            PG8_WAIT_L(8); PG8_BAR; PG8_WAIT_L(0); PG8_MMA(0, 0, At, B0); PG8_BAR; PG8_SCHED;
            PG8_LDB(B1, 1, 1); PG8_STAGE(PG8_SB(1, 0), b3, voffB);
            PG8_BAR; PG8_WAIT_L(0); PG8_MMA(0, 1, At, B1); PG8_BAR;
            PG8_LDA(At, 1, 1); PG8_STAGE(PG8_SA(1, 0), a3, voffA);
            PG8_BAR; PG8_WAIT_L(0); PG8_MMA(1, 0, At, B0); PG8_BAR; PG8_SCHED;
            PG8_STAGE(PG8_SB(1, 1), b3 + hstep, voffB);
            PG8_WAIT_V(6); PG8_BAR; PG8_MMA(1, 1, At, B1); PG8_BAR;
            }
        }
        if constexpr (ALIGN_EPI) { if (wr == 0) PG8_BAR; }
        if constexpr (!Epi::AFTER_DRAIN) { E(acc, cur, wr, wc, fr, fq); S.done(cur); }
        if (!has_next) break;
#pragma unroll
        for (int a = 0; a < 2; ++a)
#pragma unroll
            for (int b = 0; b < 2; ++b)
#pragma unroll
                for (int m = 0; m < 4; ++m)
#pragma unroll
                    for (int n = 0; n < 2; ++n) acc[a][b][m][n] = (f32x4){0.f, 0.f, 0.f, 0.f};
        cur = nxt; cA = nA; cB = nB; ++ui; nt = cur.nt;
        if constexpr (ALIGN_EPI) { if (wr == 1) PG8_BAR; }
    }
    PG8_WAIT_V(0);
    if constexpr (!ALIGN_EPI) { if (wr == 0) PG8_BAR; }
    PG8_BAR;
    if constexpr (Epi::AFTER_DRAIN) { E.fused(acc, cur, wr, wc, fr, fq, lds, wid, lane); S.done(cur); }
#undef PG8_SA
#undef PG8_SB
#undef PG8_STAGE
#undef PG8_LDA
#undef PG8_LDB
#undef PG8_MMA
#undef PG8_WAIT_V
#undef PG8_WAIT_L
#undef PG8_BAR
#undef PG8_SCHED
}
}

#ifndef PG8_SP2
#define PG8_SP2 true
#endif
#ifndef PG8_ALIGN
#define PG8_ALIGN true
#endif

constexpr int DM = 2048, NB = 2, TL = 4096, TC = 256, DEPTH = 4, DFF = 8192;
constexpr int RC = NB * TC;
constexpr int RALL = RC + NB * TL;
constexpr int NKEY = TC + TL;
constexpr int EV_IN = 5632, OD_IN = 3904, OD_INP = 3840;
constexpr int E_QR = 0, E_KR = 1024, E_VR = 2048, E_GR = 3072, E_QW = 4096, E_KW = 5120, E_VW = 5376;
constexpr int O_BG = 0, O_CG = 1024, O_XV = 2048, O_CQ = 3072, O_CKV = 3584, O_KR = 3840;
constexpr int NCH = 34;
constexpr float EPS = 1e-6f;
constexpr float LOG2E = 1.4426950408889634f;

constexpr size_t MiB = 1u << 20;
constexpr size_t WS_CTL = 0, CTL_ZERO_BYTES = 1 * MiB;
constexpr size_t WS_MOD = 1 * MiB;
constexpr size_t WS_T1C = 2 * MiB, WS_T1S = 3 * MiB;
constexpr size_t WS_T2 = 4 * MiB;
constexpr size_t WS_W1T = 8 * MiB, WS_W2T = 136 * MiB, WS_EWIN = 264 * MiB, WS_EWOUT = 308 * MiB, WS_OWIN = 324 * MiB, WS_OWOUT = 356 * MiB, WS_UQT = 372 * MiB, WS_UKVT = 375 * MiB;
constexpr size_t WS_H = 384 * MiB, WS_A1 = 452 * MiB, WS_PRJ = 486 * MiB, WS_MIX = 580 * MiB, WS_HID = 614 * MiB, WS_KVST = 750 * MiB, WS_ST = 818 * MiB;
constexpr size_t WS_VTW = 852 * MiB, WS_VTM = 857 * MiB, WS_CQN = 874 * MiB, WS_CKVN = 883 * MiB, WS_QRAW = 888 * MiB, WS_KVRAW = 914 * MiB, WS_PARTO = 948 * MiB, WS_PARTM = 980 * MiB, WS_WKRT = 1044 * MiB, WS_KR = 1045 * MiB, WS_END = 1047 * MiB;
constexpr int S_OUT = 4, S_MLP = 8;
constexpr int CW_BAR = 4096;

constexpr int LDS_BYTES = 147456;
constexpr int MISC_OFF = 143360;
constexpr int NWAVES = 8, NTHR = 512;

#define GAS __attribute__((address_space(1)))
#define LAS __attribute__((address_space(3)))
typedef unsigned short bf16;
typedef unsigned v4u __attribute__((ext_vector_type(4)));
typedef unsigned v2u __attribute__((ext_vector_type(2)));
typedef float f32x4 __attribute__((ext_vector_type(4)));
typedef float f32x16 __attribute__((ext_vector_type(16)));
typedef short bf16x8 __attribute__((ext_vector_type(8)));
#define LDS_WAIT() asm volatile("s_waitcnt lgkmcnt(0)" ::: "memory")
#define VM_WAIT() asm volatile("s_waitcnt vmcnt(0)" ::: "memory")

__device__ __forceinline__ unsigned pk2(float lo, float hi) { unsigned r; asm volatile("v_cvt_pk_bf16_f32 %0, %1, %2" : "=v"(r) : "v"(lo), "v"(hi)); return r; }
__device__ __forceinline__ float bflo(unsigned w) { return __uint_as_float(w << 16); }
__device__ __forceinline__ float bfhi(unsigned w) { return __uint_as_float(w & 0xffff0000u); }
__device__ __forceinline__ float bf2f(unsigned short b) { return __uint_as_float(((unsigned)b) << 16); }
__device__ __forceinline__ unsigned short f2bf(float f) { return (unsigned short)(pk2(f, 0.f) & 0xffffu); }
__device__ __forceinline__ float wave_sum(float v) {
#pragma unroll
    for (int o = 1; o < 64; o <<= 1) v += __shfl_xor(v, o);
    return v;
}
__device__ __forceinline__ float fexp2(float x) { return __builtin_amdgcn_exp2f(x); }
__device__ __forceinline__ int row_set(int r) { return r < RC ? 2 : ((r - RC) >> 12); }

#define XB_TMO      128
#define XB_XCNT(j)  (256  + 64 * (j))
#define XB_XSUB(j)  (1280 + 64 * (j))
#define XB_XGEN(j)  (2304 + 64 * (j))
#define XB_TOP      3328
#define XB_TOPGEN   3392
#define XCD_BAR_WORDS 3456
#define XB_SPIN_CAP (1u << 18)

__device__ __forceinline__ unsigned xb_ld(unsigned* p)              { return __hip_atomic_load(p, __ATOMIC_RELAXED, __HIP_MEMORY_SCOPE_AGENT); }
__device__ __forceinline__ unsigned xb_add(unsigned* p, unsigned v) { return __hip_atomic_fetch_add(p, v, __ATOMIC_RELAXED, __HIP_MEMORY_SCOPE_AGENT); }
__device__ __forceinline__ unsigned xb_xcc_id() { return (unsigned)__builtin_amdgcn_s_getreg((3 << 11) | 20) & 0xFu; }
#define XB_SPIN(cond, bar) do { unsigned _sp = 0; while (cond) { __builtin_amdgcn_s_sleep(1); \
    if ((++_sp & 255u) == 0u) { if (xb_ld(&(bar)[XB_TMO])) break; if (_sp > XB_SPIN_CAP) { atomicAdd(&(bar)[XB_TMO], 1u); break; } } } } while (0)

struct XcdBarrier {
    unsigned* bar; unsigned x;
    volatile LAS unsigned* st;
};

__device__ __forceinline__ XcdBarrier xcd_barrier_post(unsigned* bar, volatile LAS unsigned* st) {
    XcdBarrier b; b.bar = bar; b.x = xb_xcc_id(); b.st = st;
    if (threadIdx.x == 0) (void)xb_add(&bar[XB_XCNT(b.x)], 1u);
    return b;
}
__device__ __forceinline__ void xcd_barrier_complete(unsigned* bar, unsigned x, unsigned& nloc, unsigned& nx) {
    const unsigned G = gridDim.x * gridDim.y * gridDim.z;
    unsigned sum, cnt, mine, sp = 0u;
    for (;;) {
        sum = 0u; cnt = 0u; mine = 0u;
#pragma unroll
        for (unsigned j = 0; j < 16; ++j) { const unsigned c = xb_ld(&bar[XB_XCNT(j)]); sum += c; cnt += (c > 0u) ? 1u : 0u; mine = (j == x) ? c : mine; }
        if (sum == G) break;
        __builtin_amdgcn_s_sleep(1);
        if ((++sp & 255u) == 0u) { if (xb_ld(&bar[XB_TMO])) break; if (sp > XB_SPIN_CAP) { atomicAdd(&bar[XB_TMO], 1u); break; } }
    }
    nloc = mine > 0u ? mine : 1u; nx = cnt > 0u ? cnt : 1u;
}

__device__ __forceinline__ void xcd_barrier(const XcdBarrier& b) {
    asm volatile("s_waitcnt vmcnt(0)" ::: "memory");
    __syncthreads();
    if (threadIdx.x == 0) {
        unsigned* bar = b.bar;
        __builtin_amdgcn_s_waitcnt(0);
        unsigned nloc = b.st[0], nx = b.st[1];
        if (nloc == 0u) { xcd_barrier_complete(bar, b.x, nloc, nx); b.st[0] = nloc; b.st[1] = nx; }
        const unsigned old = xb_add(&bar[XB_XSUB(b.x)], 1u);
        const unsigned gen = old / nloc;
        if (old + 1u == (gen + 1u) * nloc) {
            __builtin_amdgcn_fence(__ATOMIC_RELEASE, "agent");
            asm volatile("s_waitcnt vmcnt(0)" ::: "memory");
            const unsigned og = xb_add(&bar[XB_TOP], 1u);
            const unsigned tg = og / nx;
            if (og + 1u == (tg + 1u) * nx) xb_add(&bar[XB_TOPGEN], 1u);
            else XB_SPIN(xb_ld(&bar[XB_TOPGEN]) == tg, bar);
            __builtin_amdgcn_fence(__ATOMIC_ACQUIRE, "agent");
            xb_add(&bar[XB_XGEN(b.x)], 1u);
            asm volatile("s_waitcnt vmcnt(0)" ::: "memory");
        } else {
            XB_SPIN(xb_ld(&bar[XB_XGEN(b.x)]) == gen, bar);
            __builtin_amdgcn_fence(__ATOMIC_ACQUIRE, "agent");
            asm volatile("s_waitcnt vmcnt(0)" ::: "memory");
        }
    }
    __syncthreads();
}

struct Args {
    const float *x, *c, *ctx, *c_ctx, *w_mod, *b_mod, *norm1_w, *norm2_w, *mlp_w1, *mlp_w2, *ev_w_in, *ev_decay, *ev_gn_w, *ev_sink, *ev_w_out,
                *od_w_in, *od_conv_w, *od_qn_w, *od_kvn_w, *od_w_uq, *od_w_ukv, *od_w_out, *norm_f;
    float* out; unsigned char* ws; int ph_lo, ph_hi;
};

__device__ __forceinline__ void unpack8(const v4u w, float (&f)[8]) {
#pragma unroll
    for (int i = 0; i < 4; ++i) { f[2 * i] = bflo(w[i]); f[2 * i + 1] = bfhi(w[i]); }
}
__device__ __forceinline__ v4u pack8(const float (&f)[8]) { v4u w; w.x = pk2(f[0], f[1]); w.y = pk2(f[2], f[3]); w.z = pk2(f[4], f[5]); w.w = pk2(f[6], f[7]); return w; }
__device__ __forceinline__ void ld8f(const float* p, float (&f)[8]) { const f32x4 a = *(const f32x4*)p, b = *(const f32x4*)(p + 4);
    f[0] = a.x; f[1] = a.y; f[2] = a.z; f[3] = a.w; f[4] = b.x; f[5] = b.y; f[6] = b.z; f[7] = b.w; }
__device__ __forceinline__ float lam_of(float log2_decay) { const float x = -fexp2(log2_decay);
    float s = -1.f / 8.f; s = s * x + 1.f / 7.f; s = s * x - 1.f / 6.f; s = s * x + 1.f / 5.f; s = s * x - 1.f / 4.f; s = s * x + 1.f / 3.f; s = s * x - 0.5f; s = s * x + 1.f; return s * x; }
__device__ __forceinline__ f32x4 mfma16(bf16x8 a, bf16x8 b, f32x4 c) { return __builtin_amdgcn_mfma_f32_16x16x32_bf16(a, b, c, 0, 0, 0); }
__device__ __forceinline__ f32x16 mfma32(bf16x8 a, bf16x8 b, f32x16 c) { return __builtin_amdgcn_mfma_f32_32x32x16_bf16(a, b, c, 0, 0, 0); }

struct P0Item { const float* W; bf16* WT; int K, N, item; };
__device__ __forceinline__ void p0_item_load(const P0Item& d, int lane, float (&ld)[32]) {
    const int nblk = d.N / 32, kb = d.item / nblk, nb = d.item % nblk; const float* src = d.W + (size_t)(64 * kb + (lane >> 5)) * d.N + 32 * nb + (lane & 31);
#pragma unroll
    for (int i = 0; i < 32; ++i) ld[i] = __builtin_nontemporal_load(src + (size_t)(2 * i) * d.N);
}
__device__ __forceinline__ void p0_item_finish(const P0Item& d, int lane, const float (&ld)[32], LAS float* scr) {
    const int nblk = d.N / 32, kb = d.item / nblk, nb = d.item % nblk, k0 = 64 * kb, n0 = 32 * nb;
#pragma unroll
    for (int i = 0; i < 32; ++i) scr[(2 * i + (lane >> 5)) * 33 + (lane & 31)] = ld[i];
    LDS_WAIT(); asm volatile("" ::: "memory");
    const int c = lane & 7;
#pragma unroll
    for (int j = 0; j < 4; ++j) { const int n = (lane >> 3) + 8 * j; const LAS float* s = scr + (8 * c) * 33 + n;
        v4u o; o.x = pk2(s[0 * 33], s[1 * 33]); o.y = pk2(s[2 * 33], s[3 * 33]); o.z = pk2(s[4 * 33], s[5 * 33]); o.w = pk2(s[6 * 33], s[7 * 33]);
        __builtin_nontemporal_store(o, (GAS v4u*)(d.WT + (size_t)(n0 + n) * d.K + k0 + 8 * c)); }
    LDS_WAIT(); asm volatile("" ::: "memory");
}
struct ProIn { const float *x, *c, *ctx, *c_ctx, *w_mod, *b_mod, *mlp_w1, *mlp_w2, *ev_w_in, *ev_w_out, *od_w_in, *od_w_out, *od_w_uq, *od_w_ukv; };
__device__ __forceinline__ void ph_prologue(const ProIn a, unsigned char* ws, LAS unsigned char* lds, int tid, int wave, int lane, int wg, int G) {
    float* mod = (float*)(ws + WS_MOD);
    for (int u = wg; u < 192; u += G) {
        LAS float* sl = (LAS float*)lds;
        LAS float* red = (LAS float*)(lds + 24576);
        for (int i = tid; i < 3 * DM; i += NTHR) { const int s = i >> 11, k = i & 2047; const float cv = (s < 2) ? a.c[s * DM + k] : a.c_ctx[k]; sl[i] = cv / (1.f + __expf(-cv)); }
        __syncthreads();
        const int l = u / 48, j0 = (u % 48) * 256;
        const float* wp = a.w_mod + ((size_t)l * DM + wave * 256) * 12288 + j0 + 4 * lane;
        f32x4 a0 = {0.f, 0.f, 0.f, 0.f}, a1 = a0, a2 = a0;
#pragma unroll 8
        for (int k = 0; k < 256; ++k) { const f32x4 w = *(const f32x4*)(wp + (size_t)k * 12288); const int kk = wave * 256 + k;
            a0 += sl[kk] * w; a1 += sl[DM + kk] * w; a2 += sl[2 * DM + kk] * w; }
        *(LAS f32x4*)(red + (wave * 3 + 0) * 256 + 4 * lane) = a0; *(LAS f32x4*)(red + (wave * 3 + 1) * 256 + 4 * lane) = a1; *(LAS f32x4*)(red + (wave * 3 + 2) * 256 + 4 * lane) = a2;
        __syncthreads();
        for (int i = tid; i < 768; i += NTHR) { const int s = i >> 8, col = i & 255; float v = a.b_mod[l * 12288 + j0 + col];
#pragma unroll
            for (int w = 0; w < 8; ++w) v += red[(w * 3 + s) * 256 + col];
            mod[(size_t)(l * 3 + s) * 12288 + j0 + col] = v; }
        __syncthreads();
    }
    {
        LAS float* scr = (LAS float*)(lds + wave * 16384);
        const int gw = wg * NWAVES + wave, NGW = G * NWAVES;
        constexpr int I_W1 = 32 * 256, I_W2 = 128 * 64, I_EI = 32 * 176, I_EO = 32 * 64, I_OI = 32 * 122, I_OO = 32 * 64, I_UQ = 8 * 48, I_UKV = 4 * 64;
        constexpr int NIT = 4 * I_W1 + 4 * I_W2 + 2 * (I_EI + I_EO + I_OI + I_OO + I_UQ + I_UKV);
#define P0_DECODE(it_, d) do { int r = (it_); \
            if (r < 4 * I_W1) { const int l = r / I_W1; d = P0Item{a.mlp_w1 + (size_t)l * DM * DFF, (bf16*)(ws + WS_W1T) + (size_t)l * DFF * DM, DM, DFF, r % I_W1}; break; } r -= 4 * I_W1; \
            if (r < 4 * I_W2) { const int l = r / I_W2; d = P0Item{a.mlp_w2 + (size_t)l * DFF * DM, (bf16*)(ws + WS_W2T) + (size_t)l * DM * DFF, DFF, DM, r % I_W2}; break; } r -= 4 * I_W2; \
            if (r < 2 * I_EI) { const int l = r / I_EI; d = P0Item{a.ev_w_in + (size_t)l * DM * EV_IN, (bf16*)(ws + WS_EWIN) + (size_t)l * EV_IN * DM, DM, EV_IN, r % I_EI}; break; } r -= 2 * I_EI; \
            if (r < 2 * I_EO) { const int l = r / I_EO; d = P0Item{a.ev_w_out + (size_t)l * DM * DM, (bf16*)(ws + WS_EWOUT) + (size_t)l * DM * DM, DM, DM, r % I_EO}; break; } r -= 2 * I_EO; \
            if (r < 2 * I_OI) { const int l = r / I_OI, it2 = r % I_OI, nb = it2 % 122;     \
                bf16* dst = nb < 120 ? (bf16*)(ws + WS_OWIN) + (size_t)l * OD_INP * DM : (bf16*)(ws + WS_WKRT) + (size_t)l * 64 * DM - (size_t)OD_INP * DM; \
                d = P0Item{a.od_w_in + (size_t)l * DM * OD_IN, dst, DM, OD_IN, it2}; break; } r -= 2 * I_OI; \
            if (r < 2 * I_OO) { const int l = r / I_OO; d = P0Item{a.od_w_out + (size_t)l * DM * DM, (bf16*)(ws + WS_OWOUT) + (size_t)l * DM * DM, DM, DM, r % I_OO}; break; } r -= 2 * I_OO; \
            if (r < 2 * I_UQ) { const int l = r / I_UQ; d = P0Item{a.od_w_uq + (size_t)l * 512 * 1536, (bf16*)(ws + WS_UQT) + (size_t)l * 1536 * 512, 512, 1536, r % I_UQ}; break; } r -= 2 * I_UQ; \
            { const int l = r / I_UKV; d = P0Item{a.od_w_ukv + (size_t)l * 256 * 2048, (bf16*)(ws + WS_UKVT) + (size_t)l * 2048 * 256, 256, 2048, r % I_UKV}; } } while (0)
        P0Item dA, dB; float ldA[32], ldB[32];
        int it = gw;
        if (it < NIT) { P0_DECODE(it, dA); p0_item_load(dA, lane, ldA); }
        while (it < NIT) {
            if (it + NGW < NIT) { P0_DECODE(it + NGW, dB); p0_item_load(dB, lane, ldB); }
            p0_item_finish(dA, lane, ldA, scr);
            it += NGW;
            if (it >= NIT) break;
            if (it + NGW < NIT) { P0_DECODE(it + NGW, dA); p0_item_load(dA, lane, ldA); }
            p0_item_finish(dB, lane, ldB, scr);
            it += NGW;
        }
#undef P0_DECODE
    }
    const int gt = wg * NTHR + tid, NGT = G * NTHR;
    {
        const double INV2PI = 0.15915494309189533576888;
        const float L2B = 13.287712379549449f;
        float* t1c = (float*)(ws + WS_T1C); float* t1s = (float*)(ws + WS_T1S);
        for (int i = gt; i < TL * 64; i += NGT) { const int pos = i >> 6, f = i & 63; const float inv = fexp2(-(float)(2 * f) / 128.f * L2B); const float ang = (float)pos * inv;
            double rev = (double)ang * INV2PI; rev -= __builtin_rint(rev); const float fr = (float)rev; t1c[i] = __builtin_amdgcn_cosf(fr); t1s[i] = __builtin_amdgcn_sinf(fr); }
        float* t2c = (float*)(ws + WS_T2); float* t2s = t2c + 64 * 32; float* t3c = t2s + 64 * 32; float* t3s = t3c + 64 * 16;
        for (int i = gt; i < 64 * 32; i += NGT) { const int pos = i >> 5, f = i & 31; const float inv = fexp2(-(float)(2 * f) / 64.f * L2B); const float ang = (float)pos * inv;
            double rev = (double)ang * INV2PI; rev -= __builtin_rint(rev); const float fr = (float)rev; t2c[i] = __builtin_amdgcn_cosf(fr); t2s[i] = __builtin_amdgcn_sinf(fr); }
        for (int i = gt; i < 64 * 16; i += NGT) { const int pos = i >> 4, f = i & 15; const float inv = fexp2(-(float)(2 * f) / 32.f * L2B); const float ang = (float)pos * inv;
            double rev = (double)ang * INV2PI; rev -= __builtin_rint(rev); const float fr = (float)rev; t3c[i] = __builtin_amdgcn_cosf(fr); t3s[i] = __builtin_amdgcn_sinf(fr); }
    }
}

__device__ __forceinline__ void ph_norm(bool src32, const float* Hc, const float* Hx, const bf16* Hb, const float* nw, const float* mod_l, int ch_sh, int ch_sc, bf16* A, int row_lo, LAS unsigned char* lds, int tid, int gw, int NGW, int lane) {
    LAS float* comb = (LAS float*)(lds + 1024);
    for (int i = tid; i < 3 * DM; i += NTHR) { const int set = i >> 11, col = i & 2047; comb[(set * 2 + 0) * DM + col] = nw[col] * (1.f + mod_l[(size_t)(set * 6 + ch_sc) * DM + col]); comb[(set * 2 + 1) * DM + col] = mod_l[(size_t)(set * 6 + ch_sh) * DM + col]; }
    __syncthreads();
#define NORM_ROW_OUT(vv, r_) do { float ss = 0.f; \
        _Pragma("unroll") for (int j = 0; j < 8; ++j) ss += (vv[j].x * vv[j].x + vv[j].y * vv[j].y) + (vv[j].z * vv[j].z + vv[j].w * vv[j].w); \
        ss = wave_sum(ss); \
        const float rs = 1.f / sqrtf(ss * (1.f / DM) + EPS); \
        const LAS float* ca = comb + (row_set(r_) * 2) * DM; const LAS float* cb = ca + DM; \
        v2u* o = (v2u*)(A + (size_t)(r_) * DM) + lane; \
        _Pragma("unroll") for (int j = 0; j < 8; ++j) { const int col = 256 * j + 4 * lane; const f32x4 w = *(const LAS f32x4*)(ca + col), t = *(const LAS f32x4*)(cb + col); \
            const f32x4 y = (vv[j] * rs) * w + t; v2u q; q.x = pk2(y.x, y.y); q.y = pk2(y.z, y.w); o[64 * j] = q; } } while (0)
    if (src32) {
        for (int r0 = row_lo + gw; r0 < RALL; r0 += 2 * NGW) {
            f32x4 va[8], vb[8]; const int r1 = r0 + NGW; const bool h1 = r1 < RALL;
            { const f32x4* xr = (const f32x4*)(r0 < RC ? Hc + (size_t)r0 * DM : Hx + (size_t)(r0 - RC) * DM) + lane;
#pragma unroll
              for (int j = 0; j < 8; ++j) va[j] = xr[64 * j]; }
            if (h1) { const f32x4* xr = (const f32x4*)(r1 < RC ? Hc + (size_t)r1 * DM : Hx + (size_t)(r1 - RC) * DM) + lane;
#pragma unroll
              for (int j = 0; j < 8; ++j) vb[j] = xr[64 * j]; }
            NORM_ROW_OUT(va, r0);
            if (h1) NORM_ROW_OUT(vb, r1);
        }
    } else {
        for (int r0 = row_lo + gw; r0 < RALL; r0 += 5 * NGW) {
            v2u pk[5][8];
#pragma unroll
            for (int b = 0; b < 5; ++b) { const int r = r0 + b * NGW; if (r < RALL) { const v2u* xr = (const v2u*)(Hb + (size_t)r * DM) + lane;
#pragma unroll
                for (int j = 0; j < 8; ++j) pk[b][j] = xr[64 * j]; } }
#pragma unroll
            for (int b = 0; b < 5; ++b) { const int r = r0 + b * NGW; if (r < RALL) { f32x4 v[8];
#pragma unroll
                for (int j = 0; j < 8; ++j) v[j] = (f32x4){bflo(pk[b][j].x), bfhi(pk[b][j].x), bflo(pk[b][j].y), bfhi(pk[b][j].y)};
                NORM_ROW_OUT(v, r); } }
        }
    }
#undef NORM_ROW_OUT
    __syncthreads();
}
template <int NPART> __device__ __forceinline__ void ph_norm_ctx(const float* Hin32, bf16* H, const float* nw, const float* mod_l, int ch_sh, int ch_sc, bf16* A, const bf16* part, const float* pgate, LAS unsigned char* lds, int tid, int wave, int lane, int wg, int G) {
    LAS float* red = (LAS float*)lds;
    const float* sh = mod_l + (size_t)(2 * 6 + ch_sh) * DM; const float* sc = mod_l + (size_t)(2 * 6 + ch_sc) * DM;
    const int col = 256 * wave + 4 * lane;
    for (int r = wg; r < RC; r += G) {
        f32x4 h;
        if (Hin32) h = *(const f32x4*)(Hin32 + (size_t)r * DM + col);
        else { const v2u w = *(const v2u*)(H + (size_t)r * DM + col); h = (f32x4){bflo(w.x), bfhi(w.x), bflo(w.y), bfhi(w.y)}; }
        f32x4 acc = {0.f, 0.f, 0.f, 0.f};
        v2u pw[NPART];
#pragma unroll
        for (int s = 0; s < NPART; ++s) pw[s] = *(const v2u*)(part + ((size_t)s * RC + r) * DM + col);
#pragma unroll
        for (int s = 0; s < NPART; ++s) acc += (f32x4){bflo(pw[s].x), bfhi(pw[s].x), bflo(pw[s].y), bfhi(pw[s].y)};
        h += *(const f32x4*)(pgate + col) * acc;
        { v2u w; w.x = pk2(h.x, h.y); w.y = pk2(h.z, h.w); *(v2u*)(H + (size_t)r * DM + col) = w;
          h = (f32x4){bflo(w.x), bfhi(w.x), bflo(w.y), bfhi(w.y)}; }
        float ss = wave_sum((h.x * h.x + h.y * h.y) + (h.z * h.z + h.w * h.w));
        if (lane == 0) red[wave] = ss;
        __syncthreads();
        float tot = 0.f;
#pragma unroll
        for (int w = 0; w < 8; ++w) tot += red[w];
        __syncthreads();
        const float rs = 1.f / sqrtf(tot * (1.f / DM) + EPS);
        const f32x4 w4 = *(const f32x4*)(nw + col), s4 = *(const f32x4*)(sc + col), t4 = *(const f32x4*)(sh + col);
        const f32x4 y = (h * rs) * w4 * (s4 + 1.f) + t4; v2u q; q.x = pk2(y.x, y.y); q.y = pk2(y.z, y.w);
        *(v2u*)(A + (size_t)r * DM + col) = q;
    }
}
__device__ __forceinline__ void ph_final(const bf16* H, const float* nw, float* out, int gw, int NGW, int lane) {
    f32x4 wv[8];
#pragma unroll
    for (int j = 0; j < 8; ++j) wv[j] = *(const f32x4*)(nw + 256 * j + 4 * lane);
    for (int r0 = gw; r0 < NB * TL; r0 += 4 * NGW) {
        v2u pk[4][8];
#pragma unroll
        for (int b = 0; b < 4; ++b) { const int r = r0 + b * NGW; if (r < NB * TL) { const v2u* xr = (const v2u*)(H + (size_t)(RC + r) * DM) + lane;
#pragma unroll
            for (int j = 0; j < 8; ++j) pk[b][j] = xr[64 * j]; } }
#pragma unroll
        for (int b = 0; b < 4; ++b) { const int r = r0 + b * NGW; if (r < NB * TL) { f32x4 v[8]; float ss = 0.f;
#pragma unroll
            for (int j = 0; j < 8; ++j) { v[j] = (f32x4){bflo(pk[b][j].x), bfhi(pk[b][j].x), bflo(pk[b][j].y), bfhi(pk[b][j].y)}; ss += (v[j].x * v[j].x + v[j].y * v[j].y) + (v[j].z * v[j].z + v[j].w * v[j].w); }
            ss = wave_sum(ss);
            const float rs = 1.f / sqrtf(ss * (1.f / DM) + EPS);
            f32x4* o = (f32x4*)(out + (size_t)r * DM) + lane;
#pragma unroll
            for (int j = 0; j < 8; ++j) o[64 * j] = (v[j] * rs) * wv[j]; } }
    }
}

__device__ __forceinline__ void vt_tile(const bf16* src, int ld_src, bf16* dst, LAS unsigned char* scr, int lane) {
#pragma unroll
    for (int it = 0; it < 8; ++it) { const int key = it * 8 + (lane >> 3), pc = lane & 7;
        const v4u w = *(const v4u*)(src + (size_t)key * ld_src + pc * 8); *(LAS v4u*)(scr + key * 144 + pc * 16) = w; }
    LDS_WAIT(); asm volatile("" ::: "memory");
#pragma unroll
    for (int q = 0; q < 8; ++q) { unsigned e[8];
#pragma unroll
        for (int i = 0; i < 8; ++i) e[i] = *(const LAS unsigned short*)(scr + (16 * (q >> 1) + 4 * (q & 1) + 8 * (i >> 2) + (i & 3)) * 144 + lane * 2);
        v4u w; w.x = e[0] | (e[1] << 16); w.y = e[2] | (e[3] << 16); w.z = e[4] | (e[5] << 16); w.w = e[6] | (e[7] << 16);
        *(v4u*)(dst + (size_t)lane * NKEY + 8 * q) = w; }
    LDS_WAIT(); asm volatile("" ::: "memory");
}
__device__ __forceinline__ int key_row(int b, int kk) { return kk < TC ? b * TC + kk : RC + b * TL + (kk - TC); }

__device__ __forceinline__ void post_win_tile(unsigned char* ws, LAS unsigned char* lds, int pm, int pn, int tid, int wave, int lane) {
    bf16* prj = (bf16*)(ws + WS_PRJ);
    if (pn >= 16 && pn <= 20) {
        if (pm < 2) return;
        const float* t2c = (const float*)(ws + WS_T2); const float* t2s = t2c + 64 * 32;
        for (int idx0 = tid; idx0 < 256 * 16; idx0 += 4 * NTHR) {
            v4u w1[4], w2[4]; bf16* bp[4]; int tb[4];
#pragma unroll
            for (int q = 0; q < 4; ++q) { const int idx = idx0 + q * NTHR; const int p = idx & 3, half = (idx >> 2) & 1, hh = (idx >> 3) & 1, i = idx >> 4;
                const int r = pm * 256 + i, t = (r - RC) & (TL - 1), posv = half ? (t & 63) : (t >> 6);
                bp[q] = prj + (size_t)r * EV_IN + 256 * pn + hh * 128 + half * 64 + 8 * p; tb[q] = posv * 32 + 8 * p;
                w1[q] = *(const v4u*)bp[q]; w2[q] = *(const v4u*)(bp[q] + 32); }
#pragma unroll
            for (int q = 0; q < 4; ++q) { float x1[8], x2[8], cs[8], sn[8], o1[8], o2[8];
                unpack8(w1[q], x1); unpack8(w2[q], x2); ld8f(t2c + tb[q], cs); ld8f(t2s + tb[q], sn);
#pragma unroll
                for (int e = 0; e < 8; ++e) { o1[e] = x1[e] * cs[e] - x2[e] * sn[e]; o2[e] = x2[e] * cs[e] + x1[e] * sn[e]; }
                *(v4u*)bp[q] = pack8(o1); *(v4u*)(bp[q] + 32) = pack8(o2); }
        }
    } else if (pn == 21) {
        bf16* vtw = (bf16*)(ws + WS_VTW); LAS unsigned char* scr = lds + wave * 16384;
        const int b = pm < 2 ? pm : ((pm - 2) >> 4), kt0 = pm < 2 ? 0 : 4 + ((pm - 2) & 15) * 4;
        for (int q = 0; q < 2; ++q) { const int it = wave * 2 + q, dvh = it & 1, kvh = (it >> 1) & 1, kt = kt0 + (it >> 2);
            const int row0 = key_row(b, 64 * kt);
            vt_tile(prj + (size_t)row0 * EV_IN + E_VW + kvh * 128 + dvh * 64, EV_IN, vtw + ((size_t)(b * 2 + kvh) * 128 + dvh * 64) * NKEY + 64 * kt, scr, lane); }
    }
}

__device__ __forceinline__ void ret_kv_unit(unsigned char* ws, const float* dec, LAS unsigned char* lds, int tid, int wave, int lane, int u) {
    const int bh = u / NCH, c = u % NCH, b = bh >> 3, h = bh & 7;
    const bool isctx = c < 2;
    const int row0 = isctx ? b * TC + c * 128 : RC + b * TL + (c - 2) * 128, pos0 = isctx ? 0 : (c - 2) * 128;
    const bf16* prj = (const bf16*)(ws + WS_PRJ);
    const float* t1c = (const float*)(ws + WS_T1C); const float* t1s = (const float*)(ws + WS_T1S);
    const float lf2 = lam_of(dec[h]) * LOG2E, lb2 = lam_of(dec[8 + h]) * LOG2E;
    LAS bf16* KTf = (LAS bf16*)lds; LAS bf16* KTb = KTf + 128 * 136; LAS bf16* VTs = KTb + 128 * 136;
    for (int it = tid; it < 512; it += NTHR) { const int tp = it & 63, p = it >> 6;
        float x1[2][8], x2[2][8], ft[2], bt[2];
#pragma unroll
        for (int q = 0; q < 2; ++q) { const int t = 2 * tp + q; const bf16* kr = prj + (size_t)(row0 + t) * EV_IN + E_KR + h * 128 + 8 * p;
            unpack8(*(const v4u*)kr, x1[q]); unpack8(*(const v4u*)(kr + 64), x2[q]);
            if (!isctx) { float cs[8], sn[8]; ld8f(t1c + (size_t)(pos0 + t) * 64 + 8 * p, cs); ld8f(t1s + (size_t)(pos0 + t) * 64 + 8 * p, sn);
#pragma unroll
                for (int e = 0; e < 8; ++e) { const float a1 = x1[q][e] * cs[e] - x2[q][e] * sn[e], a2 = x2[q][e] * cs[e] + x1[q][e] * sn[e]; x1[q][e] = a1; x2[q][e] = a2; } }
            ft[q] = fexp2(lf2 * (float)(127 - t)); bt[q] = fexp2(lb2 * (float)t); }
#pragma unroll
        for (int e = 0; e < 8; ++e) {
            *(LAS unsigned*)(KTf + (8 * p + e) * 136 + 2 * tp) = pk2(x1[0][e] * ft[0], x1[1][e] * ft[1]); *(LAS unsigned*)(KTf + (64 + 8 * p + e) * 136 + 2 * tp) = pk2(x2[0][e] * ft[0], x2[1][e] * ft[1]);
            *(LAS unsigned*)(KTb + (8 * p + e) * 136 + 2 * tp) = pk2(x1[0][e] * bt[0], x1[1][e] * bt[1]); *(LAS unsigned*)(KTb + (64 + 8 * p + e) * 136 + 2 * tp) = pk2(x2[0][e] * bt[0], x2[1][e] * bt[1]); }
    }
    {
        v4u w0[2], w1[2];
#pragma unroll
        for (int q = 0; q < 2; ++q) { const int it = tid + q * NTHR, tp = it & 63, p = it >> 6; const bf16* vr = prj + (size_t)(row0 + 2 * tp) * EV_IN + E_VR + h * 128 + 8 * p;
            w0[q] = *(const v4u*)vr; w1[q] = *(const v4u*)(vr + EV_IN); }
#pragma unroll
        for (int q = 0; q < 2; ++q) { const int it = tid + q * NTHR, tp = it & 63, p = it >> 6;
#pragma unroll
            for (int i = 0; i < 4; ++i) { const unsigned lo = (w0[q][i] & 0xffffu) | (w1[q][i] << 16), hi = (w0[q][i] >> 16) | (w1[q][i] & 0xffff0000u);
                *(LAS unsigned*)(VTs + (8 * p + 2 * i) * 136 + 2 * tp) = lo; *(LAS unsigned*)(VTs + (8 * p + 2 * i + 1) * 136 + 2 * tp) = hi; } }
    }
    __syncthreads();
    const int dir = wave >> 2, dvb = (wave & 3) * 32, fr = lane & 15, fq = lane >> 4;
    const LAS bf16* KT = dir ? KTb : KTf;
    f32x4 acc[2][8];
#pragma unroll
    for (int m = 0; m < 2; ++m)
#pragma unroll
        for (int n = 0; n < 8; ++n) acc[m][n] = (f32x4){0.f, 0.f, 0.f, 0.f};
#pragma unroll
    for (int s = 0; s < 4; ++s) {
        bf16x8 af[2];
#pragma unroll
        for (int m = 0; m < 2; ++m) af[m] = *(const LAS bf16x8*)(VTs + (dvb + 16 * m + fr) * 136 + 32 * s + 8 * fq);
#pragma unroll
        for (int n = 0; n < 8; ++n) { const bf16x8 bfr = *(const LAS bf16x8*)(KT + (16 * n + fr) * 136 + 32 * s + 8 * fq);
#pragma unroll
            for (int m = 0; m < 2; ++m) acc[m][n] = mfma16(af[m], bfr, acc[m][n]); }
    }
    float* o = (float*)(ws + WS_KVST) + ((size_t)(dir * 16 + bh) * NCH + c) * 16384;
#pragma unroll
    for (int m = 0; m < 2; ++m)
#pragma unroll
        for (int n = 0; n < 8; ++n)
#pragma unroll
            for (int r = 0; r < 4; ++r) o[(dvb + 16 * m + 4 * fq + r) * 128 + 16 * n + fr] = acc[m][n][r];
    __syncthreads();
}
__device__ __forceinline__ void ph_ret_scan(unsigned char* ws, const float* dec, int tid, int wg, int G) {
    for (int w = wg; w < 256; w += G) {
        const int s = w >> 3, slice = w & 7, dir = s >> 4, bh = s & 15, h = bh & 7;
        const float g = fexp2(lam_of(dec[dir * 8 + h]) * LOG2E * 128.f);
        const size_t e0 = (size_t)slice * 2048 + tid * 4;
        const float* kv = (const float*)(ws + WS_KVST) + (size_t)(dir * 16 + bh) * NCH * 16384 + e0;
        bf16* st = (bf16*)(ws + WS_ST) + (size_t)(dir * 16 + bh) * NCH * 16384 + e0;
        f32x4 S = {0.f, 0.f, 0.f, 0.f};
#pragma unroll
        for (int half = 0; half < 2; ++half) {
            f32x4 buf[17];
#pragma unroll
            for (int i = 0; i < 17; ++i) { const int k = half * 17 + i; const int c = dir ? (k == 0 ? 1 : (k == 1 ? 0 : 35 - k)) : k; buf[i] = *(const f32x4*)(kv + (size_t)c * 16384); }
#pragma unroll
            for (int i = 0; i < 17; ++i) { const int k = half * 17 + i; const int c = dir ? (k == 0 ? 1 : (k == 1 ? 0 : 35 - k)) : k;
                v2u q; q.x = pk2(S.x, S.y); q.y = pk2(S.z, S.w); *(v2u*)(st + (size_t)c * 16384) = q; S = S * g + buf[i]; }
        }
    }
}
__device__ __forceinline__ void ret_out_unit(unsigned char* ws, const float* dec, const float* gnw, LAS unsigned char* lds, int tid, int wave, int lane, int u) {
    const int bh = u / NCH, c = u % NCH, b = bh >> 3, h = bh & 7;
    const bool isctx = c < 2;
    const int row0 = isctx ? b * TC + c * 128 : RC + b * TL + (c - 2) * 128, pos0 = isctx ? 0 : (c - 2) * 128;
    const bf16* prj = (const bf16*)(ws + WS_PRJ);
    const float* t1c = (const float*)(ws + WS_T1C); const float* t1s = (const float*)(ws + WS_T1S);
    const float lf2 = lam_of(dec[h]) * LOG2E, lb2 = lam_of(dec[8 + h]) * LOG2E;
    const float scale = 0.088388347648318440f;
    LAS bf16* Qs = (LAS bf16*)lds; LAS bf16* Ks = Qs + 128 * 136; LAS bf16* VTs = Ks + 128 * 136; LAS bf16* Ps = VTs + 128 * 136;
    for (int it = tid; it < 1024; it += NTHR) { const int t = it >> 3, p = it & 7;
        const bf16* qr = prj + (size_t)(row0 + t) * EV_IN + E_QR + h * 128 + 8 * p; const bf16* kr = qr + (E_KR - E_QR);
        float q1[8], q2[8], k1[8], k2[8]; unpack8(*(const v4u*)qr, q1); unpack8(*(const v4u*)(qr + 64), q2); unpack8(*(const v4u*)kr, k1); unpack8(*(const v4u*)(kr + 64), k2);
        if (!isctx) { float cs[8], sn[8]; ld8f(t1c + (size_t)(pos0 + t) * 64 + 8 * p, cs); ld8f(t1s + (size_t)(pos0 + t) * 64 + 8 * p, sn);
#pragma unroll
            for (int e = 0; e < 8; ++e) { const float a1 = q1[e] * cs[e] - q2[e] * sn[e], a2 = q2[e] * cs[e] + q1[e] * sn[e]; q1[e] = a1; q2[e] = a2;
                const float b1 = k1[e] * cs[e] - k2[e] * sn[e], b2 = k2[e] * cs[e] + k1[e] * sn[e]; k1[e] = b1; k2[e] = b2; } }
        *(LAS v4u*)(Qs + t * 136 + 8 * p) = pack8(q1); *(LAS v4u*)(Qs + t * 136 + 64 + 8 * p) = pack8(q2);
        *(LAS v4u*)(Ks + t * 136 + 8 * p) = pack8(k1); *(LAS v4u*)(Ks + t * 136 + 64 + 8 * p) = pack8(k2);
    }
    for (int it = tid; it < 2048; it += NTHR) { const int t = it & 127, p = it >> 7;
        const v4u w = *(const v4u*)(prj + (size_t)(row0 + t) * EV_IN + E_VR + h * 128 + 8 * p);
#pragma unroll
        for (int i = 0; i < 4; ++i) { VTs[(8 * p + 2 * i) * 136 + t] = (bf16)(w[i] & 0xffffu); VTs[(8 * p + 2 * i + 1) * 136 + t] = (bf16)(w[i] >> 16); }
    }
    __syncthreads();
    v4u streg[2][4];
    { const bf16* st0 = (const bf16*)(ws + WS_ST) + ((size_t)bh * NCH + c) * 16384;
#pragma unroll
      for (int dir = 0; dir < 2; ++dir)
#pragma unroll
          for (int j = 0; j < 4; ++j) streg[dir][j] = *(const v4u*)(st0 + (size_t)dir * 16 * NCH * 16384 + (size_t)(tid + NTHR * j) * 8); }
    const int i0 = 16 * wave, fr = lane & 15, fq = lane >> 4;
    bf16x8 qa[4];
#pragma unroll
    for (int s = 0; s < 4; ++s) qa[s] = *(const LAS bf16x8*)(Qs + (i0 + fr) * 136 + 32 * s + 8 * fq);
#pragma unroll
    for (int n = 0; n < 8; ++n) { f32x4 sa = {0.f, 0.f, 0.f, 0.f};
#pragma unroll
        for (int s = 0; s < 4; ++s) { const bf16x8 kb = *(const LAS bf16x8*)(Ks + (16 * n + fr) * 136 + 32 * s + 8 * fq); sa = mfma16(qa[s], kb, sa); }
#pragma unroll
        for (int r = 0; r < 4; ++r) { const int d = (i0 + 4 * fq + r) - (16 * n + fr);
            const float dcy = d >= 0 ? fexp2(lf2 * (float)d) : fexp2(lb2 * (float)(-d));
            Ps[(i0 + 4 * fq + r) * 136 + 16 * n + fr] = f2bf(sa[r] * scale * dcy); }
    }
    LDS_WAIT(); asm volatile("" ::: "memory");
    f32x4 O[8];
#pragma unroll
    for (int n = 0; n < 8; ++n) O[n] = (f32x4){0.f, 0.f, 0.f, 0.f};
#pragma unroll
    for (int s = 0; s < 4; ++s) { const bf16x8 pa = *(const LAS bf16x8*)(Ps + (i0 + fr) * 136 + 32 * s + 8 * fq);
#pragma unroll
        for (int n = 0; n < 8; ++n) { const bf16x8 vb = *(const LAS bf16x8*)(VTs + (16 * n + fr) * 136 + 32 * s + 8 * fq); O[n] = mfma16(pa, vb, O[n]); } }
    __syncthreads();
#pragma unroll
    for (int dir = 0; dir < 2; ++dir)
#pragma unroll
        for (int j = 0; j < 4; ++j) { const int e = (tid + NTHR * j) * 8, dvr = e >> 7, dkc = e & 127; *(LAS v4u*)((dir ? Qs : Ks) + dvr * 136 + dkc) = streg[dir][j]; }
    __syncthreads();
#pragma unroll
    for (int dir = 0; dir < 2; ++dir) {
        const LAS bf16* st = dir ? Qs : Ks;
        f32x4 T[8];
#pragma unroll
        for (int n = 0; n < 8; ++n) T[n] = (f32x4){0.f, 0.f, 0.f, 0.f};
#pragma unroll
        for (int s = 0; s < 4; ++s)
#pragma unroll
            for (int n = 0; n < 8; ++n) { const bf16x8 sb = *(const LAS bf16x8*)(st + (16 * n + fr) * 136 + 32 * s + 8 * fq); T[n] = mfma16(qa[s], sb, T[n]); }
#pragma unroll
        for (int r = 0; r < 4; ++r) { const int il = i0 + 4 * fq + r; const float fac = scale * (dir == 0 ? fexp2(lf2 * (float)(il + 1)) : fexp2(lb2 * (float)(128 - il)));
#pragma unroll
            for (int n = 0; n < 8; ++n) O[n][r] += T[n][r] * fac; }
    }
    bf16* mix = (bf16*)(ws + WS_MIX);
    unsigned short gtv[4][8]; float gw8[8];
#pragma unroll
    for (int n = 0; n < 8; ++n) gw8[n] = gnw[h * 128 + 16 * n + fr];
#pragma unroll
    for (int r = 0; r < 4; ++r)
#pragma unroll
        for (int n = 0; n < 8; ++n) gtv[r][n] = prj[(size_t)(row0 + i0 + 4 * fq + r) * EV_IN + E_GR + h * 128 + 16 * n + fr];
#pragma unroll
    for (int r = 0; r < 4; ++r) {
        float s1 = 0.f;
#pragma unroll
        for (int n = 0; n < 8; ++n) s1 += O[n][r];
        s1 += __shfl_xor(s1, 1); s1 += __shfl_xor(s1, 2); s1 += __shfl_xor(s1, 4); s1 += __shfl_xor(s1, 8);
        const float mu = s1 * (1.f / 128.f);
        float s2 = 0.f;
#pragma unroll
        for (int n = 0; n < 8; ++n) { const float d = O[n][r] - mu; s2 += d * d; }
        s2 += __shfl_xor(s2, 1); s2 += __shfl_xor(s2, 2); s2 += __shfl_xor(s2, 4); s2 += __shfl_xor(s2, 8);
        const float rstd = 1.f / sqrtf(s2 * (1.f / 128.f) + EPS);
        const int row = row0 + i0 + 4 * fq + r;
#pragma unroll
        for (int n = 0; n < 8; ++n) { const int dv = 16 * n + fr; const float gt = bf2f(gtv[r][n]);
            const float y = (O[n][r] - mu) * rstd * gw8[n] * (gt / (1.f + __expf(-gt)));
            mix[(size_t)row * DM + h * 128 + dv] = f2bf(y); }
    }
    __syncthreads();
}

template <int DQK, bool WINDOW, bool SINK>
__device__ __forceinline__ void attn_unit(LAS unsigned char* lds, int tid, int wave, int lane,
        const bf16* Qp, int ldq, const bf16* Kc, const bf16* Kl, int ldk, const bf16* K2c, const bf16* K2l, int ldk2, const bf16* VT,
        int nctx, int tlo, int thi, int q0, float sc_log2, float sink_log2, bf16* Op, int ldo) {
    constexpr int KS = DQK * 2 + 16, KT_BYTES = 64 * KS, VS = 144, VT_BYTES = 128 * VS, BUF = KT_BYTES + VT_BYTES;
    constexpr int NS = DQK / 16, KPT = DQK / 64;
    const int c = lane & 31, h = lane >> 5;
    bf16x8 qf[NS];
    { const bf16* qr = Qp + (size_t)(wave * 32 + c) * ldq + 8 * h;
#pragma unroll
      for (int s = 0; s < NS; ++s) qf[s] = *(const bf16x8*)(qr + 16 * s); }
    f32x16 oT[4];
#pragma unroll
    for (int dt = 0; dt < 4; ++dt)
#pragma unroll
        for (int r = 0; r < 16; ++r) oT[dt][r] = 0.f;
    float m_run = SINK ? sink_log2 : -1e30f, l_run = (SINK && h == 0) ? 1.f : 0.f;
    const int ntile = nctx + (thi - tlo);
    v4u kregA[KPT], vregA[2], kregB[KPT], vregB[2];
    const unsigned koff0 = (unsigned)((tid >> 4) * ldk + (tid & 15) * 8), koff1 = koff0 + 32u * (unsigned)ldk, koff2 = (unsigned)((tid >> 3) * ldk2 + (tid & 7) * 8);
    const unsigned voff0 = (unsigned)((tid >> 3) * NKEY + (tid & 7) * 8), voff1 = voff0 + 64u * NKEY;
    const int klds0 = (tid >> 4) * KS + (tid & 15) * 16, klds2 = (tid >> 3) * KS + 256 + (tid & 7) * 16, vlds0 = (tid >> 3) * VS + (tid & 7) * 16;
#define ATT_LOAD(i_, kreg, vreg) do { int _i = (i_); if (_i > ntile - 1) _i = ntile - 1; const bool _cx = _i < nctx; const int _t = _cx ? _i : tlo + (_i - nctx); \
        const bf16* _k = (_cx ? Kc : Kl) + (size_t)(64 * _t) * ldk; const int _vc = _cx ? 64 * _t : TC + 64 * _t; \
        kreg[0] = *(const v4u*)(_k + koff0); kreg[1] = *(const v4u*)(_k + koff1); \
        if (DQK > 128) { const bf16* _k2 = (_cx ? K2c : K2l) + (size_t)(64 * _t) * ldk2; kreg[KPT - 1] = *(const v4u*)(_k2 + koff2); } \
        vreg[0] = *(const v4u*)(VT + voff0 + _vc); vreg[1] = *(const v4u*)(VT + voff1 + _vc); } while (0)
#define ATT_STORE(buf_, kreg, vreg) do { LAS unsigned char* _kb = lds + (buf_) * BUF; LAS unsigned char* _vb = _kb + KT_BYTES; \
        *(LAS v4u*)(_kb + klds0) = kreg[0]; *(LAS v4u*)(_kb + klds0 + 32 * KS) = kreg[1]; \
        if (DQK > 128) *(LAS v4u*)(_kb + klds2) = kreg[KPT - 1]; \
        *(LAS v4u*)(_vb + vlds0) = vreg[0]; *(LAS v4u*)(_vb + vlds0 + 64 * VS) = vreg[1]; } while (0)
#define ATT_THR 8.0f
#define ATT_COMPUTE(i) do { \
        if (WINDOW && (i) >= nctx) { const int _k0 = 64 * (tlo + ((i) - nctx)), _qw = q0 + wave * 32; if (_k0 > _qw + 159 || _k0 + 63 < _qw - 128) break; }     \
        const LAS unsigned char* kb = lds + (i & 1) * BUF; const LAS unsigned char* vb = kb + KT_BYTES; \
        f32x16 sT[2]; \
        _Pragma("unroll") \
        for (int kt = 0; kt < 2; ++kt) \
        _Pragma("unroll") \
            for (int r = 0; r < 16; ++r) sT[kt][r] = 0.f; \
        { \
            constexpr int PF = 4, NQ = 2 * NS; \
            bf16x8 kf[PF]; \
        _Pragma("unroll") \
            for (int n = 0; n < PF; ++n) kf[n] = *(const LAS bf16x8*)(kb + (32 * (n / NS) + c) * KS + (16 * (n % NS) + 8 * h) * 2); \
        _Pragma("unroll") \
            for (int n = 0; n < NQ; ++n) { const bf16x8 ka = kf[n % PF]; \
                if (n + PF < NQ) kf[n % PF] = *(const LAS bf16x8*)(kb + (32 * ((n + PF) / NS) + c) * KS + (16 * ((n + PF) % NS) + 8 * h) * 2); \
                sT[n / NS] = mfma32(ka, qf[n % NS], sT[n / NS]); } \
        } \
        const bool msk = WINDOW && (i >= nctx); \
        const int kpos0 = 64 * (tlo + (i - nctx)), qpos = q0 + wave * 32 + c; \
        float mx = -1e38f; \
        _Pragma("unroll") \
        for (int kt = 0; kt < 2; ++kt) \
        _Pragma("unroll") \
            for (int r = 0; r < 16; ++r) { \
                if (WINDOW) { const int kpos = kpos0 + 32 * kt + (r & 3) + 8 * (r >> 2) + 4 * h; const int dd = qpos - kpos; if (msk && (dd > 128 || dd < -128)) sT[kt][r] = -1e38f; } \
                mx = fmaxf(mx, sT[kt][r]); } \
        mx = fmaxf(mx, __shfl_xor(mx, 32)); \
        const float mxs = mx * sc_log2; \
        if (__builtin_amdgcn_ballot_w64(mxs > m_run + ATT_THR) != 0ull) {     \
            const float mn = fmaxf(m_run, mxs), alpha = fexp2(m_run - mn); \
            m_run = mn; l_run *= alpha; \
            _Pragma("unroll") \
            for (int dt = 0; dt < 4; ++dt) \
            _Pragma("unroll") \
                for (int r = 0; r < 16; ++r) oT[dt][r] *= alpha; \
        } \
        float ps = 0.f; \
        _Pragma("unroll") \
        for (int kt = 0; kt < 2; ++kt) \
        _Pragma("unroll") \
            for (int r = 0; r < 16; ++r) { const float pv = fexp2(fmaf(sT[kt][r], sc_log2, -m_run)); sT[kt][r] = pv; ps += pv; } \
        l_run += ps; \
        bf16x8 pf[4]; \
        _Pragma("unroll") \
        for (int s = 0; s < 4; ++s) { const int kt = s >> 1, s8 = (s & 1) * 8; v4u w; \
            w.x = pk2(sT[kt][s8 + 0], sT[kt][s8 + 1]); w.y = pk2(sT[kt][s8 + 2], sT[kt][s8 + 3]); w.z = pk2(sT[kt][s8 + 4], sT[kt][s8 + 5]); w.w = pk2(sT[kt][s8 + 6], sT[kt][s8 + 7]); \
            pf[s] = __builtin_bit_cast(bf16x8, w); } \
        { \
            constexpr int PF = 4; \
            v4u vf[PF]; \
        _Pragma("unroll") \
            for (int n = 0; n < PF; ++n) vf[n] = *(const LAS v4u*)(vb + (32 * (n >> 2) + c) * VS + (16 * (n & 3) + 8 * h) * 2); \
        _Pragma("unroll") \
            for (int n = 0; n < 16; ++n) { const v4u va = vf[n % PF]; \
                if (n + PF < 16) { const int n2 = n + PF; vf[n % PF] = *(const LAS v4u*)(vb + (32 * (n2 >> 2) + c) * VS + (16 * (n2 & 3) + 8 * h) * 2); } \
                oT[n >> 2] = mfma32(__builtin_bit_cast(bf16x8, va), pf[n & 3], oT[n >> 2]); } \
        } \
    } while (0)
    if (ntile > 0) { ATT_LOAD(0, kregA, vregA); ATT_STORE(0, kregA, vregA); ATT_LOAD(1, kregB, vregB); }
    __syncthreads();
    for (int i = 0; i < ntile; i += 2) {
        ATT_LOAD(i + 2, kregA, vregA);
        ATT_COMPUTE(i);
        ATT_STORE((i + 1) & 1, kregB, vregB);
        __syncthreads();
        if (i + 1 < ntile) {
            ATT_LOAD(i + 3, kregB, vregB);
            ATT_COMPUTE(i + 1);
            ATT_STORE(i & 1, kregA, vregA);
            __syncthreads();
        }
    }
#undef ATT_COMPUTE
#undef ATT_THR
#undef ATT_LOAD
#undef ATT_STORE
    const float lt = l_run + __shfl_xor(l_run, 32), inv = 1.f / lt;
    bf16* orow = Op + (size_t)(wave * 32 + c) * ldo + 4 * h;
#pragma unroll
    for (int dt = 0; dt < 4; ++dt)
#pragma unroll
        for (int rq = 0; rq < 4; ++rq) { v2u w; w.x = pk2(oT[dt][4 * rq] * inv, oT[dt][4 * rq + 1] * inv); w.y = pk2(oT[dt][4 * rq + 2] * inv, oT[dt][4 * rq + 3] * inv);
            *(v2u*)(orow + 32 * dt + 8 * rq) = w; }
}

__device__ __forceinline__ void ph_win(unsigned char* ws, const float* sink, LAS unsigned char* lds, int tid, int wave, int lane, int wg, int G) {
    const bf16* prj = (const bf16*)(ws + WS_PRJ); bf16* mix = (bf16*)(ws + WS_MIX); const bf16* vtw = (const bf16*)(ws + WS_VTW);
    const float scl = 0.088388347648318440f * LOG2E;
    for (int u = wg; u < 272; u += G) {
        const bool cx = u >= 256;
        const int pair = cx ? (u - 256) : ((u & 7) * 2 + (u >> 7)), qb = (u >> 3) & 15, b = pair >> 3, hq = pair & 7, kvh = hq >> 2;
        const int q0 = cx ? 0 : qb * 256; int tlo = (q0 - 128) / 64; if (tlo < 0) tlo = 0; int thi = (q0 + 383) / 64 + 1; if (thi > 64) thi = 64; if (cx) { tlo = 0; thi = 0; }
        const int qrow = cx ? b * TC : RC + b * TL + q0;
        attn_unit<128, true, true>(lds, tid, wave, lane, prj + (size_t)qrow * EV_IN + E_QW + hq * 128, EV_IN,
            prj + (size_t)(b * TC) * EV_IN + E_KW + kvh * 128, prj + (size_t)(RC + b * TL) * EV_IN + E_KW + kvh * 128, EV_IN, nullptr, nullptr, 0,
            vtw + (size_t)(b * 2 + kvh) * 128 * NKEY, 4, tlo, thi, q0, scl, sink[hq] * LOG2E, mix + (size_t)qrow * DM + 1024 + hq * 128, DM);
    }
}
__device__ __forceinline__ void ph_ret_out(unsigned char* ws, const float* dec, const float* gnw, LAS unsigned char* lds, int tid, int wave, int lane, int wg, int G) {
    for (int u = (wg + G - 32) % G; u < 16 * NCH; u += G) ret_out_unit(ws, dec, gnw, lds, tid, wave, lane, u);
}

__device__ __forceinline__ void ph_prep_odd(unsigned char* ws, LAS unsigned char* lds, const float* convw, const float* qnw, const float* kvnw, int jl, int tid, int wave, int lane, int wg, int G) {
    const bf16* prj = (const bf16*)(ws + WS_PRJ); bf16* mix = (bf16*)(ws + WS_MIX);
    {
        const bf16* a1 = (const bf16*)(ws + WS_A1); const bf16* wk = (const bf16*)(ws + WS_WKRT) + (size_t)jl * 64 * DM; bf16* kr = (bf16*)(ws + WS_KR);
        const int fr = lane & 15, fq = lane >> 4;
        LAS f32x4* red = (LAS f32x4*)lds;
        for (int t = wg; t < RALL / 32; t += G) {
            f32x4 acc[2][4];
#pragma unroll
            for (int m = 0; m < 2; ++m)
#pragma unroll
                for (int n = 0; n < 4; ++n) acc[m][n] = (f32x4){0.f, 0.f, 0.f, 0.f};
            const bf16* ap = a1 + (size_t)(32 * t + fr) * DM + 256 * wave + 8 * fq; const bf16* bp = wk + (size_t)fr * DM + 256 * wave + 8 * fq;
#pragma unroll
            for (int s = 0; s < 8; ++s) { bf16x8 af[2], bfr[4];
#pragma unroll
                for (int m = 0; m < 2; ++m) af[m] = *(const bf16x8*)(ap + (size_t)(16 * m) * DM + 32 * s);
#pragma unroll
                for (int n = 0; n < 4; ++n) bfr[n] = *(const bf16x8*)(bp + (size_t)(16 * n) * DM + 32 * s);
#pragma unroll
                for (int m = 0; m < 2; ++m)
#pragma unroll
                    for (int n = 0; n < 4; ++n) acc[m][n] = mfma16(af[m], bfr[n], acc[m][n]); }
#pragma unroll
            for (int m = 0; m < 2; ++m)
#pragma unroll
                for (int n = 0; n < 4; ++n) red[(wave * 8 + m * 4 + n) * 64 + lane] = acc[m][n];
            __syncthreads();
            { const int m = wave >> 2, n = wave & 3; f32x4 sacc = red[(0 * 8 + wave) * 64 + lane];
#pragma unroll
              for (int w = 1; w < 8; ++w) sacc += red[(w * 8 + wave) * 64 + lane];
#pragma unroll
              for (int r = 0; r < 4; ++r) kr[(size_t)(32 * t + 16 * m + 4 * fq + r) * 64 + 16 * n + fr] = f2bf(sacc[r]); }
            __syncthreads();
        }
    }
    const int gt = wg * NTHR + tid, NGT = G * NTHR;
    const bool wfix = (NGT & 127) == 0;
    float w0[8], w1[8], w2[8];
    if (wfix) { const int c0 = (gt & 127) * 8; ld8f(convw + c0, w0); ld8f(convw + 1024 + c0, w1); ld8f(convw + 2048 + c0, w2); }
    for (int idx0 = gt; idx0 < RALL * 128; idx0 += 3 * NGT) {
        v4u wb[3], wc[3][3], wx[3][3];
#pragma unroll
        for (int b = 0; b < 3; ++b) { const int idx = idx0 + b * NGT; if (idx < RALL * 128) {
            const int r = idx >> 7, c0 = (idx & 127) * 8;
            int t, T; if (r < RC) { t = r & (TC - 1); T = TC; } else { t = (r - RC) & (TL - 1); T = TL; }
            const bf16* pr = prj + (size_t)r * OD_INP;
            wb[b] = *(const v4u*)(pr + O_BG + c0); wc[b][1] = *(const v4u*)(pr + O_CG + c0); wx[b][1] = *(const v4u*)(pr + O_XV + c0);
            if (t > 0) { wc[b][0] = *(const v4u*)(pr - OD_INP + O_CG + c0); wx[b][0] = *(const v4u*)(pr - OD_INP + O_XV + c0); } else { wc[b][0] = (v4u){0u, 0u, 0u, 0u}; wx[b][0] = wc[b][0]; }
            if (t < T - 1) { wc[b][2] = *(const v4u*)(pr + OD_INP + O_CG + c0); wx[b][2] = *(const v4u*)(pr + OD_INP + O_XV + c0); } else { wc[b][2] = (v4u){0u, 0u, 0u, 0u}; wx[b][2] = wc[b][2]; } } }
#pragma unroll
        for (int b = 0; b < 3; ++b) { const int idx = idx0 + b * NGT; if (idx < RALL * 128) {
            const int r = idx >> 7, c0 = (idx & 127) * 8;
            float bg[8], u0[8], u1[8], u2[8], a[8], b2[8], y[8];
            unpack8(wb[b], bg);
            unpack8(wc[b][0], a); unpack8(wx[b][0], b2);
#pragma unroll
            for (int e = 0; e < 8; ++e) u0[e] = a[e] * b2[e];
            unpack8(wc[b][1], a); unpack8(wx[b][1], b2);
#pragma unroll
            for (int e = 0; e < 8; ++e) u1[e] = a[e] * b2[e];
            unpack8(wc[b][2], a); unpack8(wx[b][2], b2);
#pragma unroll
            for (int e = 0; e < 8; ++e) u2[e] = a[e] * b2[e];
            if (!wfix) { ld8f(convw + c0, w0); ld8f(convw + 1024 + c0, w1); ld8f(convw + 2048 + c0, w2); }
#pragma unroll
            for (int e = 0; e < 8; ++e) y[e] = bg[e] * (u0[e] * w0[e] + u1[e] * w1[e] + u2[e] * w2[e]);
            *(v4u*)(mix + (size_t)r * DM + c0) = pack8(y); } }
    }
    bf16* cqn = (bf16*)(ws + WS_CQN); bf16* ckvn = (bf16*)(ws + WS_CKVN);
    const int gw = wg * NWAVES + wave, NGW = G * NWAVES;
    float qw8[8]; ld8f(qnw + 8 * lane, qw8); const f32x4 kw4 = *(const f32x4*)(kvnw + 4 * lane);
    for (int r0 = gw; r0 < RALL; r0 += 5 * NGW) {
        v4u wq[5]; v2u wk[5];
#pragma unroll
        for (int b = 0; b < 5; ++b) { const int r = r0 + b * NGW; if (r < RALL) { const bf16* pr = prj + (size_t)r * OD_INP; wq[b] = *(const v4u*)(pr + O_CQ + 8 * lane); wk[b] = *(const v2u*)(pr + O_CKV + 4 * lane); } }
#pragma unroll
        for (int b = 0; b < 5; ++b) { const int r = r0 + b * NGW; if (r < RALL) {
            float q[8]; unpack8(wq[b], q);
            float ss = 0.f;
#pragma unroll
            for (int e = 0; e < 8; ++e) ss += q[e] * q[e];
            ss = wave_sum(ss);
            const float rs = 1.f / sqrtf(ss * (1.f / 512.f) + EPS);
#pragma unroll
            for (int e = 0; e < 8; ++e) q[e] = q[e] * rs * qw8[e];
            *(v4u*)(cqn + (size_t)r * 512 + 8 * lane) = pack8(q);
            const v2u kw = wk[b];
            const float k0 = bflo(kw.x), k1 = bfhi(kw.x), k2 = bflo(kw.y), k3 = bfhi(kw.y);
            float s2 = wave_sum(k0 * k0 + k1 * k1 + k2 * k2 + k3 * k3);
            const float rs2 = 1.f / sqrtf(s2 * (1.f / 256.f) + EPS);
            v2u o; o.x = pk2(k0 * rs2 * kw4.x, k1 * rs2 * kw4.y); o.y = pk2(k2 * rs2 * kw4.z, k3 * rs2 * kw4.w);
            *(v2u*)(ckvn + (size_t)r * 256 + 4 * lane) = o; } }
    }
}
__device__ __forceinline__ void rope64_item(bf16* blk, int t, int half, int p, const float* t3c, const float* t3s) {
    const int posv = half ? (t & 63) : (t >> 6); bf16* bp = blk + half * 32 + 8 * p; const int tb = posv * 16 + 8 * p;
    const v4u w1 = *(const v4u*)bp, w2 = *(const v4u*)(bp + 16);
    float x1[8], x2[8], cs[8], sn[8], o1[8], o2[8];
    unpack8(w1, x1); unpack8(w2, x2); ld8f(t3c + tb, cs); ld8f(t3s + tb, sn);
#pragma unroll
    for (int e = 0; e < 8; ++e) { o1[e] = x1[e] * cs[e] - x2[e] * sn[e]; o2[e] = x2[e] * cs[e] + x1[e] * sn[e]; }
    *(v4u*)bp = pack8(o1); *(v4u*)(bp + 16) = pack8(o2);
}
__device__ __forceinline__ void ph_rope_kr(unsigned char* ws, int tid, int wg, int G) {
    bf16* krb = (bf16*)(ws + WS_KR); const float* t3c = (const float*)(ws + WS_T2) + 2 * 64 * 32; const float* t3s = t3c + 64 * 16;
    for (int idx = wg * NTHR + tid; idx < NB * TL * 4; idx += G * NTHR) { const int p = idx & 1, half = (idx >> 1) & 1, rl = idx >> 2;
        rope64_item(krb + (size_t)(RC + rl) * 64, rl & (TL - 1), half, p, t3c, t3s); }
}
__device__ __forceinline__ void post_q_tile(unsigned char* ws, int pm, int pn, int tid) {
    if (pm < 2) return;
    bf16* qraw = (bf16*)(ws + WS_QRAW); const float* t3c = (const float*)(ws + WS_T2) + 2 * 64 * 32; const float* t3s = t3c + 64 * 16;
    for (int h = 0; h < 8; ++h) { const int c0 = 192 * h + 128; if (c0 < 256 * pn || c0 >= 256 * pn + 256) continue;
        for (int idx = tid; idx < 1024; idx += NTHR) { const int p = idx & 1, half = (idx >> 1) & 1, i = idx >> 2; const int r = pm * 256 + i;
            rope64_item(qraw + (size_t)r * 1536 + c0, (r - RC) & (TL - 1), half, p, t3c, t3s); } }
}
__device__ __forceinline__ void post_v_tile(unsigned char* ws, LAS unsigned char* lds, int b, int hh, int kt0, int wave, int lane) {
    const bf16* kvraw = (const bf16*)(ws + WS_KVRAW); bf16* vtm = (bf16*)(ws + WS_VTM); LAS unsigned char* scr = lds + wave * 16384;
    const int kt = kt0 + (wave >> 1), dvh = wave & 1, row0 = key_row(b, 64 * kt);
    vt_tile(kvraw + (size_t)row0 * 2048 + hh * 256 + 128 + dvh * 64, 2048, vtm + ((size_t)(b * 8 + hh) * 128 + dvh * 64) * NKEY + 64 * kt, scr, lane);
}
__device__ __forceinline__ void ph_mix_odd(unsigned char* ws, LAS unsigned char* lds, int nunits, int tid, int wave, int lane, int wg, int G) {
    const bf16* krb = (const bf16*)(ws + WS_KR); bf16* mix = (bf16*)(ws + WS_MIX); const bf16* vtm = (const bf16*)(ws + WS_VTM);
    const bf16* qraw = (const bf16*)(ws + WS_QRAW); const bf16* kvraw = (const bf16*)(ws + WS_KVRAW);
    const float scl = 0.072168783648703220f * LOG2E;
    for (int u = wg; u < nunits; u += G) {
        const bool cx = u >= 256;
        const int pair = cx ? (u - 256) : ((u & 7) * 2 + (u >> 7)), qb = (u >> 3) & 15, b = pair >> 3, hh = pair & 7;
        const int q0 = cx ? 0 : qb * 256, qrow = cx ? b * TC : RC + b * TL + q0;
        attn_unit<192, false, false>(lds, tid, wave, lane, qraw + (size_t)qrow * 1536 + hh * 192, 1536,
            kvraw + (size_t)(b * TC) * 2048 + hh * 256, kvraw + (size_t)(RC + b * TL) * 2048 + hh * 256, 2048,
            krb + (size_t)(b * TC) * 64, krb + (size_t)(RC + b * TL) * 64, 64,
            vtm + (size_t)(b * 8 + hh) * 128 * NKEY, 4, 0, cx ? 0 : 64, q0, scl, 0.f, mix + (size_t)qrow * DM + 1024 + hh * 128, DM);
    }
}

#define NOINL static __device__ __forceinline__
typedef const GAS float* gcf;
typedef GAS unsigned char* gws;
typedef const GAS unsigned short* gcb;
__device__ __forceinline__ int mk_lane() { int l; asm volatile("v_mbcnt_lo_u32_b32 %0, -1, 0\n\tv_mbcnt_hi_u32_b32 %0, -1, %0" : "=v"(l)); return l; }
#define PH_IDS int wv_ = wave_in; asm volatile("" : "+s"(wv_)); const int wave = wv_, lane = mk_lane(), tid = wave * 64 + lane, G = gridDim.x, wg = blockIdx.x; (void)lane; (void)wave; (void)G; (void)wg; (void)tid
#define PH_GW const int gw = wg * NWAVES + wave, NGW = G * NWAVES

__device__ __forceinline__ int uni(int v) { return __builtin_amdgcn_readfirstlane(v); }
template <class T> __device__ __forceinline__ GAS T* uni(GAS T* p) { const unsigned long long v = (unsigned long long)p; const unsigned lo = (unsigned)__builtin_amdgcn_readfirstlane((int)(unsigned)v), hi = (unsigned)__builtin_amdgcn_readfirstlane((int)(unsigned)(v >> 32));
    return (GAS T*)(((unsigned long long)hi << 32) | lo); }
template <class T> __device__ __forceinline__ LAS T* uni(LAS T* p) { return (LAS T*)(unsigned)__builtin_amdgcn_readfirstlane((int)(unsigned)(unsigned long long)p); }
#define U(x) x = uni(x)
#define OPQ(x) asm volatile("" : "+s"(x))

NOINL void f_prologue(int wave_in, gws ws, LAS unsigned char* lds, gcf x, gcf c, gcf ctx, gcf c_ctx, gcf w_mod, gcf b_mod, gcf mlp_w1, gcf mlp_w2, gcf ev_w_in, gcf ev_w_out, gcf od_w_in, gcf od_w_out, gcf od_w_uq, gcf od_w_ukv) {
    PH_IDS; U(ws); U(lds); U(x); U(c); U(ctx); U(c_ctx); U(w_mod); U(b_mod); U(mlp_w1); U(mlp_w2); U(ev_w_in); U(ev_w_out); U(od_w_in); U(od_w_out); U(od_w_uq); U(od_w_ukv);
    ProIn p{(const float*)x, (const float*)c, (const float*)ctx, (const float*)c_ctx, (const float*)w_mod, (const float*)b_mod, (const float*)mlp_w1, (const float*)mlp_w2, (const float*)ev_w_in, (const float*)ev_w_out,
            (const float*)od_w_in, (const float*)od_w_out, (const float*)od_w_uq, (const float*)od_w_ukv};
    ph_prologue(p, (unsigned char*)ws, lds, tid, wave, lane, wg, G);
}
NOINL void f_norm(int wave_in, gws ws, LAS unsigned char* lds, gcf nw, gcf ctx32, gcf x32, int layer, int ch_sh, int ch_sc, int mode) {
    PH_IDS; PH_GW; U(ws); U(lds); U(nw); U(ctx32); U(x32); U(layer); U(ch_sh); U(ch_sc); U(mode);
    const float* mod_l = (const float*)(ws + WS_MOD) + (size_t)layer * 3 * 12288;
    bf16* Hb = (bf16*)(ws + WS_H);
    if (mode == 1) ph_norm_ctx<S_MLP>(nullptr, Hb, (const float*)nw, mod_l, ch_sh, ch_sc, (bf16*)(ws + WS_A1), (const bf16*)(ws + WS_PARTM), mod_l - 3 * 12288 + (2 * 6 + 5) * DM, lds, tid, wave, lane, wg, G);
    if (mode == 2) ph_norm_ctx<S_OUT>(layer == 0 ? (const float*)ctx32 : nullptr, Hb, (const float*)nw, mod_l, ch_sh, ch_sc, (bf16*)(ws + WS_A1), (const bf16*)(ws + WS_PARTO), mod_l + (2 * 6 + 2) * DM, lds, tid, wave, lane, wg, G);
    __syncthreads();
    ph_norm(mode == 0, (const float*)ctx32, (const float*)x32, Hb, (const float*)nw, mod_l, ch_sh, ch_sc, (bf16*)(ws + WS_A1), mode == 0 ? 0 : RC, lds, tid, gw, NGW, lane);
}
NOINL void f_final(int wave_in, gws ws, gcf nw, GAS float* out) { PH_IDS; PH_GW; U(ws); U(nw); U(out); ph_final((const bf16*)(ws + WS_H), (const float*)nw, (float*)out, gw, NGW, lane); }
NOINL void f_post_win(int wave_in, gws ws, LAS unsigned char* lds) { PH_IDS; U(ws); U(lds); VM_WAIT(); __syncthreads();
    pg8::StaticOrder S; S.init(RALL, EV_IN, G, wg, DM); pg8::Unit u;
    for (int i = 0; S.next(i, u); ++i) { post_win_tile((unsigned char*)ws, lds, u.pm, u.pn, tid, wave, lane); } }
NOINL void f_ret_kv(int wave_in, gws ws, LAS unsigned char* lds, gcf dec) { PH_IDS; U(ws); U(lds); U(dec); for (int u = wg; u < 16 * NCH; u += G) ret_kv_unit((unsigned char*)ws, (const float*)dec, lds, tid, wave, lane, u); }
NOINL void f_ret_scan(int wave_in, gws ws, gcf dec) { PH_IDS; U(ws); U(dec); ph_ret_scan((unsigned char*)ws, (const float*)dec, tid, wg, G); }
NOINL void f_win(int wave_in, gws ws, LAS unsigned char* lds, gcf sink) { PH_IDS; U(ws); U(lds); U(sink); ph_win((unsigned char*)ws, (const float*)sink, lds, tid, wave, lane, wg, G); }
NOINL void f_ret_out(int wave_in, gws ws, LAS unsigned char* lds, gcf dec, gcf gnw) { PH_IDS; U(ws); U(lds); U(dec); U(gnw); ph_ret_out((unsigned char*)ws, (const float*)dec, (const float*)gnw, lds, tid, wave, lane, wg, G); }
NOINL void f_prep_odd(int wave_in, gws ws, LAS unsigned char* lds, gcf convw, gcf qnw, gcf kvnw, int jl) { PH_IDS; U(ws); U(lds); U(convw); U(qnw); U(kvnw); U(jl); ph_prep_odd((unsigned char*)ws, lds, (const float*)convw, (const float*)qnw, (const float*)kvnw, jl, tid, wave, lane, wg, G); }
NOINL void f_rope_kr(int wave_in, gws ws) { PH_IDS; U(ws); ph_rope_kr((unsigned char*)ws, tid, wg, G); }
NOINL void f_post_q(int wave_in, gws ws) { PH_IDS; U(ws); VM_WAIT(); __syncthreads();
    pg8::StaticOrder S; S.init(RALL, 1536, G, wg, 512); pg8::Unit u; for (int i = 0; S.next(i, u); ++i) post_q_tile((unsigned char*)ws, u.pm, u.pn, tid); }
NOINL void f_post_v(int wave_in, gws ws, LAS unsigned char* lds) { PH_IDS; U(ws); U(lds); VM_WAIT(); __syncthreads();
    pg8::Unit u;
    { pg8::StaticOrder S; S.init(RC, 2048, G, ((wg - 204) % G + G) % G, 256); for (int i = 0; S.next(i, u); ++i) post_v_tile((unsigned char*)ws, lds, u.pm, u.pn, 0, wave, lane); }
    { pg8::StaticOrder S; S.init(RALL - RC, 2048, G, wg, 256); for (int i = 0; S.next(i, u); ++i) post_v_tile((unsigned char*)ws, lds, u.pm >> 4, u.pn, 4 + (u.pm & 15) * 4, wave, lane); }
}
NOINL void f_mla(int wave_in, gws ws, LAS unsigned char* lds, int nunits) { PH_IDS; U(ws); U(lds); U(nunits); ph_mix_odd((unsigned char*)ws, lds, nunits, tid, wave, lane, wg, G); }
template <int ACT> NOINL void f_gemm_act(int wave_in, LAS unsigned char* lds, gcb A, gcb Bt, GAS unsigned short* O, int M, int N, int K, int ldc, int wg_shift = 0) {
    PH_IDS; U(lds); U(A); U(Bt); U(O); U(M); U(N); U(K); U(ldc); U(wg_shift); OPQ(M); OPQ(N); OPQ(K); OPQ(ldc);
    pg8::Gemm g{(const pg8::bf16_t*)A, (const pg8::bf16_t*)Bt, M, N, K}; pg8::StaticOrder S; S.init(M, N, G, ((wg - wg_shift) % G + G) % G, K);
    pg8::EpiAct<ACT> E{(pg8::bf16_t*)O, ldc};
    pg8::gemm_phase<pg8::EpiAct<ACT>, pg8::StaticOrder, PG8_ALIGN, PG8_SP2>((PG8_LAS unsigned char*)lds, g, S, E, wave);
}
NOINL void f_gemm_res(int wave_in, LAS unsigned char* lds, gcb A, gcb Bt, GAS unsigned short* Hp, gcf x32, gcf gate0, GAS unsigned short* part, int M, int N, int K, int S) {
    PH_IDS; U(lds); U(A); U(Bt); U(Hp); U(x32); U(gate0); U(part); U(M); U(N); U(K); U(S); OPQ(M); OPQ(N); OPQ(K); OPQ(S);
    pg8::Gemm g{(const pg8::bf16_t*)A, (const pg8::bf16_t*)Bt, M, N, K}; pg8::ResOrder S_; S_.init(M, N, K, S, G, wg);
    pg8::EpiResGate E{(pg8::bf16_t*)Hp, N, (const float*)gate0, 6 * DM, (pg8::bf16_t*)part, (const float*)x32};
    pg8::gemm_phase<pg8::EpiResGate, pg8::ResOrder, PG8_ALIGN, PG8_SP2>((PG8_LAS unsigned char*)lds, g, S_, E, wave);
}

constexpr int PH_END = 50;
#ifndef MK_PER_PHASE
#define MK_PER_PHASE 0
#endif
__global__ void __launch_bounds__(NTHR, 2) mk_fwd(Args a) {
    extern __shared__ __attribute__((aligned(16))) unsigned char lds_raw[];
    LAS unsigned char* lds = (LAS unsigned char*)lds_raw;
    const int tid = threadIdx.x;
    const int wv = __builtin_amdgcn_readfirstlane(tid >> 6);
    gws ws = (gws)a.ws;
    volatile LAS unsigned* MISC = (volatile LAS unsigned*)(lds + MISC_OFF);
    for (int u = tid; u < (LDS_BYTES - MISC_OFF) / 4; u += NTHR) ((LAS unsigned*)(lds + MISC_OFF))[u] = 0u;
    __syncthreads();
    const int lo = a.ph_lo, hi = a.ph_hi;
    XcdBarrier bar; bar.bar = (unsigned*)(a.ws + WS_CTL) + CW_BAR; bar.x = 0; bar.st = MISC + 8;
    if (hi - lo > 1) bar = xcd_barrier_post((unsigned*)(a.ws + WS_CTL) + CW_BAR, MISC + 8);
#define IN(k) (lo <= (k) && (k) < hi)
#define SEAM(k) do { if ((k) + 1 < hi) xcd_barrier(bar); } while (0)

    if (IN(0)) { f_prologue(wv, ws, lds, (gcf)a.x, (gcf)a.c, (gcf)a.ctx, (gcf)a.c_ctx, (gcf)a.w_mod, (gcf)a.b_mod, (gcf)a.mlp_w1, (gcf)a.mlp_w2, (gcf)a.ev_w_in, (gcf)a.ev_w_out, (gcf)a.od_w_in, (gcf)a.od_w_out, (gcf)a.od_w_uq, (gcf)a.od_w_ukv);


        SEAM(0); }

#pragma nounroll
    for (int l = 0; l < DEPTH; ++l) {
        const int j = l >> 1, pb = 1 + 12 * l;
        const int row_off = (l == DEPTH - 1) ? RC : 0, Mr = RALL - row_off;
        if (IN(pb + 0)) { f_norm(wv, ws, lds, (gcf)(a.norm1_w + l * DM), (gcf)a.ctx, (gcf)a.x, l, 0, 1, l == 0 ? 0 : 1); SEAM(pb + 0); }
        if (!(l & 1)) {
            if (IN(pb + 1)) { f_gemm_act<0>(wv, lds, (gcb)(ws + WS_A1), (gcb)(ws + WS_EWIN) + (size_t)j * EV_IN * DM, (GAS unsigned short*)(ws + WS_PRJ), RALL, EV_IN, DM, EV_IN);
                f_post_win(wv, ws, lds);
                SEAM(pb + 1); }
            if (IN(pb + 2)) { f_ret_kv(wv, ws, lds, (gcf)(a.ev_decay + j * 16)); SEAM(pb + 2); }
            if (IN(pb + 4)) { f_ret_scan(wv, ws, (gcf)(a.ev_decay + j * 16)); SEAM(pb + 4); }
            if (IN(pb + 5)) { f_win(wv, ws, lds, (gcf)(a.ev_sink + j * 8)); __syncthreads(); f_ret_out(wv, ws, lds, (gcf)(a.ev_decay + j * 16), (gcf)(a.ev_gn_w + j * 1024));


                SEAM(pb + 5); }
        } else {
            if (IN(pb + 1)) { f_gemm_act<0>(wv, lds, (gcb)(ws + WS_A1), (gcb)(ws + WS_OWIN) + (size_t)j * OD_INP * DM, (GAS unsigned short*)(ws + WS_PRJ), RALL, OD_INP, DM, OD_INP);
                SEAM(pb + 1); }
            if (IN(pb + 2)) { f_prep_odd(wv, ws, lds, (gcf)(a.od_conv_w + j * 3 * 1024), (gcf)(a.od_qn_w + j * 512), (gcf)(a.od_kvn_w + j * 256), j); SEAM(pb + 2); }
            if (IN(pb + 3)) {
                f_rope_kr(wv, ws);
                f_gemm_act<0>(wv, lds, (gcb)(ws + WS_CQN), (gcb)(ws + WS_UQT) + (size_t)j * 1536 * 512, (GAS unsigned short*)(ws + WS_QRAW), RALL, 1536, 512, 1536);
                f_post_q(wv, ws);
                __syncthreads();
                f_gemm_act<0>(wv, lds, (gcb)(ws + WS_CKVN), (gcb)(ws + WS_UKVT) + (size_t)j * 2048 * 256, (GAS unsigned short*)(ws + WS_KVRAW), RC, 2048, 256, 2048, 204);
                __syncthreads();
                f_gemm_act<0>(wv, lds, (gcb)(ws + WS_CKVN) + (size_t)RC * 256, (gcb)(ws + WS_UKVT) + (size_t)j * 2048 * 256, (GAS unsigned short*)(ws + WS_KVRAW) + (size_t)RC * 2048, RALL - RC, 2048, 256, 2048);
                f_post_v(wv, ws, lds);
                SEAM(pb + 3); }
            if (IN(pb + 6)) { f_mla(wv, ws, lds, row_off ? 256 : 272); SEAM(pb + 6); }
        }
        if (IN(pb + 7)) { gcb wo = (l & 1) ? (gcb)(ws + WS_OWOUT) + (size_t)j * DM * DM : (gcb)(ws + WS_EWOUT) + (size_t)j * DM * DM;
            f_gemm_res(wv, lds, (gcb)(ws + WS_MIX), wo, (GAS unsigned short*)(ws + WS_H), l == 0 ? (gcf)a.x : (gcf)nullptr, (gcf)(ws + WS_MOD) + (size_t)l * 3 * 12288 + 2 * DM, (GAS unsigned short*)(ws + WS_PARTO), RALL, DM, DM, row_off ? 0 : S_OUT);
            SEAM(pb + 7); }
        if (IN(pb + 8)) { f_norm(wv, ws, lds, (gcf)(a.norm2_w + l * DM), (gcf)a.ctx, (gcf)a.x, l, 3, 4, row_off ? 3 : 2); SEAM(pb + 8); }
        if (IN(pb + 9)) { f_gemm_act<1>(wv, lds, (gcb)(ws + WS_A1) + (size_t)row_off * DM, (gcb)(ws + WS_W1T) + (size_t)l * DFF * DM, (GAS unsigned short*)(ws + WS_HID) + (size_t)row_off * DFF, Mr, DFF, DM, DFF);

            SEAM(pb + 9); }
        if (IN(pb + 10)) { f_gemm_res(wv, lds, (gcb)(ws + WS_HID), (gcb)(ws + WS_W2T) + (size_t)l * DM * DFF, (GAS unsigned short*)(ws + WS_H), (gcf)nullptr, (gcf)(ws + WS_MOD) + (size_t)l * 3 * 12288 + 5 * DM, (GAS unsigned short*)(ws + WS_PARTM), RALL, DM, DFF, row_off ? 0 : S_MLP);
            SEAM(pb + 10); }
    }
    if (IN(49)) f_final(wv, ws, (gcf)a.norm_f, (GAS float*)a.out);
#undef IN
#undef SEAM
}

extern "C" void kernel_launch(void* const* d_in, const int* in_sizes, int n_in, void* d_out, int out_size, void* d_ws, size_t ws_size, hipStream_t stream) {
    static int grid = 0;
    if (grid == 0) {
        if (n_in != 23 || out_size != NB * TL * DM || ws_size < WS_END) { fprintf(stderr, "kernel_launch: unexpected shapes (n_in %d, out %d, ws %zu); nothing launched\n", n_in, out_size, ws_size); grid = -1; return; }
        int dev = 0, cus = 0, per_cu = 0;
        if (hipGetDevice(&dev) != hipSuccess || hipDeviceGetAttribute(&cus, hipDeviceAttributeMultiprocessorCount, dev) != hipSuccess) { grid = -1; return; }
        if (hipFuncSetAttribute((const void*)mk_fwd, hipFuncAttributeMaxDynamicSharedMemorySize, LDS_BYTES) != hipSuccess) { fprintf(stderr, "kernel_launch: hipFuncSetAttribute failed\n"); grid = -1; return; }
        if (hipOccupancyMaxActiveBlocksPerMultiprocessor(&per_cu, (const void*)mk_fwd, NTHR, LDS_BYTES) != hipSuccess || per_cu < 1) { fprintf(stderr, "kernel_launch: occupancy query reports %d blocks per CU; nothing launched\n", per_cu); grid = -1; (void)hipGetLastError(); return; }
        grid = cus;
    }
    if (grid < 0) return;
    if (hipMemsetAsync((char*)d_ws + WS_CTL, 0, CTL_ZERO_BYTES, stream) != hipSuccess) return;
    Args a{};
    const float** ap = (const float**)&a;
    for (int i = 0; i < 23; ++i) ap[i] = (const float*)d_in[i];
    a.out = (float*)d_out; a.ws = (unsigned char*)d_ws;
#if MK_PER_PHASE
    for (int p = 0; p < PH_END; ++p) { a.ph_lo = p; a.ph_hi = p + 1; hipLaunchKernelGGL(mk_fwd, dim3(grid), dim3(NTHR), LDS_BYTES, stream, a); }
#else
    a.ph_lo = 0; a.ph_hi = PH_END;
    hipLaunchKernelGGL(mk_fwd, dim3(grid), dim3(NTHR), LDS_BYTES, stream, a);
#endif
    const hipError_t le = hipPeekAtLastError();
    if (le != hipSuccess) fprintf(stderr, "kernel_launch: launch failed: %s\n", hipGetErrorName(le));
}
```

```cpp
#include <hip/hip_runtime.h>
#include <cstdio>
#include <cstdint>
#define MK_PER_PHASE 0
namespace pg8 {
#define PG8_LAS __attribute__((address_space(3)))
typedef unsigned short bf16_t;
typedef short bf16x8 __attribute__((ext_vector_type(8)));
typedef float f32x4 __attribute__((ext_vector_type(4)));
typedef unsigned u32x4 __attribute__((ext_vector_type(4)));
constexpr int BM = 256, BK = 64, HALF = 128, HTB = HALF * BK * 2  , STAGE_BYTES = 8 * HTB, NXCD = 8, WGM = 4;

__host__ __device__ __forceinline__ int lds_byte(int r, int c) { const int st = (r >> 4) * 2 + (c >> 5), rr = r & 15, cc = c & 31, ob = rr * 64 + cc * 2; return st * 1024 + (ob ^ (((ob >> 9) & 1) << 5)); }
__host__ __device__ __forceinline__ void stage_rc(int b, int& R, int& C) { const int st = b / 1024, sb = b % 1024, swz = sb ^ (((sb >> 9) & 1) << 5); R = (st >> 1) * 16 + swz / 64; C = (st & 1) * 32 + (swz % 64) / 2; }
__host__ __device__ __forceinline__ int perm32(int rho) { const int n = rho >> 4, i = rho & 15; return 8 * (i >> 2) + 4 * n + (i & 3); }

struct Unit { int pm, pn, ks, nt, koff; };
struct Gemm { const bf16_t* A; const bf16_t* Bt; int M, N, K; };

struct StaticOrder {
    int nM, nN, nwg, G, c, ntK;
    __host__ __device__ void init(int M, int N, int G_, int c_, int K_) { nM = M / BM; nN = N / BM; nwg = nM * nN; G = G_; c = c_; ntK = K_ / BK; }
    __host__ __device__ bool next(int i, Unit& u) const {
        const long L = (long)i * G + c; if (L >= nwg) return false;
        int wgid = (int)L; { const int q = nwg / NXCD, r = nwg % NXCD, xcd = wgid % NXCD, off = wgid / NXCD; wgid = (xcd < r ? xcd * (q + 1) : r * (q + 1) + (xcd - r) * q) + off; }
        const int nig = WGM * nN, gid = wgid / nig, fm = gid * WGM, gsz = (nM - fm) < WGM ? (nM - fm) : WGM;
        u.pm = fm + ((wgid % nig) % gsz); u.pn = (wgid % nig) / gsz; u.ks = -1; u.nt = ntK; u.koff = 0; return true;
    }
    __device__ __forceinline__ void a_ready(const Unit&) const {}
    __device__ __forceinline__ void done(const Unit&) const {}
};

__device__ __forceinline__ unsigned cvt_pk_bf16(float lo, float hi) { unsigned r; asm volatile("v_cvt_pk_bf16_f32 %0, %1, %2" : "=v"(r) : "v"(lo), "v"(hi)); return r; }
typedef float f32x2 __attribute__((ext_vector_type(2)));
__device__ __forceinline__ f32x2 gelu_pk(f32x2 v) {
    const f32x2 av = __builtin_elementwise_abs(v), d = av * 0.2316418882f + 1.0f;
    f32x2 t; t.x = __builtin_amdgcn_rcpf(d.x); t.y = __builtin_amdgcn_rcpf(d.y);
    f32x2 q = t * 0.5307027145f + (-0.7265760135f); q = q * t + 0.7107068705f; q = q * t + (-0.142248368f); q = q * t + 0.127414796f; q = q * t;
    const f32x2 s = (v * v) * (-0.72134752044f);
    f32x2 e; e.x = __builtin_amdgcn_exp2f(s.x); e.y = __builtin_amdgcn_exp2f(s.y);
    const f32x2 m = v * (q * e), r = v - m;
    f32x2 o; o.x = v.x < 0.f ? m.x : r.x; o.y = v.y < 0.f ? m.y : r.y; return o;
}


template <int ACT> struct EpiAct {
    static constexpr bool PERM = true, AFTER_DRAIN = false;
    bf16_t* O; int ldc;
    __device__ __forceinline__ void operator()(const f32x4 (&acc)[2][2][4][2], const Unit& u, int wr, int wc, int fr, int fq) const {
        const int row0 = u.pm * BM + wr * 64 + fr, col0 = u.pn * BM + wc * 32 + 8 * fq;
#pragma unroll
        for (int ai = 0; ai < 2; ++ai)
#pragma unroll
            for (int m = 0; m < 4; ++m) { bf16_t* rowp = O + (size_t)(row0 + ai * HALF + m * 16) * ldc + col0;
#pragma unroll
                for (int bj = 0; bj < 2; ++bj) { f32x4 v0 = acc[ai][bj][m][0], v1 = acc[ai][bj][m][1];
                    if (ACT == 1) {
#pragma unroll
                        for (int e = 0; e < 4; ++e) { const float a = fmaxf(v0[e], 0.f), b = fmaxf(v1[e], 0.f); v0[e] = a * a; v1[e] = b * b; } }
                    u32x4 w; w.x = cvt_pk_bf16(v0[0], v0[1]); w.y = cvt_pk_bf16(v0[2], v0[3]); w.z = cvt_pk_bf16(v1[0], v1[1]); w.w = cvt_pk_bf16(v1[2], v1[3]);
                    *(u32x4*)(rowp + bj * HALF) = w; } }
    }
};
struct EpiResGate {
    static constexpr bool PERM = true, AFTER_DRAIN = false;
    bf16_t* H; int ldc; const float* gate0; int set_stride; bf16_t* part; const float* Hx32;
    __device__ __forceinline__ void operator()(const f32x4 (&acc)[2][2][4][2], const Unit& u, int wr, int wc, int fr, int fq) const {
        const int row0 = u.pm * BM + wr * 64 + fr, col0 = u.pn * BM + wc * 32 + 8 * fq;
        if (u.ks >= 0) {
            bf16_t* P = part + (size_t)u.ks * 512 * ldc;
#pragma unroll
            for (int ai = 0; ai < 2; ++ai)
#pragma unroll
                for (int m = 0; m < 4; ++m) { bf16_t* rowp = P + (size_t)(row0 + ai * HALF + m * 16) * ldc + col0;
#pragma unroll
                    for (int bj = 0; bj < 2; ++bj) { const f32x4 v0 = acc[ai][bj][m][0], v1 = acc[ai][bj][m][1];
                        u32x4 o; o.x = cvt_pk_bf16(v0[0], v0[1]); o.y = cvt_pk_bf16(v0[2], v0[3]); o.z = cvt_pk_bf16(v1[0], v1[1]); o.w = cvt_pk_bf16(v1[2], v1[3]);
                        *(u32x4*)(rowp + bj * HALF) = o; } }
            return; }
        const int grow = u.pm * BM; const int set = grow < 512 ? 2 : ((grow - 512) >> 12);
        const float* g = gate0 + (size_t)set * set_stride + col0;
        f32x4 gv[2][2];
#pragma unroll
        for (int bj = 0; bj < 2; ++bj) { gv[bj][0] = *(const f32x4*)(g + bj * HALF); gv[bj][1] = *(const f32x4*)(g + bj * HALF + 4); }
        if (Hx32) {
#pragma unroll
            for (int ai = 0; ai < 2; ++ai) { f32x4 hx[4][2][2];
#pragma unroll
                for (int m = 0; m < 4; ++m)
#pragma unroll
                    for (int bj = 0; bj < 2; ++bj) { const float* ps = Hx32 + (size_t)(row0 + ai * HALF + m * 16) * ldc + col0 - (size_t)512 * ldc + bj * HALF; hx[m][bj][0] = *(const f32x4*)ps; hx[m][bj][1] = *(const f32x4*)(ps + 4); }
#pragma unroll
                for (int m = 0; m < 4; ++m)
#pragma unroll
                    for (int bj = 0; bj < 2; ++bj) { const f32x4 v0 = hx[m][bj][0] + gv[bj][0] * acc[ai][bj][m][0], v1 = hx[m][bj][1] + gv[bj][1] * acc[ai][bj][m][1];
                        u32x4 o; o.x = cvt_pk_bf16(v0[0], v0[1]); o.y = cvt_pk_bf16(v0[2], v0[3]); o.z = cvt_pk_bf16(v1[0], v1[1]); o.w = cvt_pk_bf16(v1[2], v1[3]);
                        *(u32x4*)(H + (size_t)(row0 + ai * HALF + m * 16) * ldc + col0 + bj * HALF) = o; } }
        } else {
#pragma unroll
            for (int ai = 0; ai < 2; ++ai) { u32x4 hw[4][2];
#pragma unroll
                for (int m = 0; m < 4; ++m)
#pragma unroll
                    for (int bj = 0; bj < 2; ++bj) hw[m][bj] = *(const u32x4*)(H + (size_t)(row0 + ai * HALF + m * 16) * ldc + col0 + bj * HALF);
#pragma unroll
                for (int m = 0; m < 4; ++m)
#pragma unroll
                    for (int bj = 0; bj < 2; ++bj) { const u32x4 w = hw[m][bj];
                        const f32x4 h0 = {__uint_as_float(w.x << 16), __uint_as_float(w.x & 0xffff0000u), __uint_as_float(w.y << 16), __uint_as_float(w.y & 0xffff0000u)};
                        const f32x4 h1 = {__uint_as_float(w.z << 16), __uint_as_float(w.z & 0xffff0000u), __uint_as_float(w.w << 16), __uint_as_float(w.w & 0xffff0000u)};
                        const f32x4 v0 = h0 + gv[bj][0] * acc[ai][bj][m][0], v1 = h1 + gv[bj][1] * acc[ai][bj][m][1];
                        u32x4 o; o.x = cvt_pk_bf16(v0[0], v0[1]); o.y = cvt_pk_bf16(v0[2], v0[3]); o.z = cvt_pk_bf16(v1[0], v1[1]); o.w = cvt_pk_bf16(v1[2], v1[3]);
                        *(u32x4*)(H + (size_t)(row0 + ai * HALF + m * 16) * ldc + col0 + bj * HALF) = o; } }
        }
    }
};

struct ResOrder {
    StaticOrder so; int nmain, nsplit, S, nN, ntc, G, c;
    __host__ __device__ void init(int M, int N, int K, int S_, int G_, int c_) { so.init(M - 512, N, G_, c_, K); nmain = so.nwg; S = S_; nN = N / BM; nsplit = 2 * nN * S_; ntc = S_ ? K / S_ / BK : 0; G = G_; c = c_; }
    __host__ __device__ bool next(int i, Unit& u) const {
        const long L = (long)i * G + c;
        if (L < nmain) { so.next(i, u); u.pm += 2; return true; }
        const int s = (int)(L - nmain); if (s >= nsplit) return false;
        u.ks = s % S; const int rest = s / S; u.pn = rest % nN; u.pm = rest / nN; u.nt = ntc; u.koff = u.ks * ntc * BK; return true;
    }
    __device__ __forceinline__ void a_ready(const Unit&) const {}
    __device__ __forceinline__ void done(const Unit&) const {}
};
template <class Epi, class Sched, bool ALIGN_EPI = false, bool SP2 = false>
__device__ __forceinline__ void gemm_phase(PG8_LAS unsigned char* lds, const Gemm g, const Sched& S, const Epi& E, int wave_in) {
    int lane_; asm volatile("v_mbcnt_lo_u32_b32 %0, -1, 0\n\tv_mbcnt_hi_u32_b32 %0, -1, %0" : "=v"(lane_));
    const int wid = wave_in, tid = wid * 64 + lane_, lane = tid & 63, wr = wid >> 2, wc = wid & 3, fr = lane & 15, fq = lane >> 4;
    const int K = g.K;
    unsigned voffA[2], voffB[2];
#pragma unroll
    for (int i = 0; i < 2; ++i) { int R, C; stage_rc(tid * 16 + i * 8192, R, C); const int Rb = Epi::PERM ? ((R & ~31) + perm32(R & 31)) : R;
        voffA[i] = (unsigned)(R * K + C) * 2u; voffB[i] = (unsigned)(Rb * K + C) * 2u; }
    const size_t kstep = (size_t)(BK * 2);
    const size_t hstep = (size_t)HALF * K * 2;
    const size_t tstep = 2 * hstep;
    const unsigned ldsw = (unsigned)wid * 1024u;
    const int aoff = lds_byte(wr * 64 + fr, fq * 8), boff = lds_byte(wc * 32 + fr, fq * 8);
#define PG8_SA(b, h) (((b) * 2 + (h)) * HTB)
#define PG8_SB(b, h) ((4 + (b) * 2 + (h)) * HTB)
#define PG8_STAGE(bufoff, gbase, voff) do { _Pragma("unroll") for (int _i = 0; _i < 2; ++_i) \
        __builtin_amdgcn_global_load_lds((const unsigned*)((const char*)(gbase) + (voff)[_i]), (PG8_LAS unsigned*)(lds + (bufoff) + ldsw + _i * 8192), 16, 0, 0); } while (0)
#define PG8_LDA(dst, b, h) do { _Pragma("unroll") for (int m = 0; m < 4; ++m) _Pragma("unroll") for (int k = 0; k < 2; ++k) dst[m][k] = *(const PG8_LAS bf16x8*)(lds + PG8_SA(b, h) + aoff + m * 2048 + k * 1024); } while (0)
#define PG8_LDB(dst, b, h) do { _Pragma("unroll") for (int n = 0; n < 2; ++n) _Pragma("unroll") for (int k = 0; k < 2; ++k) dst[n][k] = *(const PG8_LAS bf16x8*)(lds + PG8_SB(b, h) + boff + n * 2048 + k * 1024); } while (0)
#define PG8_MMA(ai, bj, At, Bt) do { __builtin_amdgcn_s_setprio(1); _Pragma("unroll") for (int m = 0; m < 4; ++m) _Pragma("unroll") for (int n = 0; n < 2; ++n) _Pragma("unroll") for (int k = 0; k < 2; ++k) \
        acc[ai][bj][m][n] = __builtin_amdgcn_mfma_f32_16x16x32_bf16(Bt[n][k], At[m][k], acc[ai][bj][m][n], 0, 0, 0); __builtin_amdgcn_s_setprio(0); } while (0)
#define PG8_WAIT_V(n) asm volatile("s_waitcnt vmcnt(" #n ")" ::: "memory")
#define PG8_WAIT_L(n) asm volatile("s_waitcnt lgkmcnt(" #n ")" ::: "memory")
#define PG8_BAR __builtin_amdgcn_s_barrier()
#define PG8_SCHED __builtin_amdgcn_sched_barrier(0)
    Unit cur, nxt; int ui = 0;
    if (!S.next(0, cur)) return;
    f32x4 acc[2][2][4][2];
#pragma unroll
    for (int a = 0; a < 2; ++a)
#pragma unroll
        for (int b = 0; b < 2; ++b)
#pragma unroll
            for (int m = 0; m < 4; ++m)
#pragma unroll
                for (int n = 0; n < 2; ++n) acc[a][b][m][n] = (f32x4){0.f, 0.f, 0.f, 0.f};
    bf16x8 At[4][2], B0[2][2], B1[2][2];
    const char* cA = (const char*)g.A + (size_t)cur.pm * tstep + (size_t)cur.koff * 2; const char* cB = (const char*)g.Bt + (size_t)cur.pn * tstep + (size_t)cur.koff * 2;
    int nt = cur.nt;
    S.a_ready(cur);
    if constexpr (SP2) {
        PG8_STAGE(PG8_SB(0, 0), cB, voffB); PG8_STAGE(PG8_SB(0, 1), cB + hstep, voffB); PG8_STAGE(PG8_SA(0, 0), cA, voffA); PG8_STAGE(PG8_SA(0, 1), cA + hstep, voffA);
        if (wr == 1) PG8_BAR;
        PG8_WAIT_V(2); PG8_BAR;
        PG8_STAGE(PG8_SB(1, 0), cB + kstep, voffB); PG8_STAGE(PG8_SA(1, 0), cA + kstep, voffA); PG8_STAGE(PG8_SB(1, 1), cB + hstep + kstep, voffB);
        PG8_WAIT_V(6); PG8_BAR;
    } else {
        PG8_STAGE(PG8_SB(0, 0), cB, voffB); PG8_STAGE(PG8_SA(0, 0), cA, voffA); PG8_STAGE(PG8_SB(0, 1), cB + hstep, voffB); PG8_STAGE(PG8_SA(0, 1), cA + hstep, voffA);
        if (wr == 1) PG8_BAR;
        PG8_WAIT_V(4); PG8_BAR;
        PG8_STAGE(PG8_SB(1, 0), cB + kstep, voffB); PG8_STAGE(PG8_SA(1, 0), cA + kstep, voffA); PG8_STAGE(PG8_SB(1, 1), cB + hstep + kstep, voffB);
        PG8_WAIT_V(6); PG8_BAR;
    }
    for (;;) {
        const bool has_next = S.next(ui + 1, nxt);
        const char* nA = has_next ? (const char*)g.A + (size_t)nxt.pm * tstep + (size_t)nxt.koff * 2 : cA; const char* nB = has_next ? (const char*)g.Bt + (size_t)nxt.pn * tstep + (size_t)nxt.koff * 2 : cB;
        asm volatile(".p2align 8" ::: "memory");
        for (int t = 0; t < nt; t += 2) {
            const bool last = (t == nt - 2);
            const char* a1 = cA + (size_t)(t + 1) * kstep;
            const char* a2 = last ? nA : cA + (size_t)(t + 2) * kstep; const char* b2 = last ? nB : cB + (size_t)(t + 2) * kstep;
            const char* a3 = a2 + kstep; const char* b3 = b2 + kstep;
            if (last && has_next) S.a_ready(nxt);
            if constexpr (SP2) {
            PG8_LDB(B0, 0, 0); PG8_LDB(B1, 0, 1); PG8_SCHED; PG8_LDA(At, 0, 0); PG8_STAGE(PG8_SA(1, 1), a1 + hstep, voffA);
            PG8_WAIT_V(8); PG8_WAIT_L(0); PG8_BAR; PG8_MMA(0, 0, At, B0); PG8_MMA(0, 1, At, B1); PG8_BAR; PG8_SCHED;
            PG8_LDA(At, 0, 1); PG8_STAGE(PG8_SB(0, 0), b2, voffB); PG8_STAGE(PG8_SB(0, 1), b2 + hstep, voffB); PG8_STAGE(PG8_SA(0, 0), a2, voffA);
            PG8_WAIT_V(8); PG8_WAIT_L(0); PG8_BAR; PG8_MMA(1, 0, At, B0); PG8_MMA(1, 1, At, B1); PG8_BAR; PG8_SCHED;
            PG8_LDB(B0, 1, 0); PG8_LDB(B1, 1, 1); PG8_SCHED; PG8_LDA(At, 1, 0); PG8_STAGE(PG8_SA(0, 1), a2 + hstep, voffA);
            PG8_WAIT_V(8); PG8_WAIT_L(0); PG8_BAR; PG8_MMA(0, 0, At, B0); PG8_MMA(0, 1, At, B1); PG8_BAR; PG8_SCHED;
            PG8_LDA(At, 1, 1); PG8_STAGE(PG8_SB(1, 0), b3, voffB); PG8_STAGE(PG8_SB(1, 1), b3 + hstep, voffB); PG8_STAGE(PG8_SA(1, 0), a3, voffA);
            PG8_WAIT_V(8); PG8_WAIT_L(0); PG8_BAR; PG8_MMA(1, 0, At, B0); PG8_MMA(1, 1, At, B1); PG8_BAR; PG8_SCHED;
            } else {
            PG8_LDB(B0, 0, 0); PG8_SCHED; PG8_LDA(At, 0, 0); PG8_STAGE(PG8_SA(1, 1), a1 + hstep, voffA);
            PG8_WAIT_L(8); PG8_BAR; PG8_WAIT_L(0); PG8_MMA(0, 0, At, B0); PG8_BAR; PG8_SCHED;
            PG8_LDB(B1, 0, 1); PG8_STAGE(PG8_SB(0, 0), b2, voffB);
            PG8_BAR; PG8_WAIT_L(0); PG8_MMA(0, 1, At, B1); PG8_BAR;
            PG8_LDA(At, 0, 1); PG8_STAGE(PG8_SA(0, 0), a2, voffA);
            PG8_BAR; PG8_WAIT_L(0); PG8_MMA(1, 0, At, B0); PG8_BAR; PG8_SCHED;
            PG8_STAGE(PG8_SB(0, 1), b2 + hstep, voffB);
            PG8_WAIT_V(6); PG8_BAR; PG8_MMA(1, 1, At, B1); PG8_BAR;
            PG8_LDB(B0, 1, 0); PG8_SCHED; PG8_LDA(At, 1, 0); PG8_STAGE(PG8_SA(0, 1), a2 + hstep, voffA);
            PG8_WAIT_L(8); PG8_BAR; PG8_WAIT_L(0); PG8_MMA(0, 0, At, B0); PG8_BAR; PG8_SCHED;
            PG8_LDB(B1, 1, 1); PG8_STAGE(PG8_SB(1, 0), b3, voffB);
            PG8_BAR; PG8_WAIT_L(0); PG8_MMA(0, 1, At, B1); PG8_BAR;
            PG8_LDA(At, 1, 1); PG8_STAGE(PG8_SA(1, 0), a3, voffA);
            PG8_BAR; PG8_WAIT_L(0); PG8_MMA(1, 0, At, B0); PG8_BAR; PG8_SCHED;
            PG8_STAGE(PG8_SB(1, 1), b3 + hstep, voffB);
            PG8_WAIT_V(6); PG8_BAR; PG8_MMA(1, 1, At, B1); PG8_BAR;
            }
        }
        if constexpr (ALIGN_EPI) { if (wr == 0) PG8_BAR; }
        if constexpr (!Epi::AFTER_DRAIN) { E(acc, cur, wr, wc, fr, fq); S.done(cur); }
        if (!has_next) break;
#pragma unroll
        for (int a = 0; a < 2; ++a)
#pragma unroll
            for (int b = 0; b < 2; ++b)
#pragma unroll
                for (int m = 0; m < 4; ++m)
#pragma unroll
                    for (int n = 0; n < 2; ++n) acc[a][b][m][n] = (f32x4){0.f, 0.f, 0.f, 0.f};
        cur = nxt; cA = nA; cB = nB; ++ui; nt = cur.nt;
        if constexpr (ALIGN_EPI) { if (wr == 1) PG8_BAR; }
    }
    PG8_WAIT_V(0);
    if constexpr (!ALIGN_EPI) { if (wr == 0) PG8_BAR; }
    PG8_BAR;
    if constexpr (Epi::AFTER_DRAIN) { E.fused(acc, cur, wr, wc, fr, fq, lds, wid, lane); S.done(cur); }
#undef PG8_SA
#undef PG8_SB
#undef PG8_STAGE
#undef PG8_LDA
#undef PG8_LDB
#undef PG8_MMA
#undef PG8_WAIT_V
#undef PG8_WAIT_L
#undef PG8_BAR
#undef PG8_SCHED
}
}

#ifndef PG8_SP2
#define PG8_SP2 true
#endif
#ifndef PG8_ALIGN
#define PG8_ALIGN true
#endif

constexpr int DM = 2048, NB = 2, TL = 4096, TC = 256, DEPTH = 4, DFF = 8192;
constexpr int RC = NB * TC;
constexpr int RALL = RC + NB * TL;
constexpr int NKEY = TC + TL;
constexpr int EV_IN = 5632, OD_IN = 3904, OD_INP = 3840;
constexpr int E_QR = 0, E_KR = 1024, E_VR = 2048, E_GR = 3072, E_QW = 4096, E_KW = 5120, E_VW = 5376;
constexpr int O_BG = 0, O_CG = 1024, O_XV = 2048, O_CQ = 3072, O_CKV = 3584, O_KR = 3840;
constexpr int NCH = 34;
constexpr float EPS = 1e-6f;
constexpr float LOG2E = 1.4426950408889634f;

constexpr size_t MiB = 1u << 20;
constexpr size_t WS_CTL = 0, CTL_ZERO_BYTES = 1 * MiB;
constexpr size_t WS_MOD = 1 * MiB;
constexpr size_t WS_T1C = 2 * MiB, WS_T1S = 3 * MiB;
constexpr size_t WS_T2 = 4 * MiB;
constexpr size_t WS_W1T = 8 * MiB, WS_W2T = 136 * MiB, WS_EWIN = 264 * MiB, WS_EWOUT = 308 * MiB, WS_OWIN = 324 * MiB, WS_OWOUT = 356 * MiB, WS_UQT = 372 * MiB, WS_UKVT = 375 * MiB;
constexpr size_t WS_H = 384 * MiB, WS_A1 = 452 * MiB, WS_PRJ = 486 * MiB, WS_MIX = 580 * MiB, WS_HID = 614 * MiB, WS_KVST = 750 * MiB, WS_ST = 818 * MiB;
constexpr size_t WS_VTW = 852 * MiB, WS_VTM = 857 * MiB, WS_CQN = 874 * MiB, WS_CKVN = 883 * MiB, WS_QRAW = 888 * MiB, WS_KVRAW = 914 * MiB, WS_PARTO = 948 * MiB, WS_PARTM = 980 * MiB, WS_WKRT = 1044 * MiB, WS_KR = 1045 * MiB, WS_END = 1047 * MiB;
constexpr int S_OUT = 4, S_MLP = 8;
constexpr int CW_BAR = 4096;

constexpr int LDS_BYTES = 147456;
constexpr int MISC_OFF = 143360;
constexpr int NWAVES = 8, NTHR = 512;

#define GAS __attribute__((address_space(1)))
#define LAS __attribute__((address_space(3)))
typedef unsigned short bf16;
typedef unsigned v4u __attribute__((ext_vector_type(4)));
typedef unsigned v2u __attribute__((ext_vector_type(2)));
typedef float f32x4 __attribute__((ext_vector_type(4)));
typedef float f32x16 __attribute__((ext_vector_type(16)));
typedef short bf16x8 __attribute__((ext_vector_type(8)));
#define LDS_WAIT() asm volatile("s_waitcnt lgkmcnt(0)" ::: "memory")
#define VM_WAIT() asm volatile("s_waitcnt vmcnt(0)" ::: "memory")

__device__ __forceinline__ unsigned pk2(float lo, float hi) { unsigned r; asm volatile("v_cvt_pk_bf16_f32 %0, %1, %2" : "=v"(r) : "v"(lo), "v"(hi)); return r; }
__device__ __forceinline__ float bflo(unsigned w) { return __uint_as_float(w << 16); }
__device__ __forceinline__ float bfhi(unsigned w) { return __uint_as_float(w & 0xffff0000u); }
__device__ __forceinline__ float bf2f(unsigned short b) { return __uint_as_float(((unsigned)b) << 16); }
__device__ __forceinline__ unsigned short f2bf(float f) { return (unsigned short)(pk2(f, 0.f) & 0xffffu); }
__device__ __forceinline__ float wave_sum(float v) {
#pragma unroll
    for (int o = 1; o < 64; o <<= 1) v += __shfl_xor(v, o);
    return v;
}
__device__ __forceinline__ float fexp2(float x) { return __builtin_amdgcn_exp2f(x); }
__device__ __forceinline__ int row_set(int r) { return r < RC ? 2 : ((r - RC) >> 12); }

#define XB_TMO      128
#define XB_XCNT(j)  (256  + 64 * (j))
#define XB_XSUB(j)  (1280 + 64 * (j))
#define XB_XGEN(j)  (2304 + 64 * (j))
#define XB_TOP      3328
#define XB_TOPGEN   3392
#define XCD_BAR_WORDS 3456
#define XB_SPIN_CAP (1u << 18)

__device__ __forceinline__ unsigned xb_ld(unsigned* p)              { return __hip_atomic_load(p, __ATOMIC_RELAXED, __HIP_MEMORY_SCOPE_AGENT); }
__device__ __forceinline__ unsigned xb_add(unsigned* p, unsigned v) { return __hip_atomic_fetch_add(p, v, __ATOMIC_RELAXED, __HIP_MEMORY_SCOPE_AGENT); }
__device__ __forceinline__ unsigned xb_xcc_id() { return (unsigned)__builtin_amdgcn_s_getreg((3 << 11) | 20) & 0xFu; }
#define XB_SPIN(cond, bar) do { unsigned _sp = 0; while (cond) { __builtin_amdgcn_s_sleep(1); \
    if ((++_sp & 255u) == 0u) { if (xb_ld(&(bar)[XB_TMO])) break; if (_sp > XB_SPIN_CAP) { atomicAdd(&(bar)[XB_TMO], 1u); break; } } } } while (0)

struct XcdBarrier {
    unsigned* bar; unsigned x;
    volatile LAS unsigned* st;
};

__device__ __forceinline__ XcdBarrier xcd_barrier_post(unsigned* bar, volatile LAS unsigned* st) {
    XcdBarrier b; b.bar = bar; b.x = xb_xcc_id(); b.st = st;
    if (threadIdx.x == 0) (void)xb_add(&bar[XB_XCNT(b.x)], 1u);
    return b;
}
__device__ __forceinline__ void xcd_barrier_complete(unsigned* bar, unsigned x, unsigned& nloc, unsigned& nx) {
    const unsigned G = gridDim.x * gridDim.y * gridDim.z;
    unsigned sum, cnt, mine, sp = 0u;
    for (;;) {
        sum = 0u; cnt = 0u; mine = 0u;
#pragma unroll
        for (unsigned j = 0; j < 16; ++j) { const unsigned c = xb_ld(&bar[XB_XCNT(j)]); sum += c; cnt += (c > 0u) ? 1u : 0u; mine = (j == x) ? c : mine; }
        if (sum == G) break;
        __builtin_amdgcn_s_sleep(1);
        if ((++sp & 255u) == 0u) { if (xb_ld(&bar[XB_TMO])) break; if (sp > XB_SPIN_CAP) { atomicAdd(&bar[XB_TMO], 1u); break; } }
    }
    nloc = mine > 0u ? mine : 1u; nx = cnt > 0u ? cnt : 1u;
}

__device__ __forceinline__ void xcd_barrier(const XcdBarrier& b) {
    asm volatile("s_waitcnt vmcnt(0)" ::: "memory");
    __syncthreads();
    if (threadIdx.x == 0) {
        unsigned* bar = b.bar;
        __builtin_amdgcn_s_waitcnt(0);
        unsigned nloc = b.st[0], nx = b.st[1];
        if (nloc == 0u) { xcd_barrier_complete(bar, b.x, nloc, nx); b.st[0] = nloc; b.st[1] = nx; }
        const unsigned old = xb_add(&bar[XB_XSUB(b.x)], 1u);
        const unsigned gen = old / nloc;
        if (old + 1u == (gen + 1u) * nloc) {
            __builtin_amdgcn_fence(__ATOMIC_RELEASE, "agent");
            asm volatile("s_waitcnt vmcnt(0)" ::: "memory");
            const unsigned og = xb_add(&bar[XB_TOP], 1u);
            const unsigned tg = og / nx;
            if (og + 1u == (tg + 1u) * nx) xb_add(&bar[XB_TOPGEN], 1u);
            else XB_SPIN(xb_ld(&bar[XB_TOPGEN]) == tg, bar);
            __builtin_amdgcn_fence(__ATOMIC_ACQUIRE, "agent");
            xb_add(&bar[XB_XGEN(b.x)], 1u);
            asm volatile("s_waitcnt vmcnt(0)" ::: "memory");
        } else {
            XB_SPIN(xb_ld(&bar[XB_XGEN(b.x)]) == gen, bar);
            __builtin_amdgcn_fence(__ATOMIC_ACQUIRE, "agent");
            asm volatile("s_waitcnt vmcnt(0)" ::: "memory");
        }
    }
    __syncthreads();
}

struct Args {
    const float *x, *c, *ctx, *c_ctx, *w_mod, *b_mod, *norm1_w, *norm2_w, *mlp_w1, *mlp_w2, *ev_w_in, *ev_decay, *ev_gn_w, *ev_sink, *ev_w_out,
                *od_w_in, *od_conv_w, *od_qn_w, *od_kvn_w, *od_w_uq, *od_w_ukv, *od_w_out, *norm_f;
    float* out; unsigned char* ws; int ph_lo, ph_hi;
};

__device__ __forceinline__ void unpack8(const v4u w, float (&f)[8]) {
#pragma unroll
    for (int i = 0; i < 4; ++i) { f[2 * i] = bflo(w[i]); f[2 * i + 1] = bfhi(w[i]); }
}
__device__ __forceinline__ v4u pack8(const float (&f)[8]) { v4u w; w.x = pk2(f[0], f[1]); w.y = pk2(f[2], f[3]); w.z = pk2(f[4], f[5]); w.w = pk2(f[6], f[7]); return w; }
__device__ __forceinline__ void ld8f(const float* p, float (&f)[8]) { const f32x4 a = *(const f32x4*)p, b = *(const f32x4*)(p + 4);
    f[0] = a.x; f[1] = a.y; f[2] = a.z; f[3] = a.w; f[4] = b.x; f[5] = b.y; f[6] = b.z; f[7] = b.w; }
__device__ __forceinline__ float lam_of(float log2_decay) { const float x = -fexp2(log2_decay);
    float s = -1.f / 8.f; s = s * x + 1.f / 7.f; s = s * x - 1.f / 6.f; s = s * x + 1.f / 5.f; s = s * x - 1.f / 4.f; s = s * x + 1.f / 3.f; s = s * x - 0.5f; s = s * x + 1.f; return s * x; }
__device__ __forceinline__ f32x4 mfma16(bf16x8 a, bf16x8 b, f32x4 c) { return __builtin_amdgcn_mfma_f32_16x16x32_bf16(a, b, c, 0, 0, 0); }
__device__ __forceinline__ f32x16 mfma32(bf16x8 a, bf16x8 b, f32x16 c) { return __builtin_amdgcn_mfma_f32_32x32x16_bf16(a, b, c, 0, 0, 0); }

struct P0Item { const float* W; bf16* WT; int K, N, item; };
__device__ __forceinline__ void p0_item_load(const P0Item& d, int lane, float (&ld)[32]) {
    const int nblk = d.N / 32, kb = d.item / nblk, nb = d.item % nblk; const float* src = d.W + (size_t)(64 * kb + (lane >> 5)) * d.N + 32 * nb + (lane & 31);
#pragma unroll
    for (int i = 0; i < 32; ++i) ld[i] = __builtin_nontemporal_load(src + (size_t)(2 * i) * d.N);
}
__device__ __forceinline__ void p0_item_finish(const P0Item& d, int lane, const float (&ld)[32], LAS float* scr) {
    const int nblk = d.N / 32, kb = d.item / nblk, nb = d.item % nblk, k0 = 64 * kb, n0 = 32 * nb;
#pragma unroll
    for (int i = 0; i < 32; ++i) scr[(2 * i + (lane >> 5)) * 33 + (lane & 31)] = ld[i];
    LDS_WAIT(); asm volatile("" ::: "memory");
    const int c = lane & 7;
#pragma unroll
    for (int j = 0; j < 4; ++j) { const int n = (lane >> 3) + 8 * j; const LAS float* s = scr + (8 * c) * 33 + n;
        v4u o; o.x = pk2(s[0 * 33], s[1 * 33]); o.y = pk2(s[2 * 33], s[3 * 33]); o.z = pk2(s[4 * 33], s[5 * 33]); o.w = pk2(s[6 * 33], s[7 * 33]);
        __builtin_nontemporal_store(o, (GAS v4u*)(d.WT + (size_t)(n0 + n) * d.K + k0 + 8 * c)); }
    LDS_WAIT(); asm volatile("" ::: "memory");
}
struct ProIn { const float *x, *c, *ctx, *c_ctx, *w_mod, *b_mod, *mlp_w1, *mlp_w2, *ev_w_in, *ev_w_out, *od_w_in, *od_w_out, *od_w_uq, *od_w_ukv; };
__device__ __forceinline__ void ph_prologue(const ProIn a, unsigned char* ws, LAS unsigned char* lds, int tid, int wave, int lane, int wg, int G) {
    float* mod = (float*)(ws + WS_MOD);
    for (int u = wg; u < 192; u += G) {
        LAS float* sl = (LAS float*)lds;
        LAS float* red = (LAS float*)(lds + 24576);
        for (int i = tid; i < 3 * DM; i += NTHR) { const int s = i >> 11, k = i & 2047; const float cv = (s < 2) ? a.c[s * DM + k] : a.c_ctx[k]; sl[i] = cv / (1.f + __expf(-cv)); }
        __syncthreads();
        const int l = u / 48, j0 = (u % 48) * 256;
        const float* wp = a.w_mod + ((size_t)l * DM + wave * 256) * 12288 + j0 + 4 * lane;
        f32x4 a0 = {0.f, 0.f, 0.f, 0.f}, a1 = a0, a2 = a0;
#pragma unroll 8
        for (int k = 0; k < 256; ++k) { const f32x4 w = *(const f32x4*)(wp + (size_t)k * 12288); const int kk = wave * 256 + k;
            a0 += sl[kk] * w; a1 += sl[DM + kk] * w; a2 += sl[2 * DM + kk] * w; }
        *(LAS f32x4*)(red + (wave * 3 + 0) * 256 + 4 * lane) = a0; *(LAS f32x4*)(red + (wave * 3 + 1) * 256 + 4 * lane) = a1; *(LAS f32x4*)(red + (wave * 3 + 2) * 256 + 4 * lane) = a2;
        __syncthreads();
        for (int i = tid; i < 768; i += NTHR) { const int s = i >> 8, col = i & 255; float v = a.b_mod[l * 12288 + j0 + col];
#pragma unroll
            for (int w = 0; w < 8; ++w) v += red[(w * 3 + s) * 256 + col];
            mod[(size_t)(l * 3 + s) * 12288 + j0 + col] = v; }
        __syncthreads();
    }
    {
        LAS float* scr = (LAS float*)(lds + wave * 16384);
        const int gw = wg * NWAVES + wave, NGW = G * NWAVES;
        constexpr int I_W1 = 32 * 256, I_W2 = 128 * 64, I_EI = 32 * 176, I_EO = 32 * 64, I_OI = 32 * 122, I_OO = 32 * 64, I_UQ = 8 * 48, I_UKV = 4 * 64;
        constexpr int NIT = 4 * I_W1 + 4 * I_W2 + 2 * (I_EI + I_EO + I_OI + I_OO + I_UQ + I_UKV);
#define P0_DECODE(it_, d) do { int r = (it_); \
            if (r < 4 * I_W1) { const int l = r / I_W1; d = P0Item{a.mlp_w1 + (size_t)l * DM * DFF, (bf16*)(ws + WS_W1T) + (size_t)l * DFF * DM, DM, DFF, r % I_W1}; break; } r -= 4 * I_W1; \
            if (r < 4 * I_W2) { const int l = r / I_W2; d = P0Item{a.mlp_w2 + (size_t)l * DFF * DM, (bf16*)(ws + WS_W2T) + (size_t)l * DM * DFF, DFF, DM, r % I_W2}; break; } r -= 4 * I_W2; \
            if (r < 2 * I_EI) { const int l = r / I_EI; d = P0Item{a.ev_w_in + (size_t)l * DM * EV_IN, (bf16*)(ws + WS_EWIN) + (size_t)l * EV_IN * DM, DM, EV_IN, r % I_EI}; break; } r -= 2 * I_EI; \
            if (r < 2 * I_EO) { const int l = r / I_EO; d = P0Item{a.ev_w_out + (size_t)l * DM * DM, (bf16*)(ws + WS_EWOUT) + (size_t)l * DM * DM, DM, DM, r % I_EO}; break; } r -= 2 * I_EO; \
            if (r < 2 * I_OI) { const int l = r / I_OI, it2 = r % I_OI, nb = it2 % 122;     \
                bf16* dst = nb < 120 ? (bf16*)(ws + WS_OWIN) + (size_t)l * OD_INP * DM : (bf16*)(ws + WS_WKRT) + (size_t)l * 64 * DM - (size_t)OD_INP * DM; \
                d = P0Item{a.od_w_in + (size_t)l * DM * OD_IN, dst, DM, OD_IN, it2}; break; } r -= 2 * I_OI; \
            if (r < 2 * I_OO) { const int l = r / I_OO; d = P0Item{a.od_w_out + (size_t)l * DM * DM, (bf16*)(ws + WS_OWOUT) + (size_t)l * DM * DM, DM, DM, r % I_OO}; break; } r -= 2 * I_OO; \
            if (r < 2 * I_UQ) { const int l = r / I_UQ; d = P0Item{a.od_w_uq + (size_t)l * 512 * 1536, (bf16*)(ws + WS_UQT) + (size_t)l * 1536 * 512, 512, 1536, r % I_UQ}; break; } r -= 2 * I_UQ; \
            { const int l = r / I_UKV; d = P0Item{a.od_w_ukv + (size_t)l * 256 * 2048, (bf16*)(ws + WS_UKVT) + (size_t)l * 2048 * 256, 256, 2048, r % I_UKV}; } } while (0)
        P0Item dA, dB; float ldA[32], ldB[32];
        int it = gw;
        if (it < NIT) { P0_DECODE(it, dA); p0_item_load(dA, lane, ldA); }
        while (it < NIT) {
            if (it + NGW < NIT) { P0_DECODE(it + NGW, dB); p0_item_load(dB, lane, ldB); }
            p0_item_finish(dA, lane, ldA, scr);
            it += NGW;
            if (it >= NIT) break;
            if (it + NGW < NIT) { P0_DECODE(it + NGW, dA); p0_item_load(dA, lane, ldA); }
            p0_item_finish(dB, lane, ldB, scr);
            it += NGW;
        }
#undef P0_DECODE
    }
    const int gt = wg * NTHR + tid, NGT = G * NTHR;
    {
        const double INV2PI = 0.15915494309189533576888;
        const float L2B = 13.287712379549449f;
        float* t1c = (float*)(ws + WS_T1C); float* t1s = (float*)(ws + WS_T1S);
        for (int i = gt; i < TL * 64; i += NGT) { const int pos = i >> 6, f = i & 63; const float inv = fexp2(-(float)(2 * f) / 128.f * L2B); const float ang = (float)pos * inv;
            double rev = (double)ang * INV2PI; rev -= __builtin_rint(rev); const float fr = (float)rev; t1c[i] = __builtin_amdgcn_cosf(fr); t1s[i] = __builtin_amdgcn_sinf(fr); }
        float* t2c = (float*)(ws + WS_T2); float* t2s = t2c + 64 * 32; float* t3c = t2s + 64 * 32; float* t3s = t3c + 64 * 16;
        for (int i = gt; i < 64 * 32; i += NGT) { const int pos = i >> 5, f = i & 31; const float inv = fexp2(-(float)(2 * f) / 64.f * L2B); const float ang = (float)pos * inv;
            double rev = (double)ang * INV2PI; rev -= __builtin_rint(rev); const float fr = (float)rev; t2c[i] = __builtin_amdgcn_cosf(fr); t2s[i] = __builtin_amdgcn_sinf(fr); }
        for (int i = gt; i < 64 * 16; i += NGT) { const int pos = i >> 4, f = i & 15; const float inv = fexp2(-(float)(2 * f) / 32.f * L2B); const float ang = (float)pos * inv;
            double rev = (double)ang * INV2PI; rev -= __builtin_rint(rev); const float fr = (float)rev; t3c[i] = __builtin_amdgcn_cosf(fr); t3s[i] = __builtin_amdgcn_sinf(fr); }
    }
}

__device__ __forceinline__ void ph_norm(bool src32, const float* Hc, const float* Hx, const bf16* Hb, const float* nw, const float* mod_l, int ch_sh, int ch_sc, bf16* A, int row_lo, LAS unsigned char* lds, int tid, int gw, int NGW, int lane) {
    LAS float* comb = (LAS float*)(lds + 1024);
    for (int i = tid; i < 3 * DM; i += NTHR) { const int set = i >> 11, col = i & 2047; comb[(set * 2 + 0) * DM + col] = nw[col] * (1.f + mod_l[(size_t)(set * 6 + ch_sc) * DM + col]); comb[(set * 2 + 1) * DM + col] = mod_l[(size_t)(set * 6 + ch_sh) * DM + col]; }
    __syncthreads();
#define NORM_ROW_OUT(vv, r_) do { float ss = 0.f; \
        _Pragma("unroll") for (int j = 0; j < 8; ++j) ss += (vv[j].x * vv[j].x + vv[j].y * vv[j].y) + (vv[j].z * vv[j].z + vv[j].w * vv[j].w); \
        ss = wave_sum(ss); \
        const float rs = 1.f / sqrtf(ss * (1.f / DM) + EPS); \
        const LAS float* ca = comb + (row_set(r_) * 2) * DM; const LAS float* cb = ca + DM; \
        v2u* o = (v2u*)(A + (size_t)(r_) * DM) + lane; \
        _Pragma("unroll") for (int j = 0; j < 8; ++j) { const int col = 256 * j + 4 * lane; const f32x4 w = *(const LAS f32x4*)(ca + col), t = *(const LAS f32x4*)(cb + col); \
            const f32x4 y = (vv[j] * rs) * w + t; v2u q; q.x = pk2(y.x, y.y); q.y = pk2(y.z, y.w); o[64 * j] = q; } } while (0)
    if (src32) {
        for (int r0 = row_lo + gw; r0 < RALL; r0 += 2 * NGW) {
            f32x4 va[8], vb[8]; const int r1 = r0 + NGW; const bool h1 = r1 < RALL;
            { const f32x4* xr = (const f32x4*)(r0 < RC ? Hc + (size_t)r0 * DM : Hx + (size_t)(r0 - RC) * DM) + lane;
#pragma unroll
              for (int j = 0; j < 8; ++j) va[j] = xr[64 * j]; }
            if (h1) { const f32x4* xr = (const f32x4*)(r1 < RC ? Hc + (size_t)r1 * DM : Hx + (size_t)(r1 - RC) * DM) + lane;
#pragma unroll
              for (int j = 0; j < 8; ++j) vb[j] = xr[64 * j]; }
            NORM_ROW_OUT(va, r0);
            if (h1) NORM_ROW_OUT(vb, r1);
        }
    } else {
        for (int r0 = row_lo + gw; r0 < RALL; r0 += 5 * NGW) {
            v2u pk[5][8];
#pragma unroll
            for (int b = 0; b < 5; ++b) { const int r = r0 + b * NGW; if (r < RALL) { const v2u* xr = (const v2u*)(Hb + (size_t)r * DM) + lane;
#pragma unroll
                for (int j = 0; j < 8; ++j) pk[b][j] = xr[64 * j]; } }
#pragma unroll
            for (int b = 0; b < 5; ++b) { const int r = r0 + b * NGW; if (r < RALL) { f32x4 v[8];
#pragma unroll
                for (int j = 0; j < 8; ++j) v[j] = (f32x4){bflo(pk[b][j].x), bfhi(pk[b][j].x), bflo(pk[b][j].y), bfhi(pk[b][j].y)};
                NORM_ROW_OUT(v, r); } }
        }
    }
#undef NORM_ROW_OUT
    __syncthreads();
}
template <int NPART> __device__ __forceinline__ void ph_norm_ctx(const float* Hin32, bf16* H, const float* nw, const float* mod_l, int ch_sh, int ch_sc, bf16* A, const bf16* part, const float* pgate, LAS unsigned char* lds, int tid, int wave, int lane, int wg, int G) {
    LAS float* red = (LAS float*)lds;
    const float* sh = mod_l + (size_t)(2 * 6 + ch_sh) * DM; const float* sc = mod_l + (size_t)(2 * 6 + ch_sc) * DM;
    const int col = 256 * wave + 4 * lane;
    for (int r = wg; r < RC; r += G) {
        f32x4 h;
        if (Hin32) h = *(const f32x4*)(Hin32 + (size_t)r * DM + col);
        else { const v2u w = *(const v2u*)(H + (size_t)r * DM + col); h = (f32x4){bflo(w.x), bfhi(w.x), bflo(w.y), bfhi(w.y)}; }
        f32x4 acc = {0.f, 0.f, 0.f, 0.f};
        v2u pw[NPART];
#pragma unroll
        for (int s = 0; s < NPART; ++s) pw[s] = *(const v2u*)(part + ((size_t)s * RC + r) * DM + col);
#pragma unroll
        for (int s = 0; s < NPART; ++s) acc += (f32x4){bflo(pw[s].x), bfhi(pw[s].x), bflo(pw[s].y), bfhi(pw[s].y)};
        h += *(const f32x4*)(pgate + col) * acc;
        { v2u w; w.x = pk2(h.x, h.y); w.y = pk2(h.z, h.w); *(v2u*)(H + (size_t)r * DM + col) = w;
          h = (f32x4){bflo(w.x), bfhi(w.x), bflo(w.y), bfhi(w.y)}; }
        float ss = wave_sum((h.x * h.x + h.y * h.y) + (h.z * h.z + h.w * h.w));
        if (lane == 0) red[wave] = ss;
        __syncthreads();
        float tot = 0.f;
#pragma unroll
        for (int w = 0; w < 8; ++w) tot += red[w];
        __syncthreads();
        const float rs = 1.f / sqrtf(tot * (1.f / DM) + EPS);
        const f32x4 w4 = *(const f32x4*)(nw + col), s4 = *(const f32x4*)(sc + col), t4 = *(const f32x4*)(sh + col);
        const f32x4 y = (h * rs) * w4 * (s4 + 1.f) + t4; v2u q; q.x = pk2(y.x, y.y); q.y = pk2(y.z, y.w);
        *(v2u*)(A + (size_t)r * DM + col) = q;
    }
}
__device__ __forceinline__ void ph_final(const bf16* H, const float* nw, float* out, int gw, int NGW, int lane) {
    f32x4 wv[8];
#pragma unroll
    for (int j = 0; j < 8; ++j) wv[j] = *(const f32x4*)(nw + 256 * j + 4 * lane);
    for (int r0 = gw; r0 < NB * TL; r0 += 4 * NGW) {
        v2u pk[4][8];
#pragma unroll
        for (int b = 0; b < 4; ++b) { const int r = r0 + b * NGW; if (r < NB * TL) { const v2u* xr = (const v2u*)(H + (size_t)(RC + r) * DM) + lane;
#pragma unroll
            for (int j = 0; j < 8; ++j) pk[b][j] = xr[64 * j]; } }
#pragma unroll
        for (int b = 0; b < 4; ++b) { const int r = r0 + b * NGW; if (r < NB * TL) { f32x4 v[8]; float ss = 0.f;
#pragma unroll
            for (int j = 0; j < 8; ++j) { v[j] = (f32x4){bflo(pk[b][j].x), bfhi(pk[b][j].x), bflo(pk[b][j].y), bfhi(pk[b][j].y)}; ss += (v[j].x * v[j].x + v[j].y * v[j].y) + (v[j].z * v[j].z + v[j].w * v[j].w); }
            ss = wave_sum(ss);
            const float rs = 1.f / sqrtf(ss * (1.f / DM) + EPS);
            f32x4* o = (f32x4*)(out + (size_t)r * DM) + lane;
#pragma unroll
            for (int j = 0; j < 8; ++j) o[64 * j] = (v[j] * rs) * wv[j]; } }
    }
}

__device__ __forceinline__ void vt_tile(const bf16* src, int ld_src, bf16* dst, LAS unsigned char* scr, int lane) {
#pragma unroll
    for (int it = 0; it < 8; ++it) { const int key = it * 8 + (lane >> 3), pc = lane & 7;
        const v4u w = *(const v4u*)(src + (size_t)key * ld_src + pc * 8); *(LAS v4u*)(scr + key * 144 + pc * 16) = w; }
    LDS_WAIT(); asm volatile("" ::: "memory");
#pragma unroll
    for (int q = 0; q < 8; ++q) { unsigned e[8];
#pragma unroll
        for (int i = 0; i < 8; ++i) e[i] = *(const LAS unsigned short*)(scr + (16 * (q >> 1) + 4 * (q & 1) + 8 * (i >> 2) + (i & 3)) * 144 + lane * 2);
        v4u w; w.x = e[0] | (e[1] << 16); w.y = e[2] | (e[3] << 16); w.z = e[4] | (e[5] << 16); w.w = e[6] | (e[7] << 16);
        *(v4u*)(dst + (size_t)lane * NKEY + 8 * q) = w; }
    LDS_WAIT(); asm volatile("" ::: "memory");
}
__device__ __forceinline__ int key_row(int b, int kk) { return kk < TC ? b * TC + kk : RC + b * TL + (kk - TC); }

__device__ __forceinline__ void post_win_tile(unsigned char* ws, LAS unsigned char* lds, int pm, int pn, int tid, int wave, int lane) {
    bf16* prj = (bf16*)(ws + WS_PRJ);
    if (pn >= 16 && pn <= 20) {
        if (pm < 2) return;
        const float* t2c = (const float*)(ws + WS_T2); const float* t2s = t2c + 64 * 32;
        for (int idx0 = tid; idx0 < 256 * 16; idx0 += 4 * NTHR) {
            v4u w1[4], w2[4]; bf16* bp[4]; int tb[4];
#pragma unroll
            for (int q = 0; q < 4; ++q) { const int idx = idx0 + q * NTHR; const int p = idx & 3, half = (idx >> 2) & 1, hh = (idx >> 3) & 1, i = idx >> 4;
                const int r = pm * 256 + i, t = (r - RC) & (TL - 1), posv = half ? (t & 63) : (t >> 6);
                bp[q] = prj + (size_t)r * EV_IN + 256 * pn + hh * 128 + half * 64 + 8 * p; tb[q] = posv * 32 + 8 * p;
                w1[q] = *(const v4u*)bp[q]; w2[q] = *(const v4u*)(bp[q] + 32); }
#pragma unroll
            for (int q = 0; q < 4; ++q) { float x1[8], x2[8], cs[8], sn[8], o1[8], o2[8];
                unpack8(w1[q], x1); unpack8(w2[q], x2); ld8f(t2c + tb[q], cs); ld8f(t2s + tb[q], sn);
#pragma unroll
                for (int e = 0; e < 8; ++e) { o1[e] = x1[e] * cs[e] - x2[e] * sn[e]; o2[e] = x2[e] * cs[e] + x1[e] * sn[e]; }
                *(v4u*)bp[q] = pack8(o1); *(v4u*)(bp[q] + 32) = pack8(o2); }
        }
    } else if (pn == 21) {
        bf16* vtw = (bf16*)(ws + WS_VTW); LAS unsigned char* scr = lds + wave * 16384;
        const int b = pm < 2 ? pm : ((pm - 2) >> 4), kt0 = pm < 2 ? 0 : 4 + ((pm - 2) & 15) * 4;
        for (int q = 0; q < 2; ++q) { const int it = wave * 2 + q, dvh = it & 1, kvh = (it >> 1) & 1, kt = kt0 + (it >> 2);
            const int row0 = key_row(b, 64 * kt);
            vt_tile(prj + (size_t)row0 * EV_IN + E_VW + kvh * 128 + dvh * 64, EV_IN, vtw + ((size_t)(b * 2 + kvh) * 128 + dvh * 64) * NKEY + 64 * kt, scr, lane); }
    }
}

__device__ __forceinline__ void ret_kv_unit(unsigned char* ws, const float* dec, LAS unsigned char* lds, int tid, int wave, int lane, int u) {
    const int bh = u / NCH, c = u % NCH, b = bh >> 3, h = bh & 7;
    const bool isctx = c < 2;
    const int row0 = isctx ? b * TC + c * 128 : RC + b * TL + (c - 2) * 128, pos0 = isctx ? 0 : (c - 2) * 128;
    const bf16* prj = (const bf16*)(ws + WS_PRJ);
    const float* t1c = (const float*)(ws + WS_T1C); const float* t1s = (const float*)(ws + WS_T1S);
    const float lf2 = lam_of(dec[h]) * LOG2E, lb2 = lam_of(dec[8 + h]) * LOG2E;
    LAS bf16* KTf = (LAS bf16*)lds; LAS bf16* KTb = KTf + 128 * 136; LAS bf16* VTs = KTb + 128 * 136;
    for (int it = tid; it < 512; it += NTHR) { const int tp = it & 63, p = it >> 6;
        float x1[2][8], x2[2][8], ft[2], bt[2];
#pragma unroll
        for (int q = 0; q < 2; ++q) { const int t = 2 * tp + q; const bf16* kr = prj + (size_t)(row0 + t) * EV_IN + E_KR + h * 128 + 8 * p;
            unpack8(*(const v4u*)kr, x1[q]); unpack8(*(const v4u*)(kr + 64), x2[q]);
            if (!isctx) { float cs[8], sn[8]; ld8f(t1c + (size_t)(pos0 + t) * 64 + 8 * p, cs); ld8f(t1s + (size_t)(pos0 + t) * 64 + 8 * p, sn);
#pragma unroll
                for (int e = 0; e < 8; ++e) { const float a1 = x1[q][e] * cs[e] - x2[q][e] * sn[e], a2 = x2[q][e] * cs[e] + x1[q][e] * sn[e]; x1[q][e] = a1; x2[q][e] = a2; } }
            ft[q] = fexp2(lf2 * (float)(127 - t)); bt[q] = fexp2(lb2 * (float)t); }
#pragma unroll
        for (int e = 0; e < 8; ++e) {
            *(LAS unsigned*)(KTf + (8 * p + e) * 136 + 2 * tp) = pk2(x1[0][e] * ft[0], x1[1][e] * ft[1]); *(LAS unsigned*)(KTf + (64 + 8 * p + e) * 136 + 2 * tp) = pk2(x2[0][e] * ft[0], x2[1][e] * ft[1]);
            *(LAS unsigned*)(KTb + (8 * p + e) * 136 + 2 * tp) = pk2(x1[0][e] * bt[0], x1[1][e] * bt[1]); *(LAS unsigned*)(KTb + (64 + 8 * p + e) * 136 + 2 * tp) = pk2(x2[0][e] * bt[0], x2[1][e] * bt[1]); }
    }
    {
        v4u w0[2], w1[2];
#pragma unroll
        for (int q = 0; q < 2; ++q) { const int it = tid + q * NTHR, tp = it & 63, p = it >> 6; const bf16* vr = prj + (size_t)(row0 + 2 * tp) * EV_IN + E_VR + h * 128 + 8 * p;
            w0[q] = *(const v4u*)vr; w1[q] = *(const v4u*)(vr + EV_IN); }
#pragma unroll
        for (int q = 0; q < 2; ++q) { const int it = tid + q * NTHR, tp = it & 63, p = it >> 6;
#pragma unroll
            for (int i = 0; i < 4; ++i) { const unsigned lo = (w0[q][i] & 0xffffu) | (w1[q][i] << 16), hi = (w0[q][i] >> 16) | (w1[q][i] & 0xffff0000u);
                *(LAS unsigned*)(VTs + (8 * p + 2 * i) * 136 + 2 * tp) = lo; *(LAS unsigned*)(VTs + (8 * p + 2 * i + 1) * 136 + 2 * tp) = hi; } }
    }
    __syncthreads();
    const int dir = wave >> 2, dvb = (wave & 3) * 32, fr = lane & 15, fq = lane >> 4;
    const LAS bf16* KT = dir ? KTb : KTf;
    f32x4 acc[2][8];
#pragma unroll
    for (int m = 0; m < 2; ++m)
#pragma unroll
        for (int n = 0; n < 8; ++n) acc[m][n] = (f32x4){0.f, 0.f, 0.f, 0.f};
#pragma unroll
    for (int s = 0; s < 4; ++s) {
        bf16x8 af[2];
#pragma unroll
        for (int m = 0; m < 2; ++m) af[m] = *(const LAS bf16x8*)(VTs + (dvb + 16 * m + fr) * 136 + 32 * s + 8 * fq);
#pragma unroll
        for (int n = 0; n < 8; ++n) { const bf16x8 bfr = *(const LAS bf16x8*)(KT + (16 * n + fr) * 136 + 32 * s + 8 * fq);
#pragma unroll
            for (int m = 0; m < 2; ++m) acc[m][n] = mfma16(af[m], bfr, acc[m][n]); }
    }
    float* o = (float*)(ws + WS_KVST) + ((size_t)(dir * 16 + bh) * NCH + c) * 16384;
#pragma unroll
    for (int m = 0; m < 2; ++m)
#pragma unroll
        for (int n = 0; n < 8; ++n)
#pragma unroll
            for (int r = 0; r < 4; ++r) o[(dvb + 16 * m + 4 * fq + r) * 128 + 16 * n + fr] = acc[m][n][r];
    __syncthreads();
}
__device__ __forceinline__ void ph_ret_scan(unsigned char* ws, const float* dec, int tid, int wg, int G) {
    for (int w = wg; w < 256; w += G) {
        const int s = w >> 3, slice = w & 7, dir = s >> 4, bh = s & 15, h = bh & 7;
        const float g = fexp2(lam_of(dec[dir * 8 + h]) * LOG2E * 128.f);
        const size_t e0 = (size_t)slice * 2048 + tid * 4;
        const float* kv = (const float*)(ws + WS_KVST) + (size_t)(dir * 16 + bh) * NCH * 16384 + e0;
        bf16* st = (bf16*)(ws + WS_ST) + (size_t)(dir * 16 + bh) * NCH * 16384 + e0;
        f32x4 S = {0.f, 0.f, 0.f, 0.f};
#pragma unroll
        for (int half = 0; half < 2; ++half) {
            f32x4 buf[17];
#pragma unroll
            for (int i = 0; i < 17; ++i) { const int k = half * 17 + i; const int c = dir ? (k == 0 ? 1 : (k == 1 ? 0 : 35 - k)) : k; buf[i] = *(const f32x4*)(kv + (size_t)c * 16384); }
#pragma unroll
            for (int i = 0; i < 17; ++i) { const int k = half * 17 + i; const int c = dir ? (k == 0 ? 1 : (k == 1 ? 0 : 35 - k)) : k;
                v2u q; q.x = pk2(S.x, S.y); q.y = pk2(S.z, S.w); *(v2u*)(st + (size_t)c * 16384) = q; S = S * g + buf[i]; }
        }
    }
}
__device__ __forceinline__ void ret_out_unit(unsigned char* ws, const float* dec, const float* gnw, LAS unsigned char* lds, int tid, int wave, int lane, int u) {
    const int bh = u / NCH, c = u % NCH, b = bh >> 3, h = bh & 7;
    const bool isctx = c < 2;
    const int row0 = isctx ? b * TC + c * 128 : RC + b * TL + (c - 2) * 128, pos0 = isctx ? 0 : (c - 2) * 128;
    const bf16* prj = (const bf16*)(ws + WS_PRJ);
    const float* t1c = (const float*)(ws + WS_T1C); const float* t1s = (const float*)(ws + WS_T1S);
    const float lf2 = lam_of(dec[h]) * LOG2E, lb2 = lam_of(dec[8 + h]) * LOG2E;
    const float scale = 0.088388347648318440f;
    LAS bf16* Qs = (LAS bf16*)lds; LAS bf16* Ks = Qs + 128 * 136; LAS bf16* VTs = Ks + 128 * 136; LAS bf16* Ps = VTs + 128 * 136;
    for (int it = tid; it < 1024; it += NTHR) { const int t = it >> 3, p = it & 7;
        const bf16* qr = prj + (size_t)(row0 + t) * EV_IN + E_QR + h * 128 + 8 * p; const bf16* kr = qr + (E_KR - E_QR);
        float q1[8], q2[8], k1[8], k2[8]; unpack8(*(const v4u*)qr, q1); unpack8(*(const v4u*)(qr + 64), q2); unpack8(*(const v4u*)kr, k1); unpack8(*(const v4u*)(kr + 64), k2);
        if (!isctx) { float cs[8], sn[8]; ld8f(t1c + (size_t)(pos0 + t) * 64 + 8 * p, cs); ld8f(t1s + (size_t)(pos0 + t) * 64 + 8 * p, sn);
#pragma unroll
            for (int e = 0; e < 8; ++e) { const float a1 = q1[e] * cs[e] - q2[e] * sn[e], a2 = q2[e] * cs[e] + q1[e] * sn[e]; q1[e] = a1; q2[e] = a2;
                const float b1 = k1[e] * cs[e] - k2[e] * sn[e], b2 = k2[e] * cs[e] + k1[e] * sn[e]; k1[e] = b1; k2[e] = b2; } }
        *(LAS v4u*)(Qs + t * 136 + 8 * p) = pack8(q1); *(LAS v4u*)(Qs + t * 136 + 64 + 8 * p) = pack8(q2);
        *(LAS v4u*)(Ks + t * 136 + 8 * p) = pack8(k1); *(LAS v4u*)(Ks + t * 136 + 64 + 8 * p) = pack8(k2);
    }
    {
        v4u w0[2], w1[2];
#pragma unroll
        for (int q = 0; q < 2; ++q) { const int it = tid + q * NTHR, tp = it & 63, p = it >> 6; const bf16* vr = prj + (size_t)(row0 + 2 * tp) * EV_IN + E_VR + h * 128 + 8 * p;
            w0[q] = *(const v4u*)vr; w1[q] = *(const v4u*)(vr + EV_IN); }
#pragma unroll
        for (int q = 0; q < 2; ++q) { const int it = tid + q * NTHR, tp = it & 63, p = it >> 6;
#pragma unroll
            for (int i = 0; i < 4; ++i) { const unsigned lo = (w0[q][i] & 0xffffu) | (w1[q][i] << 16), hi = (w0[q][i] >> 16) | (w1[q][i] & 0xffff0000u);
                *(LAS unsigned*)(VTs + (8 * p + 2 * i) * 136 + 2 * tp) = lo; *(LAS unsigned*)(VTs + (8 * p + 2 * i + 1) * 136 + 2 * tp) = hi; } }
    }
    __syncthreads();
    v4u streg[2][4];
    { const bf16* st0 = (const bf16*)(ws + WS_ST) + ((size_t)bh * NCH + c) * 16384;
#pragma unroll
      for (int dir = 0; dir < 2; ++dir)
#pragma unroll
          for (int j = 0; j < 4; ++j) streg[dir][j] = *(const v4u*)(st0 + (size_t)dir * 16 * NCH * 16384 + (size_t)(tid + NTHR * j) * 8); }
    const int i0 = 16 * wave, fr = lane & 15, fq = lane >> 4;
    bf16x8 qa[4];
#pragma unroll
    for (int s = 0; s < 4; ++s) qa[s] = *(const LAS bf16x8*)(Qs + (i0 + fr) * 136 + 32 * s + 8 * fq);
#pragma unroll
    for (int n = 0; n < 8; ++n) { f32x4 sa = {0.f, 0.f, 0.f, 0.f};
#pragma unroll
        for (int s = 0; s < 4; ++s) { const bf16x8 kb = *(const LAS bf16x8*)(Ks + (16 * n + fr) * 136 + 32 * s + 8 * fq); sa = mfma16(qa[s], kb, sa); }
#pragma unroll
        for (int r = 0; r < 4; ++r) { const int d = (i0 + 4 * fq + r) - (16 * n + fr);
            const float dcy = d >= 0 ? fexp2(lf2 * (float)d) : fexp2(lb2 * (float)(-d));
            Ps[(i0 + 4 * fq + r) * 136 + 16 * n + fr] = f2bf(sa[r] * scale * dcy); }
    }
    LDS_WAIT(); asm volatile("" ::: "memory");
    f32x4 O[8];
#pragma unroll
    for (int n = 0; n < 8; ++n) O[n] = (f32x4){0.f, 0.f, 0.f, 0.f};
#pragma unroll
    for (int s = 0; s < 4; ++s) { const bf16x8 pa = *(const LAS bf16x8*)(Ps + (i0 + fr) * 136 + 32 * s + 8 * fq);
#pragma unroll
        for (int n = 0; n < 8; ++n) { const bf16x8 vb = *(const LAS bf16x8*)(VTs + (16 * n + fr) * 136 + 32 * s + 8 * fq); O[n] = mfma16(pa, vb, O[n]); } }
    __syncthreads();
#pragma unroll
    for (int dir = 0; dir < 2; ++dir)
#pragma unroll
        for (int j = 0; j < 4; ++j) { const int e = (tid + NTHR * j) * 8, dvr = e >> 7, dkc = e & 127; *(LAS v4u*)((dir ? Qs : Ks) + dvr * 136 + dkc) = streg[dir][j]; }
    __syncthreads();
#pragma unroll
    for (int dir = 0; dir < 2; ++dir) {
        const LAS bf16* st = dir ? Qs : Ks;
        f32x4 T[8];
#pragma unroll
        for (int n = 0; n < 8; ++n) T[n] = (f32x4){0.f, 0.f, 0.f, 0.f};
#pragma unroll
        for (int s = 0; s < 4; ++s)
#pragma unroll
            for (int n = 0; n < 8; ++n) { const bf16x8 sb = *(const LAS bf16x8*)(st + (16 * n + fr) * 136 + 32 * s + 8 * fq); T[n] = mfma16(qa[s], sb, T[n]); }
#pragma unroll
        for (int r = 0; r < 4; ++r) { const int il = i0 + 4 * fq + r; const float fac = scale * (dir == 0 ? fexp2(lf2 * (float)(il + 1)) : fexp2(lb2 * (float)(128 - il)));
#pragma unroll
            for (int n = 0; n < 8; ++n) O[n][r] += T[n][r] * fac; }
    }
    bf16* mix = (bf16*)(ws + WS_MIX);
    unsigned short gtv[4][8]; float gw8[8];
#pragma unroll
    for (int n = 0; n < 8; ++n) gw8[n] = gnw[h * 128 + 16 * n + fr];
#pragma unroll
    for (int r = 0; r < 4; ++r)
#pragma unroll
        for (int n = 0; n < 8; ++n) gtv[r][n] = prj[(size_t)(row0 + i0 + 4 * fq + r) * EV_IN + E_GR + h * 128 + 16 * n + fr];
#pragma unroll
    for (int r = 0; r < 4; ++r) {
        float s1 = 0.f;
#pragma unroll
        for (int n = 0; n < 8; ++n) s1 += O[n][r];
        s1 += __shfl_xor(s1, 1); s1 += __shfl_xor(s1, 2); s1 += __shfl_xor(s1, 4); s1 += __shfl_xor(s1, 8);
        const float mu = s1 * (1.f / 128.f);
        float s2 = 0.f;
#pragma unroll
        for (int n = 0; n < 8; ++n) { const float d = O[n][r] - mu; s2 += d * d; }
        s2 += __shfl_xor(s2, 1); s2 += __shfl_xor(s2, 2); s2 += __shfl_xor(s2, 4); s2 += __shfl_xor(s2, 8);
        const float rstd = 1.f / sqrtf(s2 * (1.f / 128.f) + EPS);
        const int row = row0 + i0 + 4 * fq + r;
#pragma unroll
        for (int n = 0; n < 8; ++n) { const int dv = 16 * n + fr; const float gt = bf2f(gtv[r][n]);
            const float y = (O[n][r] - mu) * rstd * gw8[n] * (gt / (1.f + __expf(-gt)));
            mix[(size_t)row * DM + h * 128 + dv] = f2bf(y); }
    }
    __syncthreads();
}

template <int DQK, bool WINDOW, bool SINK>
__device__ __forceinline__ void attn_unit(LAS unsigned char* lds, int tid, int wave, int lane,
        const bf16* Qp, int ldq, const bf16* Kc, const bf16* Kl, int ldk, const bf16* K2c, const bf16* K2l, int ldk2, const bf16* VT,
        int nctx, int tlo, int thi, int q0, float sc_log2, float sink_log2, bf16* Op, int ldo) {
    constexpr int KS = DQK * 2 + 16, KT_BYTES = 64 * KS, VS = 144, VT_BYTES = 128 * VS, BUF = KT_BYTES + VT_BYTES;
    constexpr int NS = DQK / 16, KPT = DQK / 64;
    const int c = lane & 31, h = lane >> 5;
    bf16x8 qf[NS];
    { const bf16* qr = Qp + (size_t)(wave * 32 + c) * ldq + 8 * h;
#pragma unroll
      for (int s = 0; s < NS; ++s) qf[s] = *(const bf16x8*)(qr + 16 * s); }
    f32x16 oT[4];
#pragma unroll
    for (int dt = 0; dt < 4; ++dt)
#pragma unroll
        for (int r = 0; r < 16; ++r) oT[dt][r] = 0.f;
    float m_run = SINK ? sink_log2 : -1e30f, l_run = (SINK && h == 0) ? 1.f : 0.f;
    const int ntile = nctx + (thi - tlo);
    v4u kregA[KPT], vregA[2], kregB[KPT], vregB[2];
    const unsigned koff0 = (unsigned)((tid >> 4) * ldk + (tid & 15) * 8), koff1 = koff0 + 32u * (unsigned)ldk, koff2 = (unsigned)((tid >> 3) * ldk2 + (tid & 7) * 8);
    const unsigned voff0 = (unsigned)((tid >> 3) * NKEY + (tid & 7) * 8), voff1 = voff0 + 64u * NKEY;
    const int klds0 = (tid >> 4) * KS + (tid & 15) * 16, klds2 = (tid >> 3) * KS + 256 + (tid & 7) * 16, vlds0 = (tid >> 3) * VS + (tid & 7) * 16;
#define ATT_LOAD(i_, kreg, vreg) do { int _i = (i_); if (_i > ntile - 1) _i = ntile - 1; const bool _cx = _i < nctx; const int _t = _cx ? _i : tlo + (_i - nctx); \
        const bf16* _k = (_cx ? Kc : Kl) + (size_t)(64 * _t) * ldk; const int _vc = _cx ? 64 * _t : TC + 64 * _t; \
        kreg[0] = *(const v4u*)(_k + koff0); kreg[1] = *(const v4u*)(_k + koff1); \
        if (DQK > 128) { const bf16* _k2 = (_cx ? K2c : K2l) + (size_t)(64 * _t) * ldk2; kreg[KPT - 1] = *(const v4u*)(_k2 + koff2); } \
        vreg[0] = *(const v4u*)(VT + voff0 + _vc); vreg[1] = *(const v4u*)(VT + voff1 + _vc); } while (0)
#define ATT_STORE(buf_, kreg, vreg) do { LAS unsigned char* _kb = lds + (buf_) * BUF; LAS unsigned char* _vb = _kb + KT_BYTES; \
        *(LAS v4u*)(_kb + klds0) = kreg[0]; *(LAS v4u*)(_kb + klds0 + 32 * KS) = kreg[1]; \
        if (DQK > 128) *(LAS v4u*)(_kb + klds2) = kreg[KPT - 1]; \
        *(LAS v4u*)(_vb + vlds0) = vreg[0]; *(LAS v4u*)(_vb + vlds0 + 64 * VS) = vreg[1]; } while (0)
#define ATT_THR 8.0f
#define ATT_COMPUTE(i) do { \
        if (WINDOW && (i) >= nctx) { const int _k0 = 64 * (tlo + ((i) - nctx)), _qw = q0 + wave * 32; if (_k0 > _qw + 159 || _k0 + 63 < _qw - 128) break; }     \
        const LAS unsigned char* kb = lds + (i & 1) * BUF; const LAS unsigned char* vb = kb + KT_BYTES; \
        f32x16 sT[2]; \
        _Pragma("unroll") \
        for (int kt = 0; kt < 2; ++kt) \
        _Pragma("unroll") \
            for (int r = 0; r < 16; ++r) sT[kt][r] = 0.f; \
        { \
            constexpr int PF = 4, NQ = 2 * NS; \
            bf16x8 kf[PF]; \
        _Pragma("unroll") \
            for (int n = 0; n < PF; ++n) kf[n] = *(const LAS bf16x8*)(kb + (32 * (n / NS) + c) * KS + (16 * (n % NS) + 8 * h) * 2); \
        _Pragma("unroll") \
            for (int n = 0; n < NQ; ++n) { const bf16x8 ka = kf[n % PF]; \
                if (n + PF < NQ) kf[n % PF] = *(const LAS bf16x8*)(kb + (32 * ((n + PF) / NS) + c) * KS + (16 * ((n + PF) % NS) + 8 * h) * 2); \
                sT[n / NS] = mfma32(ka, qf[n % NS], sT[n / NS]); } \
        } \
        const bool msk = WINDOW && (i >= nctx); \
        const int kpos0 = 64 * (tlo + (i - nctx)), qpos = q0 + wave * 32 + c; \
        float mx = -1e38f; \
        _Pragma("unroll") \
        for (int kt = 0; kt < 2; ++kt) \
        _Pragma("unroll") \
            for (int r = 0; r < 16; ++r) { \
                if (WINDOW) { const int kpos = kpos0 + 32 * kt + (r & 3) + 8 * (r >> 2) + 4 * h; const int dd = qpos - kpos; if (msk && (dd > 128 || dd < -128)) sT[kt][r] = -1e38f; } \
                mx = fmaxf(mx, sT[kt][r]); } \
        mx = fmaxf(mx, __shfl_xor(mx, 32)); \
        const float mxs = mx * sc_log2; \
        if (__builtin_amdgcn_ballot_w64(mxs > m_run + ATT_THR) != 0ull) {     \
            const float mn = fmaxf(m_run, mxs), alpha = fexp2(m_run - mn); \
            m_run = mn; l_run *= alpha; \
            _Pragma("unroll") \
            for (int dt = 0; dt < 4; ++dt) \
            _Pragma("unroll") \
                for (int r = 0; r < 16; ++r) oT[dt][r] *= alpha; \
        } \
        float ps = 0.f; \
        _Pragma("unroll") \
        for (int kt = 0; kt < 2; ++kt) \
        _Pragma("unroll") \
            for (int r = 0; r < 16; ++r) { const float pv = fexp2(fmaf(sT[kt][r], sc_log2, -m_run)); sT[kt][r] = pv; ps += pv; } \
        l_run += ps; \
        bf16x8 pf[4]; \
        _Pragma("unroll") \
        for (int s = 0; s < 4; ++s) { const int kt = s >> 1, s8 = (s & 1) * 8; v4u w; \
            w.x = pk2(sT[kt][s8 + 0], sT[kt][s8 + 1]); w.y = pk2(sT[kt][s8 + 2], sT[kt][s8 + 3]); w.z = pk2(sT[kt][s8 + 4], sT[kt][s8 + 5]); w.w = pk2(sT[kt][s8 + 6], sT[kt][s8 + 7]); \
            pf[s] = __builtin_bit_cast(bf16x8, w); } \
        { \
            constexpr int PF = 4; \
            v4u vf[PF]; \
        _Pragma("unroll") \
            for (int n = 0; n < PF; ++n) vf[n] = *(const LAS v4u*)(vb + (32 * (n >> 2) + c) * VS + (16 * (n & 3) + 8 * h) * 2); \
        _Pragma("unroll") \
            for (int n = 0; n < 16; ++n) { const v4u va = vf[n % PF]; \
                if (n + PF < 16) { const int n2 = n + PF; vf[n % PF] = *(const LAS v4u*)(vb + (32 * (n2 >> 2) + c) * VS + (16 * (n2 & 3) + 8 * h) * 2); } \
                oT[n >> 2] = mfma32(__builtin_bit_cast(bf16x8, va), pf[n & 3], oT[n >> 2]); } \
        } \
    } while (0)
    if (ntile > 0) { ATT_LOAD(0, kregA, vregA); ATT_STORE(0, kregA, vregA); ATT_LOAD(1, kregB, vregB); }
    __syncthreads();
    for (int i = 0; i < ntile; i += 2) {
        ATT_LOAD(i + 2, kregA, vregA);
        ATT_COMPUTE(i);
        ATT_STORE((i + 1) & 1, kregB, vregB);
        __syncthreads();
        if (i + 1 < ntile) {
            ATT_LOAD(i + 3, kregB, vregB);
            ATT_COMPUTE(i + 1);
            ATT_STORE(i & 1, kregA, vregA);
            __syncthreads();
        }
    }
#undef ATT_COMPUTE
#undef ATT_THR
#undef ATT_LOAD
#undef ATT_STORE
    const float lt = l_run + __shfl_xor(l_run, 32), inv = 1.f / lt;
    bf16* orow = Op + (size_t)(wave * 32 + c) * ldo + 4 * h;
#pragma unroll
    for (int dt = 0; dt < 4; ++dt)
#pragma unroll
        for (int rq = 0; rq < 4; ++rq) { v2u w; w.x = pk2(oT[dt][4 * rq] * inv, oT[dt][4 * rq + 1] * inv); w.y = pk2(oT[dt][4 * rq + 2] * inv, oT[dt][4 * rq + 3] * inv);
            *(v2u*)(orow + 32 * dt + 8 * rq) = w; }
}

__device__ __forceinline__ void ph_win(unsigned char* ws, const float* sink, LAS unsigned char* lds, int tid, int wave, int lane, int wg, int G) {
    const bf16* prj = (const bf16*)(ws + WS_PRJ); bf16* mix = (bf16*)(ws + WS_MIX); const bf16* vtw = (const bf16*)(ws + WS_VTW);
    const float scl = 0.088388347648318440f * LOG2E;
    for (int u = wg; u < 272; u += G) {
        const bool cx = u >= 256;
        const int pair = cx ? (u - 256) : ((u & 7) * 2 + (u >> 7)), qb = (u >> 3) & 15, b = pair >> 3, hq = pair & 7, kvh = hq >> 2;
        const int q0 = cx ? 0 : qb * 256; int tlo = (q0 - 128) / 64; if (tlo < 0) tlo = 0; int thi = (q0 + 383) / 64 + 1; if (thi > 64) thi = 64; if (cx) { tlo = 0; thi = 0; }
        const int qrow = cx ? b * TC : RC + b * TL + q0;
        attn_unit<128, true, true>(lds, tid, wave, lane, prj + (size_t)qrow * EV_IN + E_QW + hq * 128, EV_IN,
            prj + (size_t)(b * TC) * EV_IN + E_KW + kvh * 128, prj + (size_t)(RC + b * TL) * EV_IN + E_KW + kvh * 128, EV_IN, nullptr, nullptr, 0,
            vtw + (size_t)(b * 2 + kvh) * 128 * NKEY, 4, tlo, thi, q0, scl, sink[hq] * LOG2E, mix + (size_t)qrow * DM + 1024 + hq * 128, DM);
    }
}
__device__ __forceinline__ void ph_ret_out(unsigned char* ws, const float* dec, const float* gnw, LAS unsigned char* lds, int tid, int wave, int lane, int wg, int G) {
    for (int u = (wg + G - 32) % G; u < 16 * NCH; u += G) ret_out_unit(ws, dec, gnw, lds, tid, wave, lane, u);
}

__device__ __forceinline__ void ph_prep_odd(unsigned char* ws, LAS unsigned char* lds, const float* convw, const float* qnw, const float* kvnw, int jl, int tid, int wave, int lane, int wg, int G) {
    const bf16* prj = (const bf16*)(ws + WS_PRJ); bf16* mix = (bf16*)(ws + WS_MIX);
    {
        const bf16* a1 = (const bf16*)(ws + WS_A1); const bf16* wk = (const bf16*)(ws + WS_WKRT) + (size_t)jl * 64 * DM; bf16* kr = (bf16*)(ws + WS_KR);
        const int fr = lane & 15, fq = lane >> 4;
        LAS f32x4* red = (LAS f32x4*)lds;
        for (int t = wg; t < RALL / 32; t += G) {
            f32x4 acc[2][4];
#pragma unroll
            for (int m = 0; m < 2; ++m)
#pragma unroll
                for (int n = 0; n < 4; ++n) acc[m][n] = (f32x4){0.f, 0.f, 0.f, 0.f};
            const bf16* ap = a1 + (size_t)(32 * t + fr) * DM + 256 * wave + 8 * fq; const bf16* bp = wk + (size_t)fr * DM + 256 * wave + 8 * fq;
#pragma unroll
            for (int s = 0; s < 8; ++s) { bf16x8 af[2], bfr[4];
#pragma unroll
                for (int m = 0; m < 2; ++m) af[m] = *(const bf16x8*)(ap + (size_t)(16 * m) * DM + 32 * s);
#pragma unroll
                for (int n = 0; n < 4; ++n) bfr[n] = *(const bf16x8*)(bp + (size_t)(16 * n) * DM + 32 * s);
#pragma unroll
                for (int m = 0; m < 2; ++m)
#pragma unroll
                    for (int n = 0; n < 4; ++n) acc[m][n] = mfma16(af[m], bfr[n], acc[m][n]); }
#pragma unroll
            for (int m = 0; m < 2; ++m)
#pragma unroll
                for (int n = 0; n < 4; ++n) red[(wave * 8 + m * 4 + n) * 64 + lane] = acc[m][n];
            __syncthreads();
            { const int m = wave >> 2, n = wave & 3; f32x4 sacc = red[(0 * 8 + wave) * 64 + lane];
#pragma unroll
              for (int w = 1; w < 8; ++w) sacc += red[(w * 8 + wave) * 64 + lane];
#pragma unroll
              for (int r = 0; r < 4; ++r) kr[(size_t)(32 * t + 16 * m + 4 * fq + r) * 64 + 16 * n + fr] = f2bf(sacc[r]); }
            __syncthreads();
        }
    }
    const int gt = wg * NTHR + tid, NGT = G * NTHR;
    const bool wfix = (NGT & 127) == 0;
    float w0[8], w1[8], w2[8];
    if (wfix) { const int c0 = (gt & 127) * 8; ld8f(convw + c0, w0); ld8f(convw + 1024 + c0, w1); ld8f(convw + 2048 + c0, w2); }
    for (int idx0 = gt; idx0 < RALL * 128; idx0 += 3 * NGT) {
        v4u wb[3], wc[3][3], wx[3][3];
#pragma unroll
        for (int b = 0; b < 3; ++b) { const int idx = idx0 + b * NGT; if (idx < RALL * 128) {
            const int r = idx >> 7, c0 = (idx & 127) * 8;
            int t, T; if (r < RC) { t = r & (TC - 1); T = TC; } else { t = (r - RC) & (TL - 1); T = TL; }
            const bf16* pr = prj + (size_t)r * OD_INP;
            wb[b] = *(const v4u*)(pr + O_BG + c0); wc[b][1] = *(const v4u*)(pr + O_CG + c0); wx[b][1] = *(const v4u*)(pr + O_XV + c0);
            if (t > 0) { wc[b][0] = *(const v4u*)(pr - OD_INP + O_CG + c0); wx[b][0] = *(const v4u*)(pr - OD_INP + O_XV + c0); } else { wc[b][0] = (v4u){0u, 0u, 0u, 0u}; wx[b][0] = wc[b][0]; }
            if (t < T - 1) { wc[b][2] = *(const v4u*)(pr + OD_INP + O_CG + c0); wx[b][2] = *(const v4u*)(pr + OD_INP + O_XV + c0); } else { wc[b][2] = (v4u){0u, 0u, 0u, 0u}; wx[b][2] = wc[b][2]; } } }
#pragma unroll
        for (int b = 0; b < 3; ++b) { const int idx = idx0 + b * NGT; if (idx < RALL * 128) {
            const int r = idx >> 7, c0 = (idx & 127) * 8;
            float bg[8], u0[8], u1[8], u2[8], a[8], b2[8], y[8];
            unpack8(wb[b], bg);
            unpack8(wc[b][0], a); unpack8(wx[b][0], b2);
#pragma unroll
            for (int e = 0; e < 8; ++e) u0[e] = a[e] * b2[e];
            unpack8(wc[b][1], a); unpack8(wx[b][1], b2);
#pragma unroll
            for (int e = 0; e < 8; ++e) u1[e] = a[e] * b2[e];
            unpack8(wc[b][2], a); unpack8(wx[b][2], b2);
#pragma unroll
            for (int e = 0; e < 8; ++e) u2[e] = a[e] * b2[e];
            if (!wfix) { ld8f(convw + c0, w0); ld8f(convw + 1024 + c0, w1); ld8f(convw + 2048 + c0, w2); }
#pragma unroll
            for (int e = 0; e < 8; ++e) y[e] = bg[e] * (u0[e] * w0[e] + u1[e] * w1[e] + u2[e] * w2[e]);
            *(v4u*)(mix + (size_t)r * DM + c0) = pack8(y); } }
    }
    bf16* cqn = (bf16*)(ws + WS_CQN); bf16* ckvn = (bf16*)(ws + WS_CKVN);
    const int gw = wg * NWAVES + wave, NGW = G * NWAVES;
    float qw8[8]; ld8f(qnw + 8 * lane, qw8); const f32x4 kw4 = *(const f32x4*)(kvnw + 4 * lane);
    for (int r0 = gw; r0 < RALL; r0 += 5 * NGW) {
        v4u wq[5]; v2u wk[5];
#pragma unroll
        for (int b = 0; b < 5; ++b) { const int r = r0 + b * NGW; if (r < RALL) { const bf16* pr = prj + (size_t)r * OD_INP; wq[b] = *(const v4u*)(pr + O_CQ + 8 * lane); wk[b] = *(const v2u*)(pr + O_CKV + 4 * lane); } }
#pragma unroll
        for (int b = 0; b < 5; ++b) { const int r = r0 + b * NGW; if (r < RALL) {
            float q[8]; unpack8(wq[b], q);
            float ss = 0.f;
#pragma unroll
            for (int e = 0; e < 8; ++e) ss += q[e] * q[e];
            ss = wave_sum(ss);
            const float rs = 1.f / sqrtf(ss * (1.f / 512.f) + EPS);
#pragma unroll
            for (int e = 0; e < 8; ++e) q[e] = q[e] * rs * qw8[e];
            *(v4u*)(cqn + (size_t)r * 512 + 8 * lane) = pack8(q);
            const v2u kw = wk[b];
            const float k0 = bflo(kw.x), k1 = bfhi(kw.x), k2 = bflo(kw.y), k3 = bfhi(kw.y);
            float s2 = wave_sum(k0 * k0 + k1 * k1 + k2 * k2 + k3 * k3);
            const float rs2 = 1.f / sqrtf(s2 * (1.f / 256.f) + EPS);
            v2u o; o.x = pk2(k0 * rs2 * kw4.x, k1 * rs2 * kw4.y); o.y = pk2(k2 * rs2 * kw4.z, k3 * rs2 * kw4.w);
            *(v2u*)(ckvn + (size_t)r * 256 + 4 * lane) = o; } }
    }
}
__device__ __forceinline__ void rope64_item(bf16* blk, int t, int half, int p, const float* t3c, const float* t3s) {
    const int posv = half ? (t & 63) : (t >> 6); bf16* bp = blk + half * 32 + 8 * p; const int tb = posv * 16 + 8 * p;
    const v4u w1 = *(const v4u*)bp, w2 = *(const v4u*)(bp + 16);
    float x1[8], x2[8], cs[8], sn[8], o1[8], o2[8];
    unpack8(w1, x1); unpack8(w2, x2); ld8f(t3c + tb, cs); ld8f(t3s + tb, sn);
#pragma unroll
    for (int e = 0; e < 8; ++e) { o1[e] = x1[e] * cs[e] - x2[e] * sn[e]; o2[e] = x2[e] * cs[e] + x1[e] * sn[e]; }
    *(v4u*)bp = pack8(o1); *(v4u*)(bp + 16) = pack8(o2);
}
__device__ __forceinline__ void ph_rope_kr(unsigned char* ws, int tid, int wg, int G) {
    bf16* krb = (bf16*)(ws + WS_KR); const float* t3c = (const float*)(ws + WS_T2) + 2 * 64 * 32; const float* t3s = t3c + 64 * 16;
    for (int idx = wg * NTHR + tid; idx < NB * TL * 4; idx += G * NTHR) { const int p = idx & 1, half = (idx >> 1) & 1, rl = idx >> 2;
        rope64_item(krb + (size_t)(RC + rl) * 64, rl & (TL - 1), half, p, t3c, t3s); }
}
__device__ __forceinline__ void post_q_tile(unsigned char* ws, int pm, int pn, int tid) {
    if (pm < 2) return;
    bf16* qraw = (bf16*)(ws + WS_QRAW); const float* t3c = (const float*)(ws + WS_T2) + 2 * 64 * 32; const float* t3s = t3c + 64 * 16;
    for (int h = 0; h < 8; ++h) { const int c0 = 192 * h + 128; if (c0 < 256 * pn || c0 >= 256 * pn + 256) continue;
        for (int idx = tid; idx < 1024; idx += NTHR) { const int p = idx & 1, half = (idx >> 1) & 1, i = idx >> 2; const int r = pm * 256 + i;
            rope64_item(qraw + (size_t)r * 1536 + c0, (r - RC) & (TL - 1), half, p, t3c, t3s); } }
}
__device__ __forceinline__ void post_v_tile(unsigned char* ws, LAS unsigned char* lds, int b, int hh, int kt0, int wave, int lane) {
    const bf16* kvraw = (const bf16*)(ws + WS_KVRAW); bf16* vtm = (bf16*)(ws + WS_VTM); LAS unsigned char* scr = lds + wave * 16384;
    const int kt = kt0 + (wave >> 1), dvh = wave & 1, row0 = key_row(b, 64 * kt);
    vt_tile(kvraw + (size_t)row0 * 2048 + hh * 256 + 128 + dvh * 64, 2048, vtm + ((size_t)(b * 8 + hh) * 128 + dvh * 64) * NKEY + 64 * kt, scr, lane);
}
__device__ __forceinline__ void ph_mix_odd(unsigned char* ws, LAS unsigned char* lds, int nunits, int tid, int wave, int lane, int wg, int G) {
    const bf16* krb = (const bf16*)(ws + WS_KR); bf16* mix = (bf16*)(ws + WS_MIX); const bf16* vtm = (const bf16*)(ws + WS_VTM);
    const bf16* qraw = (const bf16*)(ws + WS_QRAW); const bf16* kvraw = (const bf16*)(ws + WS_KVRAW);
    const float scl = 0.072168783648703220f * LOG2E;
    for (int u = wg; u < nunits; u += G) {
        const bool cx = u >= 256;
        const int pair = cx ? (u - 256) : ((u & 7) * 2 + (u >> 7)), qb = (u >> 3) & 15, b = pair >> 3, hh = pair & 7;
        const int q0 = cx ? 0 : qb * 256, qrow = cx ? b * TC : RC + b * TL + q0;
        attn_unit<192, false, false>(lds, tid, wave, lane, qraw + (size_t)qrow * 1536 + hh * 192, 1536,
            kvraw + (size_t)(b * TC) * 2048 + hh * 256, kvraw + (size_t)(RC + b * TL) * 2048 + hh * 256, 2048,
            krb + (size_t)(b * TC) * 64, krb + (size_t)(RC + b * TL) * 64, 64,
            vtm + (size_t)(b * 8 + hh) * 128 * NKEY, 4, 0, cx ? 0 : 64, q0, scl, 0.f, mix + (size_t)qrow * DM + 1024 + hh * 128, DM);
    }
}

#define NOINL static __device__ __forceinline__
typedef const GAS float* gcf;
typedef GAS unsigned char* gws;
typedef const GAS unsigned short* gcb;
__device__ __forceinline__ int mk_lane() { int l; asm volatile("v_mbcnt_lo_u32_b32 %0, -1, 0\n\tv_mbcnt_hi_u32_b32 %0, -1, %0" : "=v"(l)); return l; }
#define PH_IDS int wv_ = wave_in; asm volatile("" : "+s"(wv_)); const int wave = wv_, lane = mk_lane(), tid = wave * 64 + lane, G = gridDim.x, wg = blockIdx.x; (void)lane; (void)wave; (void)G; (void)wg; (void)tid
#define PH_GW const int gw = wg * NWAVES + wave, NGW = G * NWAVES

__device__ __forceinline__ int uni(int v) { return __builtin_amdgcn_readfirstlane(v); }
template <class T> __device__ __forceinline__ GAS T* uni(GAS T* p) { const unsigned long long v = (unsigned long long)p; const unsigned lo = (unsigned)__builtin_amdgcn_readfirstlane((int)(unsigned)v), hi = (unsigned)__builtin_amdgcn_readfirstlane((int)(unsigned)(v >> 32));
    return (GAS T*)(((unsigned long long)hi << 32) | lo); }
template <class T> __device__ __forceinline__ LAS T* uni(LAS T* p) { return (LAS T*)(unsigned)__builtin_amdgcn_readfirstlane((int)(unsigned)(unsigned long long)p); }
#define U(x) x = uni(x)
#define OPQ(x) asm volatile("" : "+s"(x))

NOINL void f_prologue(int wave_in, gws ws, LAS unsigned char* lds, gcf x, gcf c, gcf ctx, gcf c_ctx, gcf w_mod, gcf b_mod, gcf mlp_w1, gcf mlp_w2, gcf ev_w_in, gcf ev_w_out, gcf od_w_in, gcf od_w_out, gcf od_w_uq, gcf od_w_ukv) {
    PH_IDS; U(ws); U(lds); U(x); U(c); U(ctx); U(c_ctx); U(w_mod); U(b_mod); U(mlp_w1); U(mlp_w2); U(ev_w_in); U(ev_w_out); U(od_w_in); U(od_w_out); U(od_w_uq); U(od_w_ukv);
    ProIn p{(const float*)x, (const float*)c, (const float*)ctx, (const float*)c_ctx, (const float*)w_mod, (const float*)b_mod, (const float*)mlp_w1, (const float*)mlp_w2, (const float*)ev_w_in, (const float*)ev_w_out,
            (const float*)od_w_in, (const float*)od_w_out, (const float*)od_w_uq, (const float*)od_w_ukv};
    ph_prologue(p, (unsigned char*)ws, lds, tid, wave, lane, wg, G);
}
NOINL void f_norm(int wave_in, gws ws, LAS unsigned char* lds, gcf nw, gcf ctx32, gcf x32, int layer, int ch_sh, int ch_sc, int mode) {
    PH_IDS; PH_GW; U(ws); U(lds); U(nw); U(ctx32); U(x32); U(layer); U(ch_sh); U(ch_sc); U(mode);
    const float* mod_l = (const float*)(ws + WS_MOD) + (size_t)layer * 3 * 12288;
    bf16* Hb = (bf16*)(ws + WS_H);
    if (mode == 1) ph_norm_ctx<S_MLP>(nullptr, Hb, (const float*)nw, mod_l, ch_sh, ch_sc, (bf16*)(ws + WS_A1), (const bf16*)(ws + WS_PARTM), mod_l - 3 * 12288 + (2 * 6 + 5) * DM, lds, tid, wave, lane, wg, G);
    if (mode == 2) ph_norm_ctx<S_OUT>(layer == 0 ? (const float*)ctx32 : nullptr, Hb, (const float*)nw, mod_l, ch_sh, ch_sc, (bf16*)(ws + WS_A1), (const bf16*)(ws + WS_PARTO), mod_l + (2 * 6 + 2) * DM, lds, tid, wave, lane, wg, G);
    __syncthreads();
    ph_norm(mode == 0, (const float*)ctx32, (const float*)x32, Hb, (const float*)nw, mod_l, ch_sh, ch_sc, (bf16*)(ws + WS_A1), mode == 0 ? 0 : RC, lds, tid, gw, NGW, lane);
}
NOINL void f_final(int wave_in, gws ws, gcf nw, GAS float* out) { PH_IDS; PH_GW; U(ws); U(nw); U(out); ph_final((const bf16*)(ws + WS_H), (const float*)nw, (float*)out, gw, NGW, lane); }
NOINL void f_post_win(int wave_in, gws ws, LAS unsigned char* lds) { PH_IDS; U(ws); U(lds); VM_WAIT(); __syncthreads();
    pg8::StaticOrder S; S.init(RALL, EV_IN, G, wg, DM); pg8::Unit u;
    for (int i = 0; S.next(i, u); ++i) { post_win_tile((unsigned char*)ws, lds, u.pm, u.pn, tid, wave, lane); } }
NOINL void f_ret_kv(int wave_in, gws ws, LAS unsigned char* lds, gcf dec) { PH_IDS; U(ws); U(lds); U(dec); for (int u = wg; u < 16 * NCH; u += G) ret_kv_unit((unsigned char*)ws, (const float*)dec, lds, tid, wave, lane, u); }
NOINL void f_ret_scan(int wave_in, gws ws, gcf dec) { PH_IDS; U(ws); U(dec); ph_ret_scan((unsigned char*)ws, (const float*)dec, tid, wg, G); }
NOINL void f_win(int wave_in, gws ws, LAS unsigned char* lds, gcf sink) { PH_IDS; U(ws); U(lds); U(sink); ph_win((unsigned char*)ws, (const float*)sink, lds, tid, wave, lane, wg, G); }
NOINL void f_ret_out(int wave_in, gws ws, LAS unsigned char* lds, gcf dec, gcf gnw) { PH_IDS; U(ws); U(lds); U(dec); U(gnw); ph_ret_out((unsigned char*)ws, (const float*)dec, (const float*)gnw, lds, tid, wave, lane, wg, G); }
NOINL void f_prep_odd(int wave_in, gws ws, LAS unsigned char* lds, gcf convw, gcf qnw, gcf kvnw, int jl) { PH_IDS; U(ws); U(lds); U(convw); U(qnw); U(kvnw); U(jl); ph_prep_odd((unsigned char*)ws, lds, (const float*)convw, (const float*)qnw, (const float*)kvnw, jl, tid, wave, lane, wg, G); }
NOINL void f_rope_kr(int wave_in, gws ws) { PH_IDS; U(ws); ph_rope_kr((unsigned char*)ws, tid, wg, G); }
NOINL void f_post_q(int wave_in, gws ws) { PH_IDS; U(ws); VM_WAIT(); __syncthreads();
    pg8::StaticOrder S; S.init(RALL, 1536, G, wg, 512); pg8::Unit u; for (int i = 0; S.next(i, u); ++i) post_q_tile((unsigned char*)ws, u.pm, u.pn, tid); }
NOINL void f_post_v(int wave_in, gws ws, LAS unsigned char* lds) { PH_IDS; U(ws); U(lds); VM_WAIT(); __syncthreads();
    pg8::Unit u;
    { pg8::StaticOrder S; S.init(RC, 2048, G, ((wg - 204) % G + G) % G, 256); for (int i = 0; S.next(i, u); ++i) post_v_tile((unsigned char*)ws, lds, u.pm, u.pn, 0, wave, lane); }
    { pg8::StaticOrder S; S.init(RALL - RC, 2048, G, wg, 256); for (int i = 0; S.next(i, u); ++i) post_v_tile((unsigned char*)ws, lds, u.pm >> 4, u.pn, 4 + (u.pm & 15) * 4, wave, lane); }
}
NOINL void f_mla(int wave_in, gws ws, LAS unsigned char* lds, int nunits) { PH_IDS; U(ws); U(lds); U(nunits); ph_mix_odd((unsigned char*)ws, lds, nunits, tid, wave, lane, wg, G); }
template <int ACT> NOINL void f_gemm_act(int wave_in, LAS unsigned char* lds, gcb A, gcb Bt, GAS unsigned short* O, int M, int N, int K, int ldc, int wg_shift = 0) {
    PH_IDS; U(lds); U(A); U(Bt); U(O); U(M); U(N); U(K); U(ldc); U(wg_shift); OPQ(M); OPQ(N); OPQ(K); OPQ(ldc);
    pg8::Gemm g{(const pg8::bf16_t*)A, (const pg8::bf16_t*)Bt, M, N, K}; pg8::StaticOrder S; S.init(M, N, G, ((wg - wg_shift) % G + G) % G, K);
    pg8::EpiAct<ACT> E{(pg8::bf16_t*)O, ldc};
    pg8::gemm_phase<pg8::EpiAct<ACT>, pg8::StaticOrder, PG8_ALIGN, PG8_SP2>((PG8_LAS unsigned char*)lds, g, S, E, wave);
}
NOINL void f_gemm_res(int wave_in, LAS unsigned char* lds, gcb A, gcb Bt, GAS unsigned short* Hp, gcf x32, gcf gate0, GAS unsigned short* part, int M, int N, int K, int S) {
    PH_IDS; U(lds); U(A); U(Bt); U(Hp); U(x32); U(gate0); U(part); U(M); U(N); U(K); U(S); OPQ(M); OPQ(N); OPQ(K); OPQ(S);
    pg8::Gemm g{(const pg8::bf16_t*)A, (const pg8::bf16_t*)Bt, M, N, K}; pg8::ResOrder S_; S_.init(M, N, K, S, G, wg);
    pg8::EpiResGate E{(pg8::bf16_t*)Hp, N, (const float*)gate0, 6 * DM, (pg8::bf16_t*)part, (const float*)x32};
    pg8::gemm_phase<pg8::EpiResGate, pg8::ResOrder, PG8_ALIGN, PG8_SP2>((PG8_LAS unsigned char*)lds, g, S_, E, wave);
}

constexpr int PH_END = 50;
#ifndef MK_PER_PHASE
#define MK_PER_PHASE 0
#endif
__global__ void __launch_bounds__(NTHR, 2) mk_fwd(Args a) {
    extern __shared__ __attribute__((aligned(16))) unsigned char lds_raw[];
    LAS unsigned char* lds = (LAS unsigned char*)lds_raw;
    const int tid = threadIdx.x;
    const int wv = __builtin_amdgcn_readfirstlane(tid >> 6);
    gws ws = (gws)a.ws;
    volatile LAS unsigned* MISC = (volatile LAS unsigned*)(lds + MISC_OFF);
    for (int u = tid; u < (LDS_BYTES - MISC_OFF) / 4; u += NTHR) ((LAS unsigned*)(lds + MISC_OFF))[u] = 0u;
    __syncthreads();
    const int lo = a.ph_lo, hi = a.ph_hi;
    XcdBarrier bar; bar.bar = (unsigned*)(a.ws + WS_CTL) + CW_BAR; bar.x = 0; bar.st = MISC + 8;
    if (hi - lo > 1) bar = xcd_barrier_post((unsigned*)(a.ws + WS_CTL) + CW_BAR, MISC + 8);
#define IN(k) (lo <= (k) && (k) < hi)
#define SEAM(k) do { if ((k) + 1 < hi) xcd_barrier(bar); } while (0)

    if (IN(0)) { f_prologue(wv, ws, lds, (gcf)a.x, (gcf)a.c, (gcf)a.ctx, (gcf)a.c_ctx, (gcf)a.w_mod, (gcf)a.b_mod, (gcf)a.mlp_w1, (gcf)a.mlp_w2, (gcf)a.ev_w_in, (gcf)a.ev_w_out, (gcf)a.od_w_in, (gcf)a.od_w_out, (gcf)a.od_w_uq, (gcf)a.od_w_ukv);


        SEAM(0); }

#pragma nounroll
    for (int l = 0; l < DEPTH; ++l) {
        const int j = l >> 1, pb = 1 + 12 * l;
        const int row_off = (l == DEPTH - 1) ? RC : 0, Mr = RALL - row_off;
        if (IN(pb + 0)) { f_norm(wv, ws, lds, (gcf)(a.norm1_w + l * DM), (gcf)a.ctx, (gcf)a.x, l, 0, 1, l == 0 ? 0 : 1); SEAM(pb + 0); }
        if (!(l & 1)) {
            if (IN(pb + 1)) { f_gemm_act<0>(wv, lds, (gcb)(ws + WS_A1), (gcb)(ws + WS_EWIN) + (size_t)j * EV_IN * DM, (GAS unsigned short*)(ws + WS_PRJ), RALL, EV_IN, DM, EV_IN);
                f_post_win(wv, ws, lds);
                SEAM(pb + 1); }
            if (IN(pb + 2)) { f_ret_kv(wv, ws, lds, (gcf)(a.ev_decay + j * 16)); SEAM(pb + 2); }
            if (IN(pb + 4)) { f_ret_scan(wv, ws, (gcf)(a.ev_decay + j * 16)); SEAM(pb + 4); }
            if (IN(pb + 5)) { f_win(wv, ws, lds, (gcf)(a.ev_sink + j * 8)); __syncthreads(); f_ret_out(wv, ws, lds, (gcf)(a.ev_decay + j * 16), (gcf)(a.ev_gn_w + j * 1024));


                SEAM(pb + 5); }
        } else {
            if (IN(pb + 1)) { f_gemm_act<0>(wv, lds, (gcb)(ws + WS_A1), (gcb)(ws + WS_OWIN) + (size_t)j * OD_INP * DM, (GAS unsigned short*)(ws + WS_PRJ), RALL, OD_INP, DM, OD_INP);
                SEAM(pb + 1); }
            if (IN(pb + 2)) { f_prep_odd(wv, ws, lds, (gcf)(a.od_conv_w + j * 3 * 1024), (gcf)(a.od_qn_w + j * 512), (gcf)(a.od_kvn_w + j * 256), j); SEAM(pb + 2); }
            if (IN(pb + 3)) {
                f_rope_kr(wv, ws);
                f_gemm_act<0>(wv, lds, (gcb)(ws + WS_CQN), (gcb)(ws + WS_UQT) + (size_t)j * 1536 * 512, (GAS unsigned short*)(ws + WS_QRAW), RALL, 1536, 512, 1536);
                f_post_q(wv, ws);
                __syncthreads();
                f_gemm_act<0>(wv, lds, (gcb)(ws + WS_CKVN), (gcb)(ws + WS_UKVT) + (size_t)j * 2048 * 256, (GAS unsigned short*)(ws + WS_KVRAW), RC, 2048, 256, 2048, 204);
                __syncthreads();
                f_gemm_act<0>(wv, lds, (gcb)(ws + WS_CKVN) + (size_t)RC * 256, (gcb)(ws + WS_UKVT) + (size_t)j * 2048 * 256, (GAS unsigned short*)(ws + WS_KVRAW) + (size_t)RC * 2048, RALL - RC, 2048, 256, 2048);
                f_post_v(wv, ws, lds);
                SEAM(pb + 3); }
            if (IN(pb + 6)) { f_mla(wv, ws, lds, row_off ? 256 : 272); SEAM(pb + 6); }
        }
        if (IN(pb + 7)) { gcb wo = (l & 1) ? (gcb)(ws + WS_OWOUT) + (size_t)j * DM * DM : (gcb)(ws + WS_EWOUT) + (size_t)j * DM * DM;
            f_gemm_res(wv, lds, (gcb)(ws + WS_MIX), wo, (GAS unsigned short*)(ws + WS_H), l == 0 ? (gcf)a.x : (gcf)nullptr, (gcf)(ws + WS_MOD) + (size_t)l * 3 * 12288 + 2 * DM, (GAS unsigned short*)(ws + WS_PARTO), RALL, DM, DM, row_off ? 0 : S_OUT);
            SEAM(pb + 7); }
        if (IN(pb + 8)) { f_norm(wv, ws, lds, (gcf)(a.norm2_w + l * DM), (gcf)a.ctx, (gcf)a.x, l, 3, 4, row_off ? 3 : 2); SEAM(pb + 8); }
        if (IN(pb + 9)) { f_gemm_act<1>(wv, lds, (gcb)(ws + WS_A1) + (size_t)row_off * DM, (gcb)(ws + WS_W1T) + (size_t)l * DFF * DM, (GAS unsigned short*)(ws + WS_HID) + (size_t)row_off * DFF, Mr, DFF, DM, DFF);

            SEAM(pb + 9); }
        if (IN(pb + 10)) { f_gemm_res(wv, lds, (gcb)(ws + WS_HID), (gcb)(ws + WS_W2T) + (size_t)l * DM * DFF, (GAS unsigned short*)(ws + WS_H), (gcf)nullptr, (gcf)(ws + WS_MOD) + (size_t)l * 3 * 12288 + 5 * DM, (GAS unsigned short*)(ws + WS_PARTM), RALL, DM, DFF, row_off ? 0 : S_MLP);
            SEAM(pb + 10); }
    }
    if (IN(49)) f_final(wv, ws, (gcf)a.norm_f, (GAS float*)a.out);
#undef IN
#undef SEAM
}

extern "C" void kernel_launch(void* const* d_in, const int* in_sizes, int n_in, void* d_out, int out_size, void* d_ws, size_t ws_size, hipStream_t stream) {
    static int grid = 0;
    if (grid == 0) {
        if (n_in != 23 || out_size != NB * TL * DM || ws_size < WS_END) { fprintf(stderr, "kernel_launch: unexpected shapes (n_in %d, out %d, ws %zu); nothing launched\n", n_in, out_size, ws_size); grid = -1; return; }
        int dev = 0, cus = 0, per_cu = 0;
        if (hipGetDevice(&dev) != hipSuccess || hipDeviceGetAttribute(&cus, hipDeviceAttributeMultiprocessorCount, dev) != hipSuccess) { grid = -1; return; }
        if (hipFuncSetAttribute((const void*)mk_fwd, hipFuncAttributeMaxDynamicSharedMemorySize, LDS_BYTES) != hipSuccess) { fprintf(stderr, "kernel_launch: hipFuncSetAttribute failed\n"); grid = -1; return; }
        if (hipOccupancyMaxActiveBlocksPerMultiprocessor(&per_cu, (const void*)mk_fwd, NTHR, LDS_BYTES) != hipSuccess || per_cu < 1) { fprintf(stderr, "kernel_launch: occupancy query reports %d blocks per CU; nothing launched\n", per_cu); grid = -1; (void)hipGetLastError(); return; }
        grid = cus;
    }
    if (grid < 0) return;
    if (hipMemsetAsync((char*)d_ws + WS_CTL, 0, CTL_ZERO_BYTES, stream) != hipSuccess) return;
    Args a{};
    const float** ap = (const float**)&a;
    for (int i = 0; i < 23; ++i) ap[i] = (const float*)d_in[i];
    a.out = (float*)d_out; a.ws = (unsigned char*)d_ws;
#if MK_PER_PHASE
    for (int p = 0; p < PH_END; ++p) { a.ph_lo = p; a.ph_hi = p + 1; hipLaunchKernelGGL(mk_fwd, dim3(grid), dim3(NTHR), LDS_BYTES, stream, a); }
#else
    a.ph_lo = 0; a.ph_hi = PH_END;
    hipLaunchKernelGGL(mk_fwd, dim3(grid), dim3(NTHR), LDS_BYTES, stream, a);
#endif
    const hipError_t le = hipPeekAtLastError();
    if (le != hipSuccess) fprintf(stderr, "kernel_launch: launch failed: %s\n", hipGetErrorName(le));
}
```
